# Optimizing an MI355X kernel written in HIP

```python
import math
import jax, jax.numpy as jnp
from jax import lax
import numpy as np

D_MODEL = 2048
BATCH = 4
SEQ = 8192
DEPTH = 2
DEC_BATCH = 16
DEC_SEQ = 64
PAST_LEN = 2048

CHUNK = 64
EPS = 1e-6
SSD_HEADS = 32
SSD_HEAD_DIM = 64
D_INNER = SSD_HEADS * SSD_HEAD_DIM
SSD_GROUPS = 4
D_STATE = 128
CONV_W = 4
XBC_DIM = D_INNER + 2 * SSD_GROUPS * D_STATE
GM_CHUNK = 128
GM_GROUPS = 8
GM_GROUP_DIM = 128
GM_WIDTH = GM_GROUPS * GM_GROUP_DIM
D_FF = 5632
PLE_DIM = 256
IN_COLS = D_INNER + XBC_DIM + SSD_HEADS + 2 * GM_WIDTH + 2 * D_MODEL

kernel_name = 'hybrid_ssd_gmlp_streaming_step'


def _rmsnorm(x, g):
    xf = x.astype(jnp.float32)
    y = xf * lax.rsqrt(jnp.mean(xf * xf, axis=-1, keepdims=True) + EPS)
    return (y * g.astype(jnp.float32)).astype(x.dtype)


def _swiglu(h, w_gate, w_up, w_down):
    return (jax.nn.silu(h @ w_gate) * (h @ w_up)) @ w_down


def _causal_dwconv(x, buf, w, b):
    L = x.shape[1]
    xp = jnp.concatenate([buf.astype(x.dtype), x], axis=1)
    y = b
    for k in range(CONV_W):
        y = y + xp[:, k:k + L] * w[k]
    return y, xp[:, xp.shape[1] - (CONV_W - 1):]


def _ssd_scan(x, dt, a, bm, cm, h0):
    bsz, L, H, P = x.shape
    G, N = bm.shape[2], bm.shape[3]
    hg = H // G
    Q = min(CHUNK, L)
    nc = L // Q

    def blocks(t):
        return jnp.moveaxis(t.reshape((bsz, nc, Q) + t.shape[2:]), 1, 0)

    mask = jnp.tril(jnp.ones((Q, Q), dtype=bool))

    def step(h, inp):
        xc, dtc, bc, cc = inp
        cum = jnp.cumsum(dtc * a, axis=1)
        seg = cum[:, :, None, :] - cum[:, None, :, :]
        decay = jnp.exp(jnp.where(mask[None, :, :, None], seg, -jnp.inf))
        cb = jnp.repeat(jnp.einsum('btgn,bsgn->btsg', cc, bc), hg, axis=-1)
        xdt = xc * dtc[..., None]
        y_diag = jnp.einsum('btsh,bshp->bthp', cb * decay, xdt)
        h_grp = h.reshape(bsz, G, hg, P, N)
        y_off = jnp.einsum('btgn,bgkpn->btgkp', cc, h_grp).reshape(bsz, Q, H, P) * jnp.exp(cum)[..., None]
        dec_end = jnp.exp(cum[:, -1:, :] - cum)
        bh = jnp.repeat(bc, hg, axis=2)
        h_new = h * jnp.exp(cum[:, -1])[:, :, None, None] + jnp.einsum('bsh,bshp,bshn->bhpn', dec_end, xdt, bh)
        return h_new, y_diag + y_off

    h_last, ys = lax.scan(step, h0, (blocks(x), blocks(dt), blocks(bm), blocks(cm)))
    y = jnp.moveaxis(ys, 0, 1).reshape(bsz, L, H, P)
    return y, h_last


def _ssd_branch(z, xbc_raw, dt_raw, conv_buf, h0, conv_w, conv_b, dt_bias, a_log, d_skip, norm_g):
    xbc, new_buf = _causal_dwconv(xbc_raw, conv_buf, conv_w, conv_b)
    xbc = jax.nn.silu(xbc).astype(jnp.float32)
    bsz, L, _ = xbc.shape
    gn = SSD_GROUPS * D_STATE
    xs = xbc[..., :D_INNER].reshape(bsz, L, SSD_HEADS, SSD_HEAD_DIM)
    bm = xbc[..., D_INNER:D_INNER + gn].reshape(bsz, L, SSD_GROUPS, D_STATE)
    cm = xbc[..., D_INNER + gn:].reshape(bsz, L, SSD_GROUPS, D_STATE)
    dt = jax.nn.softplus(dt_raw.astype(jnp.float32) + dt_bias.astype(jnp.float32))
    a = -jnp.exp(a_log.astype(jnp.float32))
    y, h_last = _ssd_scan(xs, dt, a, bm, cm, h0.astype(jnp.float32))
    y = y + xs * d_skip.astype(jnp.float32)[:, None]
    yg = (y.reshape(bsz, L, D_INNER) * jax.nn.silu(z.astype(jnp.float32))).reshape(bsz, L, SSD_GROUPS, D_INNER // SSD_GROUPS)
    yg = yg * lax.rsqrt(jnp.mean(yg * yg, axis=-1, keepdims=True) + EPS)
    y = yg.reshape(bsz, L, D_INNER) * norm_g.astype(jnp.float32)
    return y.astype(z.dtype), new_buf, h_last


def _gmlp_branch(uv, ln_g, ln_b, ws, bs):
    uv = jax.nn.gelu(uv)
    u, v = uv[..., :GM_WIDTH], uv[..., GM_WIDTH:]
    vf = v.astype(jnp.float32)
    mu = jnp.mean(vf, axis=-1, keepdims=True)
    var = jnp.mean(jnp.square(vf - mu), axis=-1, keepdims=True)
    vn = ((vf - mu) * lax.rsqrt(var + EPS) * ln_g.astype(jnp.float32) + ln_b.astype(jnp.float32)).astype(v.dtype)
    bsz, L, _ = u.shape
    T = min(GM_CHUNK, L)
    nc = L // T
    mask = jnp.tril(jnp.ones((T, T), dtype=bool))
    w = jnp.where(mask[None], ws[:, :T, :T], 0.0)
    vc = vn.reshape(bsz, nc, T, GM_GROUPS, GM_GROUP_DIM)
    bias = jnp.transpose(bs[:, :T])
    mixed = jnp.einsum('gts,bnsgc->bntgc', w, vc) + bias[None, None, :, :, None]
    return u * mixed.reshape(bsz, L, GM_WIDTH), vn


def _trunk(x, pe, conv_state, ssm_state, w, keep_v):
    new_conv, new_ssm, new_v = [], [], []
    o1 = D_INNER
    o2 = o1 + XBC_DIM
    o3 = o2 + SSD_HEADS
    o4 = o3 + 2 * GM_WIDTH
    for i in range(DEPTH):
        h = _rmsnorm(x, w['ffn1_norm'][i])
        x = x + 0.5 * _swiglu(h, w['ffn1_w_gate'][i], w['ffn1_w_up'][i], w['ffn1_w_down'][i])
        h = _rmsnorm(x, w['mix_norm'][i])
        proj = h @ w['w_in'][i]
        z, xbc, dt_raw = proj[..., :o1], proj[..., o1:o2], proj[..., o2:o3]
        uv, gates = proj[..., o3:o4], proj[..., o4:]
        ya, buf, hs = _ssd_branch(z, xbc, dt_raw, conv_state[i], ssm_state[i], w['conv_w'][i], w['conv_b'][i],
                                  w['dt_bias'][i], w['a_log'][i], w['d_skip'][i], w['ssd_norm'][i])
        yb, vn = _gmlp_branch(uv, w['gm_ln_g'][i], w['gm_ln_b'][i], w['gm_ws'][i], w['gm_bs'][i])
        ga = jax.nn.sigmoid(gates[..., :D_MODEL])
        gb = jax.nn.sigmoid(gates[..., D_MODEL:])
        merged = ga * (ya @ w['w_branch_ssd'][i]) + gb * (yb @ w['w_branch_gmlp'][i])
        x = x + merged @ w['w_out'][i]
        h = _rmsnorm(x, w['ffn2_norm'][i])
        x = x + 0.5 * _swiglu(h, w['ffn2_w_gate'][i], w['ffn2_w_up'][i], w['ffn2_w_down'][i])
        h = _rmsnorm(x, w['ple_norm'][i])
        x = x + (pe[i] @ w['ple_w_proj'][i]) * jax.nn.sigmoid(h @ w['ple_w_gate'][i])
        new_conv.append(buf)
        new_ssm.append(hs)
        if keep_v:
            new_v.append(vn)
    y = _rmsnorm(x, w['final_norm'])
    v_out = jnp.stack(new_v) if keep_v else None
    return y, jnp.stack(new_conv), jnp.stack(new_ssm), v_out


def setup_inputs(seed: int = 0) -> dict:
    key = jax.random.key(seed)
    ks = list(jax.random.split(key, 48))
    cnt = [0]

    def nk():
        k = ks[cnt[0]]
        cnt[0] += 1
        return k

    def nrm(shape, scale):
        return scale * jax.random.normal(nk(), shape, jnp.float32)

    def gain(shape):
        return 1.0 + 0.05 * jax.random.normal(nk(), shape, jnp.float32)

    u = jax.random.uniform(nk(), (DEPTH, SSD_HEADS), jnp.float32)
    dt0 = jnp.exp(u * (math.log(0.1) - math.log(1e-3)) + math.log(1e-3))
    dt_bias = dt0 + jnp.log(-jnp.expm1(-dt0))
    a_log = jnp.log(jax.random.uniform(nk(), (DEPTH, SSD_HEADS), jnp.float32, minval=1.0, maxval=16.0))
    return {
        'x_prompt': nrm((BATCH, SEQ, D_MODEL), 1.0),
        'x_sample': nrm((DEC_BATCH, DEC_SEQ, D_MODEL), 1.0),
        'p_prompt': nrm((DEPTH, BATCH, SEQ, PLE_DIM), 1.0),
        'p_sample': nrm((DEPTH, DEC_BATCH, DEC_SEQ, PLE_DIM), 1.0),
        'state_conv': nrm((DEPTH, DEC_BATCH, CONV_W - 1, XBC_DIM), 1.0),
        'state_ssm': nrm((DEPTH, DEC_BATCH, SSD_HEADS, SSD_HEAD_DIM, D_STATE), 0.1),
        'ffn1_norm': gain((DEPTH, D_MODEL)),
        'ffn1_w_gate': nrm((DEPTH, D_MODEL, D_FF), D_MODEL ** -0.5),
        'ffn1_w_up': nrm((DEPTH, D_MODEL, D_FF), D_MODEL ** -0.5),
        'ffn1_w_down': nrm((DEPTH, D_FF, D_MODEL), D_FF ** -0.5),
        'mix_norm': gain((DEPTH, D_MODEL)),
        'w_in': nrm((DEPTH, D_MODEL, IN_COLS), D_MODEL ** -0.5),
        'conv_w': nrm((DEPTH, CONV_W, XBC_DIM), CONV_W ** -0.5),
        'conv_b': nrm((DEPTH, XBC_DIM), 0.01),
        'dt_bias': dt_bias,
        'a_log': a_log,
        'd_skip': gain((DEPTH, SSD_HEADS)),
        'ssd_norm': gain((DEPTH, D_INNER)),
        'gm_ln_g': gain((DEPTH, GM_WIDTH)),
        'gm_ln_b': nrm((DEPTH, GM_WIDTH), 0.01),
        'gm_ws': nrm((DEPTH, GM_GROUPS, GM_CHUNK, GM_CHUNK), GM_CHUNK ** -0.5),
        'gm_bs': gain((DEPTH, GM_GROUPS, GM_CHUNK)),
        'w_branch_ssd': nrm((DEPTH, D_INNER, D_MODEL), D_INNER ** -0.5),
        'w_branch_gmlp': nrm((DEPTH, GM_WIDTH, D_MODEL), GM_WIDTH ** -0.5),
        'w_out': nrm((DEPTH, D_MODEL, D_MODEL), D_MODEL ** -0.5),
        'ffn2_norm': gain((DEPTH, D_MODEL)),
        'ffn2_w_gate': nrm((DEPTH, D_MODEL, D_FF), D_MODEL ** -0.5),
        'ffn2_w_up': nrm((DEPTH, D_MODEL, D_FF), D_MODEL ** -0.5),
        'ffn2_w_down': nrm((DEPTH, D_FF, D_MODEL), D_FF ** -0.5),
        'ple_norm': gain((DEPTH, D_MODEL)),
        'ple_w_gate': nrm((DEPTH, D_MODEL, D_MODEL), D_MODEL ** -0.5),
        'ple_w_proj': nrm((DEPTH, PLE_DIM, D_MODEL), PLE_DIM ** -0.5),
        'final_norm': gain((D_MODEL,)),
    }


def reference(x_prompt, x_sample, p_prompt, p_sample, state_conv, state_ssm,
              ffn1_norm, ffn1_w_gate, ffn1_w_up, ffn1_w_down,
              mix_norm, w_in, conv_w, conv_b, dt_bias, a_log, d_skip, ssd_norm,
              gm_ln_g, gm_ln_b, gm_ws, gm_bs,
              w_branch_ssd, w_branch_gmlp, w_out,
              ffn2_norm, ffn2_w_gate, ffn2_w_up, ffn2_w_down,
              ple_norm, ple_w_gate, ple_w_proj, final_norm):
    w = {
        'ffn1_norm': ffn1_norm, 'ffn1_w_gate': ffn1_w_gate, 'ffn1_w_up': ffn1_w_up, 'ffn1_w_down': ffn1_w_down,
        'mix_norm': mix_norm, 'w_in': w_in, 'conv_w': conv_w, 'conv_b': conv_b,
        'dt_bias': dt_bias, 'a_log': a_log, 'd_skip': d_skip, 'ssd_norm': ssd_norm,
        'gm_ln_g': gm_ln_g, 'gm_ln_b': gm_ln_b, 'gm_ws': gm_ws, 'gm_bs': gm_bs,
        'w_branch_ssd': w_branch_ssd, 'w_branch_gmlp': w_branch_gmlp, 'w_out': w_out,
        'ffn2_norm': ffn2_norm, 'ffn2_w_gate': ffn2_w_gate, 'ffn2_w_up': ffn2_w_up, 'ffn2_w_down': ffn2_w_down,
        'ple_norm': ple_norm, 'ple_w_gate': ple_w_gate, 'ple_w_proj': ple_w_proj, 'final_norm': final_norm,
    }
    bp = x_prompt.shape[0]
    conv0 = jnp.zeros((DEPTH, bp, CONV_W - 1, XBC_DIM), x_prompt.dtype)
    ssm0 = jnp.zeros((DEPTH, bp, SSD_HEADS, SSD_HEAD_DIM, D_STATE), jnp.float32)
    y_prompt, conv_prompt, ssm_prompt, _ = _trunk(x_prompt, p_prompt, conv0, ssm0, w, False)
    y_sample, conv_sample, ssm_sample, gmlp_v_sample = _trunk(x_sample, p_sample, state_conv, state_ssm, w, True)
    return (y_prompt, y_sample, ssm_prompt, conv_prompt, ssm_sample, conv_sample, gmlp_v_sample)
```

```cpp
#include <hip/hip_runtime.h>
#include <cstdio>
#include <cstdint>

namespace pg8 {
#define PG8_LAS __attribute__((address_space(3)))
typedef unsigned short bf16_t;
typedef short bf16x8 __attribute__((ext_vector_type(8)));
typedef float f32x4 __attribute__((ext_vector_type(4)));
typedef float f32x2 __attribute__((ext_vector_type(2)));
typedef unsigned u32x4 __attribute__((ext_vector_type(4)));
typedef unsigned u32x2 __attribute__((ext_vector_type(2)));
constexpr int BM = 256, BK = 64, HALF = 128, HTB = HALF * BK * 2  , STAGE_BYTES = 8 * HTB, NXCD = 8, WGM = 8;

__host__ __device__ __forceinline__ int lds_byte(int r, int c) { const int st = (r >> 4) * 2 + (c >> 5), rr = r & 15, cc = c & 31, ob = rr * 64 + cc * 2; return st * 1024 + (ob ^ (((ob >> 9) & 1) << 5)); }
__host__ __device__ __forceinline__ void stage_rc(int b, int& R, int& C) { const int st = b / 1024, sb = b % 1024, swz = sb ^ (((sb >> 9) & 1) << 5); R = (st >> 1) * 16 + swz / 64; C = (st & 1) * 32 + (swz % 64) / 2; }
__host__ __device__ __forceinline__ int perm32(int rho) { const int n = rho >> 4, i = rho & 15; return 8 * (i >> 2) + 4 * n + (i & 3); }

struct Unit { int pm, pn, kt0, ktn, slice; };
struct Gemm { const bf16_t* A; const bf16_t* Bt; int lda, ldb, M, N, K; };

struct StaticOrder {
    int nM, nN, nwg, G, c, ntk, wgm, pmb;
    __host__ __device__ __forceinline__ void init(int M, int N, int K, int G_, int c_, int wgm_ = WGM, int pmb_ = 0) { nM = M / BM; nN = N / BM; nwg = nM * nN; G = G_; c = c_; ntk = K / BK; wgm = wgm_; pmb = pmb_; }
    __host__ __device__ __forceinline__ void tile_of(int L, int& pm, int& pn) const {
        int wgid = L; { const int q = nwg / NXCD, r = nwg % NXCD, xcd = wgid % NXCD, off = wgid / NXCD; wgid = (xcd < r ? xcd * (q + 1) : r * (q + 1) + (xcd - r) * q) + off; }
        const int nig = wgm * nN, gid = wgid / nig, fm = gid * wgm, gsz = (nM - fm) < wgm ? (nM - fm) : wgm;
        pm = pmb + fm + ((wgid % nig) % gsz); pn = (wgid % nig) / gsz;
    }
    __host__ __device__ __forceinline__ bool next(int i, Unit& u) const {
        const long L = (long)i * G + c; const bool ok = L < nwg;
        int pm, pn; tile_of(ok ? (int)L : 0, pm, pn);
        u.pm = pm; u.pn = pn; u.kt0 = 0; u.ktn = ntk; u.slice = -1; return ok;
    }
    __device__ __forceinline__ void a_ready(const Unit&) const {}
    __device__ __forceinline__ void done(const Unit&) const {}
};
struct TailSplitOrder : StaticOrder {
    int nmain, ntail, pm0;
    __host__ __device__ __forceinline__ void init(int M_main, int M_tail, int pmt, int N, int K, int G_, int c_, int wgm_ = WGM, int pmb_ = 0) { StaticOrder::init(M_main, N, K, G_, c_, wgm_, pmb_); nmain = nwg; pm0 = pmt; ntail = M_tail / BM * nN * 8; }
    __host__ __device__ __forceinline__ bool next(int i, Unit& u) const {
        const long L = (long)i * G + c; const bool is_main = L < nmain; const long ti = L - nmain; const bool ok = is_main || ti < ntail;
        int pm, pn; tile_of(is_main ? (int)L : 0, pm, pn);
        const int idx = (!is_main && ok) ? (int)ti : 0, tl = idx >> 3, sl = idx & 7, half = ntk >> 1, q = half >> 3, r = half & 7;
        u.pm = is_main ? pm : pm0 + tl / nN; u.pn = is_main ? pn : tl % nN;
        u.kt0 = is_main ? 0 : 2 * (sl * q + (sl < r ? sl : r)); u.ktn = is_main ? ntk : 2 * (q + (sl < r ? 1 : 0)); u.slice = is_main ? -1 : sl; return ok;
    }
};

typedef __bf16 bf16x2_hw __attribute__((ext_vector_type(2)));
__device__ __forceinline__ unsigned cvt_pk_bf16(float lo, float hi) { const f32x2 v = {lo, hi}; const bf16x2_hw b = __builtin_convertvector(v, bf16x2_hw); return __builtin_bit_cast(unsigned, b); }

template <class Epi, class Sched, bool ALIGN_EPI = false, bool SP2 = false>
__device__ __forceinline__ void gemm_phase(PG8_LAS unsigned char* lds, const Gemm g, const Sched& S, const Epi& E, const int wid  ) {
    int lane = (int)__builtin_amdgcn_mbcnt_hi(~0u, __builtin_amdgcn_mbcnt_lo(~0u, 0u)); asm volatile("" : "+v"(lane));
    const int tid = wid * 64 + lane, wr = wid >> 2, wc = wid & 3, fr = lane & 15, fq = lane >> 4;
    unsigned voffA[2], voffB[2];
#pragma unroll
    for (int i = 0; i < 2; ++i) { int R, C; stage_rc(tid * 16 + i * 8192, R, C); const int Rb = Epi::PERM ? ((R & ~31) + perm32(R & 31)) : R;
        voffA[i] = (unsigned)(R * g.lda + C) * 2u; voffB[i] = (unsigned)(Rb * g.ldb + C) * 2u; }
    const size_t kstep = (size_t)(BK * 2);
    const size_t hsA = (size_t)HALF * g.lda * 2, hsB = (size_t)HALF * g.ldb * 2;
    const size_t tsA = 2 * hsA, tsB = 2 * hsB;
    const unsigned ldsw = (unsigned)wid * 1024u;
    const int aoff = lds_byte(wr * 64 + fr, fq * 8), boff = lds_byte(wc * 32 + fr, fq * 8);
#define PG8_SA(b, h) (((b) * 2 + (h)) * HTB)
#define PG8_SB(b, h) ((4 + (b) * 2 + (h)) * HTB)
#define PG8_STAGE(bufoff, gbase, voff) do { _Pragma("unroll") for (int _i = 0; _i < 2; ++_i) \
        __builtin_amdgcn_global_load_lds((const unsigned*)((const char*)(gbase) + (voff)[_i]), (PG8_LAS unsigned*)(lds + (bufoff) + ldsw + _i * 8192), 16, 0, 0); } while (0)
#define PG8_LDA(dst, b, h) do { _Pragma("unroll") for (int m = 0; m < 4; ++m) _Pragma("unroll") for (int k = 0; k < 2; ++k) dst[m][k] = *(const PG8_LAS bf16x8*)(lds + PG8_SA(b, h) + aoff + m * 2048 + k * 1024); } while (0)
#define PG8_LDB(dst, b, h) do { _Pragma("unroll") for (int n = 0; n < 2; ++n) _Pragma("unroll") for (int k = 0; k < 2; ++k) dst[n][k] = *(const PG8_LAS bf16x8*)(lds + PG8_SB(b, h) + boff + n * 2048 + k * 1024); } while (0)
#define PG8_MMA(ai, bj, At, Bt) do { __builtin_amdgcn_s_setprio(1); _Pragma("unroll") for (int m = 0; m < 4; ++m) _Pragma("unroll") for (int n = 0; n < 2; ++n) _Pragma("unroll") for (int k = 0; k < 2; ++k) \
        acc[ai][bj][m][n] = __builtin_amdgcn_mfma_f32_16x16x32_bf16(Bt[n][k], At[m][k], acc[ai][bj][m][n], 0, 0, 0); __builtin_amdgcn_s_setprio(0); } while (0)
#define PG8_WAIT_V(n) asm volatile("s_waitcnt vmcnt(" #n ")" ::: "memory")
#define PG8_WAIT_L(n) asm volatile("s_waitcnt lgkmcnt(" #n ")" ::: "memory")
#define PG8_BAR __builtin_amdgcn_s_barrier()
#define PG8_SCHED __builtin_amdgcn_sched_barrier(0)
    Unit cur, nxt; int ui = 0;
    if (!S.next(0, cur)) return;
    f32x4 acc[2][2][4][2];
#pragma unroll
    for (int a = 0; a < 2; ++a)
#pragma unroll
        for (int b = 0; b < 2; ++b)
#pragma unroll
            for (int m = 0; m < 4; ++m)
#pragma unroll
                for (int n = 0; n < 2; ++n) acc[a][b][m][n] = (f32x4){0.f, 0.f, 0.f, 0.f};
    bf16x8 At[4][2], B0[2][2], B1[2][2];
    const char* cA = (const char*)g.A + (size_t)cur.pm * tsA + (size_t)cur.kt0 * kstep; const char* cB = (const char*)g.Bt + (size_t)cur.pn * tsB + (size_t)cur.kt0 * kstep;
    S.a_ready(cur);
    if constexpr (SP2) {
        PG8_STAGE(PG8_SB(0, 0), cB, voffB); PG8_STAGE(PG8_SB(0, 1), cB + hsB, voffB); PG8_STAGE(PG8_SA(0, 0), cA, voffA); PG8_STAGE(PG8_SA(0, 1), cA + hsA, voffA);
        if (wr == 1) PG8_BAR;
        PG8_WAIT_V(2); PG8_BAR;
        PG8_STAGE(PG8_SB(1, 0), cB + kstep, voffB); PG8_STAGE(PG8_SA(1, 0), cA + kstep, voffA); PG8_STAGE(PG8_SB(1, 1), cB + hsB + kstep, voffB);
        PG8_WAIT_V(6); PG8_BAR;
    } else {
        PG8_STAGE(PG8_SB(0, 0), cB, voffB); PG8_STAGE(PG8_SA(0, 0), cA, voffA); PG8_STAGE(PG8_SB(0, 1), cB + hsB, voffB); PG8_STAGE(PG8_SA(0, 1), cA + hsA, voffA);
        if (wr == 1) PG8_BAR;
        PG8_WAIT_V(4); PG8_BAR;
        PG8_STAGE(PG8_SB(1, 0), cB + kstep, voffB); PG8_STAGE(PG8_SA(1, 0), cA + kstep, voffA); PG8_STAGE(PG8_SB(1, 1), cB + hsB + kstep, voffB);
        PG8_WAIT_V(6); PG8_BAR;
    }
    for (;;) {
        const bool has_next = S.next(ui + 1, nxt); const int nt = cur.ktn;
        const char* nA = has_next ? (const char*)g.A + (size_t)nxt.pm * tsA + (size_t)nxt.kt0 * kstep : cA; const char* nB = has_next ? (const char*)g.Bt + (size_t)nxt.pn * tsB + (size_t)nxt.kt0 * kstep : cB;
        for (int t = 0; t < nt; t += 2) {
            const bool last = (t == nt - 2);
            const char* a1 = cA + (size_t)(t + 1) * kstep;
            const char* a2 = last ? nA : cA + (size_t)(t + 2) * kstep; const char* b2 = last ? nB : cB + (size_t)(t + 2) * kstep;
            const char* a3 = a2 + kstep; const char* b3 = b2 + kstep;
            if (last && has_next) S.a_ready(nxt);
            if constexpr (SP2) {
            PG8_LDB(B0, 0, 0); PG8_LDB(B1, 0, 1); PG8_SCHED; PG8_LDA(At, 0, 0); PG8_STAGE(PG8_SA(1, 1), a1 + hsA, voffA);
            PG8_WAIT_V(8); PG8_WAIT_L(0); PG8_BAR; PG8_MMA(0, 0, At, B0); PG8_MMA(0, 1, At, B1); PG8_BAR; PG8_SCHED;
            PG8_LDA(At, 0, 1); PG8_STAGE(PG8_SB(0, 0), b2, voffB); PG8_STAGE(PG8_SB(0, 1), b2 + hsB, voffB); PG8_STAGE(PG8_SA(0, 0), a2, voffA);
            PG8_WAIT_V(8); PG8_WAIT_L(0); PG8_BAR; PG8_MMA(1, 0, At, B0); PG8_MMA(1, 1, At, B1); PG8_BAR; PG8_SCHED;
            PG8_LDB(B0, 1, 0); PG8_LDB(B1, 1, 1); PG8_SCHED; PG8_LDA(At, 1, 0); PG8_STAGE(PG8_SA(0, 1), a2 + hsA, voffA);
            PG8_WAIT_V(8); PG8_WAIT_L(0); PG8_BAR; PG8_MMA(0, 0, At, B0); PG8_MMA(0, 1, At, B1); PG8_BAR; PG8_SCHED;
            PG8_LDA(At, 1, 1); PG8_STAGE(PG8_SB(1, 0), b3, voffB); PG8_STAGE(PG8_SB(1, 1), b3 + hsB, voffB); PG8_STAGE(PG8_SA(1, 0), a3, voffA);
            PG8_WAIT_V(8); PG8_WAIT_L(0); PG8_BAR; PG8_MMA(1, 0, At, B0); PG8_MMA(1, 1, At, B1); PG8_BAR; PG8_SCHED;
            } else {
            PG8_LDB(B0, 0, 0); PG8_SCHED; PG8_LDA(At, 0, 0); PG8_STAGE(PG8_SA(1, 1), a1 + hsA, voffA);
            PG8_WAIT_L(8); PG8_BAR; PG8_WAIT_L(0); PG8_MMA(0, 0, At, B0); PG8_BAR; PG8_SCHED;
            PG8_LDB(B1, 0, 1); PG8_STAGE(PG8_SB(0, 0), b2, voffB);
            PG8_BAR; PG8_WAIT_L(0); PG8_MMA(0, 1, At, B1); PG8_BAR;
            PG8_LDA(At, 0, 1); PG8_STAGE(PG8_SA(0, 0), a2, voffA);
            PG8_BAR; PG8_WAIT_L(0); PG8_MMA(1, 0, At, B0); PG8_BAR; PG8_SCHED;
            PG8_STAGE(PG8_SB(0, 1), b2 + hsB, voffB);
            PG8_WAIT_V(6); PG8_BAR; PG8_MMA(1, 1, At, B1); PG8_BAR;
            PG8_LDB(B0, 1, 0); PG8_SCHED; PG8_LDA(At, 1, 0); PG8_STAGE(PG8_SA(0, 1), a2 + hsA, voffA);
            PG8_WAIT_L(8); PG8_BAR; PG8_WAIT_L(0); PG8_MMA(0, 0, At, B0); PG8_BAR; PG8_SCHED;
            PG8_LDB(B1, 1, 1); PG8_STAGE(PG8_SB(1, 0), b3, voffB);
            PG8_BAR; PG8_WAIT_L(0); PG8_MMA(0, 1, At, B1); PG8_BAR;
            PG8_LDA(At, 1, 1); PG8_STAGE(PG8_SA(1, 0), a3, voffA);
            PG8_BAR; PG8_WAIT_L(0); PG8_MMA(1, 0, At, B0); PG8_BAR; PG8_SCHED;
            PG8_STAGE(PG8_SB(1, 1), b3 + hsB, voffB);
            PG8_WAIT_V(6); PG8_BAR; PG8_MMA(1, 1, At, B1); PG8_BAR;
            }
        }
        if constexpr (ALIGN_EPI) { if (wr == 0) PG8_BAR; }
        E(acc, cur, wr, wc, fr, fq); S.done(cur);
        if (!has_next) break;
#pragma unroll
        for (int a = 0; a < 2; ++a)
#pragma unroll
            for (int b = 0; b < 2; ++b)
#pragma unroll
                for (int m = 0; m < 4; ++m)
#pragma unroll
                    for (int n = 0; n < 2; ++n) acc[a][b][m][n] = (f32x4){0.f, 0.f, 0.f, 0.f};
        cur = nxt; cA = nA; cB = nB; ++ui;
        if constexpr (ALIGN_EPI) { if (wr == 1) PG8_BAR; }
    }
    PG8_WAIT_V(0);
    if constexpr (!ALIGN_EPI) { if (wr == 0) PG8_BAR; }
    PG8_BAR;
#undef PG8_SA
#undef PG8_SB
#undef PG8_STAGE
#undef PG8_LDA
#undef PG8_LDB
#undef PG8_MMA
#undef PG8_WAIT_V
#undef PG8_WAIT_L
#undef PG8_BAR
#undef PG8_SCHED
}
}

constexpr int D = 2048, SEQ = 8192, NB_P = 4, NB_S = 16, L_S = 64, DEPTH = 2;
constexpr int M_P = NB_P * SEQ;
constexpr int M_TOK = M_P + NB_S * L_S;
constexpr int FF = 5632, FF2 = 2 * FF;
constexpr int NH = 32, HD = 64, NG = 4, NS = 128, XBC = 3072, DIN = 2048;
constexpr int GMW = 1024, PLE = 256, INC = 11296;
constexpr int NIN = 11520;
constexpr int LDP = 11520;
constexpr int LDH = 2048, LDF = 5632, LDE = 256;
constexpr int KP_D = 2048, KP_F = 5632, KP_G = 1024, KP_E = 256;
constexpr int PC_Z = 0, PC_XBC = 2048, PC_U = 5120, PC_V = 6144, PC_GA = 7168, PC_GB = 9216, PC_DT = 11264;
constexpr int PC_MRG = 2048;
constexpr int PC_TMP = 0;
constexpr float EPS = 1e-6f;

typedef unsigned short bf16;
typedef pg8::f32x4 f32x4;
typedef pg8::f32x2 f32x2;
typedef pg8::u32x4 u32x4;
typedef pg8::u32x2 u32x2;
#define LAS __attribute__((address_space(3)))

__device__ __forceinline__ float bf2f(bf16 b) { return __uint_as_float(((unsigned)b) << 16); }
__device__ __forceinline__ float bflo(unsigned w) { return __uint_as_float(w << 16); }
__device__ __forceinline__ float bfhi(unsigned w) { return __uint_as_float(w & 0xffff0000u); }
__device__ __forceinline__ bf16 f2bf(float f) { return (bf16)(pg8::cvt_pk_bf16(f, 0.f) & 0xffffu); }
__device__ __forceinline__ unsigned pk2(float lo, float hi) { return pg8::cvt_pk_bf16(lo, hi); }
__device__ __forceinline__ float fast_sigmoid(float x) { return __builtin_amdgcn_rcpf(1.f + __builtin_amdgcn_exp2f(-1.4426950409f * x)); }
__device__ __forceinline__ float fast_silu(float x) { return x * fast_sigmoid(x); }
__device__ __forceinline__ float fast_gelu_tanh(float x) { const float y = 0.7978845608f * (x + 0.044715f * x * x * x); return x * fast_sigmoid(2.f * y); }
__device__ __forceinline__ float softplus_f(float x) { return x > 20.f ? x : log1pf(expf(x)); }

using pg8::Unit;
struct EpiGU {
    static constexpr bool PERM = false;
    bf16* O; int ldc; const float* RS;
    mutable int pmc; mutable float rs[2][4];
    __device__ __forceinline__ void operator()(const f32x4 (&acc)[2][2][4][2], const Unit& u, int wr, int wc, int fr, int fq) const {
        const int row0 = u.pm * 256 + wr * 64 + fr, col0 = u.pn * 128 + wc * 32 + 8 * fq;
        if (pmc != u.pm + 1) { pmc = u.pm + 1;
#pragma unroll
            for (int ai = 0; ai < 2; ++ai)
#pragma unroll
                for (int m = 0; m < 4; ++m) rs[ai][m] = RS[row0 + ai * 128 + m * 16]; }
#pragma unroll
        for (int ai = 0; ai < 2; ++ai)
#pragma unroll
            for (int m = 0; m < 4; ++m) { bf16* rowp = O + (size_t)(row0 + ai * 128 + m * 16) * ldc + col0;
                const float rl = -1.4426950409f * rs[ai][m], r2 = rs[ai][m] * rs[ai][m];
                const f32x4 g0 = acc[ai][0][m][0], u0 = acc[ai][0][m][1], g1 = acc[ai][1][m][0], u1 = acc[ai][1][m][1];
                const f32x4 p0 = g0 * u0 * r2, p1 = g1 * u1 * r2, e0 = g0 * rl, e1 = g1 * rl;
                float o[8];
#pragma unroll
                for (int j = 0; j < 4; ++j) { o[j] = p0[j] * __builtin_amdgcn_rcpf(1.f + __builtin_amdgcn_exp2f(e0[j])); o[4 + j] = p1[j] * __builtin_amdgcn_rcpf(1.f + __builtin_amdgcn_exp2f(e1[j])); }
                u32x4 w; w.x = pk2(o[0], o[1]); w.y = pk2(o[2], o[3]); w.z = pk2(o[4], o[5]); w.w = pk2(o[6], o[7]);
                *(u32x4*)rowp = w; }
    }
};
__device__ __forceinline__ float ssq8(const f32x4 a, const f32x4 b) { return ((a[0] * a[0] + a[1] * a[1]) + (a[2] * a[2] + a[3] * a[3])) + ((b[0] * b[0] + b[1] * b[1]) + (b[2] * b[2] + b[3] * b[3])); }
__device__ __forceinline__ void ssq_emit(float* SSQ, float s, int plane, int row, int fq) { s += __shfl_xor(s, 16); s += __shfl_xor(s, 32); if (fq == 0) SSQ[(size_t)plane * M_TOK + row] = s; }
constexpr int XBP = D;
__device__ __forceinline__ void unpack8(const u32x4 w, f32x4& lo, f32x4& hi) { lo = (f32x4){bflo(w.x), bfhi(w.x), bflo(w.y), bfhi(w.y)}; hi = (f32x4){bflo(w.z), bfhi(w.z), bflo(w.w), bfhi(w.w)}; }
__device__ __forceinline__ u32x4 pack8u(const f32x4 lo, const f32x4 hi) { return (u32x4){pk2(lo[0], lo[1]), pk2(lo[2], lo[3]), pk2(hi[0], hi[1]), pk2(hi[2], hi[3])}; }
template <bool SRC_F32> struct EpiRes {
    static constexpr bool PERM = true;
    const float* rlo; const float* rhi; bf16* XB; int split; float alpha; float* part; float* SSQ;
    __device__ __forceinline__ void operator()(const f32x4 (&acc)[2][2][4][2], const Unit& u, int wr, int wc, int fr, int fq) const {
        const int row0 = u.pm * 256 + wr * 64 + fr, col0 = u.pn * 256 + wc * 32 + 8 * fq;
        if (u.slice >= 0) {
#pragma unroll
            for (int ai = 0; ai < 2; ++ai)
#pragma unroll
                for (int m = 0; m < 4; ++m) { float* pp = part + ((size_t)u.slice * (M_TOK - M_P) + (size_t)(row0 + ai * 128 + m * 16 - split)) * D + col0;
#pragma unroll
                    for (int bj = 0; bj < 2; ++bj) { *(f32x4*)(pp + bj * 128) = alpha * acc[ai][bj][m][0]; *(f32x4*)(pp + bj * 128 + 4) = alpha * acc[ai][bj][m][1]; } }
            return;
        }
#pragma unroll
        for (int ai = 0; ai < 2; ++ai) {
            f32x4 r0[4][2], r1[4][2];
#pragma unroll
            for (int m = 0; m < 4; ++m) { const int r = row0 + ai * 128 + m * 16;
#pragma unroll
                for (int bj = 0; bj < 2; ++bj) {
                    if (SRC_F32) { const float* rp = (r < split ? rlo + (size_t)r * D : rhi + (size_t)(r - split) * D) + col0 + bj * 128; r0[m][bj] = *(const f32x4*)rp; r1[m][bj] = *(const f32x4*)(rp + 4); }
                    else unpack8(*(const u32x4*)(XB + (size_t)r * XBP + col0 + bj * 128), r0[m][bj], r1[m][bj]); } }
#pragma unroll
            for (int m = 0; m < 4; ++m) { bf16* xp = XB + (size_t)(row0 + ai * 128 + m * 16) * XBP + col0; float sq = 0.f;
#pragma unroll
                for (int bj = 0; bj < 2; ++bj) { const f32x4 x0 = r0[m][bj] + alpha * acc[ai][bj][m][0], x1 = r1[m][bj] + alpha * acc[ai][bj][m][1]; sq += ssq8(x0, x1); *(u32x4*)(xp + bj * 128) = pack8u(x0, x1); }
                ssq_emit(SSQ, sq, u.pn * 4 + wc, row0 + ai * 128 + m * 16, fq); }
            asm volatile("" ::: "memory"); }
    }
};
struct EpiInProj {
    static constexpr bool PERM = true;
    bf16* P; float* DT; const float* dt_bias; const float* RS;
    mutable int pmc; mutable float rsc[2][4];
    __device__ __forceinline__ void operator()(const f32x4 (&acc)[2][2][4][2], const Unit& u, int wr, int wc, int fr, int fq) const {
        const int row0 = u.pm * 256 + wr * 64 + fr, col0 = u.pn * 256 + wc * 32 + 8 * fq;
        const int mode = u.pn < 8 ? 0 : u.pn < 20 ? 1 : u.pn < 28 ? 2 : u.pn < 44 ? 3 : 4;
        if (pmc != u.pm + 1) { pmc = u.pm + 1;
#pragma unroll
            for (int ai = 0; ai < 2; ++ai)
#pragma unroll
                for (int m = 0; m < 4; ++m) rsc[ai][m] = RS[row0 + ai * 128 + m * 16]; }
        if (mode == 4) {
            if (wc == 0) {
                const f32x4 b0 = *(const f32x4*)(dt_bias + 8 * fq), b1 = *(const f32x4*)(dt_bias + 8 * fq + 4);
#pragma unroll
                for (int ai = 0; ai < 2; ++ai)
#pragma unroll
                    for (int m = 0; m < 4; ++m) { float* dp = DT + (size_t)(row0 + ai * 128 + m * 16) * 32 + 8 * fq; const float rs = rsc[ai][m];
                        f32x4 v0 = acc[ai][0][m][0] * rs + b0, v1 = acc[ai][0][m][1] * rs + b1;
#pragma unroll
                        for (int j = 0; j < 4; ++j) { v0[j] = softplus_f(v0[j]); v1[j] = softplus_f(v1[j]); }
                        *(f32x4*)dp = v0; *(f32x4*)(dp + 4) = v1; }
            }
            return;
        }
#pragma unroll
        for (int ai = 0; ai < 2; ++ai)
#pragma unroll
            for (int m = 0; m < 4; ++m) { bf16* rowp = P + (size_t)(row0 + ai * 128 + m * 16) * LDP + col0; const float rs = rsc[ai][m];
#pragma unroll
                for (int bj = 0; bj < 2; ++bj) { f32x4 v0 = acc[ai][bj][m][0] * rs, v1 = acc[ai][bj][m][1] * rs;
                    if (mode == 0) {
#pragma unroll
                        for (int j = 0; j < 4; ++j) { v0[j] = fast_silu(v0[j]); v1[j] = fast_silu(v1[j]); } }
                    else if (mode == 2) {
#pragma unroll
                        for (int j = 0; j < 4; ++j) { v0[j] = fast_gelu_tanh(v0[j]); v1[j] = fast_gelu_tanh(v1[j]); } }
                    else if (mode == 3) {
#pragma unroll
                        for (int j = 0; j < 4; ++j) { v0[j] = fast_sigmoid(v0[j]); v1[j] = fast_sigmoid(v1[j]); } }
                    u32x4 w; w.x = pk2(v0[0], v0[1]); w.y = pk2(v0[2], v0[3]); w.z = pk2(v1[0], v1[1]); w.w = pk2(v1[2], v1[3]);
                    *(u32x4*)(rowp + bj * 128) = w; } }
    }
};
template <int MODE> struct EpiMerge {
    static constexpr bool PERM = true;
    const bf16* Gt; bf16* T;
    __device__ __forceinline__ void operator()(const f32x4 (&acc)[2][2][4][2], const Unit& u, int wr, int wc, int fr, int fq) const {
        const int row0 = u.pm * 256 + wr * 64 + fr, col0 = u.pn * 256 + wc * 32 + 8 * fq;
#pragma unroll
        for (int ai = 0; ai < 2; ++ai) {
            u32x4 gg[4][2], tt[4][2];
#pragma unroll
            for (int m = 0; m < 4; ++m) { const size_t ro = (size_t)(row0 + ai * 128 + m * 16) * LDP + col0;
#pragma unroll
                for (int bj = 0; bj < 2; ++bj) { gg[m][bj] = *(const u32x4*)(Gt + ro + bj * 128); if (MODE == 1) tt[m][bj] = *(const u32x4*)(T + ro + bj * 128); } }
#pragma unroll
            for (int m = 0; m < 4; ++m) { const size_t ro = (size_t)(row0 + ai * 128 + m * 16) * LDP + col0;
#pragma unroll
                for (int bj = 0; bj < 2; ++bj) { const u32x4 g4 = gg[m][bj];
                    f32x4 v0 = acc[ai][bj][m][0], v1 = acc[ai][bj][m][1];
                    v0[0] *= bflo(g4.x); v0[1] *= bfhi(g4.x); v0[2] *= bflo(g4.y); v0[3] *= bfhi(g4.y); v1[0] *= bflo(g4.z); v1[1] *= bfhi(g4.z); v1[2] *= bflo(g4.w); v1[3] *= bfhi(g4.w);
                    if (MODE == 1) { const u32x4 t4 = tt[m][bj];
                        v0[0] += bflo(t4.x); v0[1] += bfhi(t4.x); v0[2] += bflo(t4.y); v0[3] += bfhi(t4.y); v1[0] += bflo(t4.z); v1[1] += bfhi(t4.z); v1[2] += bflo(t4.w); v1[3] += bfhi(t4.w); }
                    u32x4 w; w.x = pk2(v0[0], v0[1]); w.y = pk2(v0[2], v0[3]); w.z = pk2(v1[0], v1[1]); w.w = pk2(v1[2], v1[3]);
                    *(u32x4*)(T + ro + bj * 128) = w; } }
            asm volatile("" ::: "memory"); }
    }
};
struct EpiPg {
    static constexpr bool PERM = true;
    bf16* T; const float* RS;
    __device__ __forceinline__ void operator()(const f32x4 (&acc)[2][2][4][2], const Unit& u, int wr, int wc, int fr, int fq) const {
        const int row0 = u.pm * 256 + wr * 64 + fr, col0 = u.pn * 256 + wc * 32 + 8 * fq;
#pragma unroll
        for (int ai = 0; ai < 2; ++ai)
#pragma unroll
            for (int m = 0; m < 4; ++m) { bf16* rowp = T + (size_t)(row0 + ai * 128 + m * 16) * LDP + col0; const float rs = RS[row0 + ai * 128 + m * 16];
#pragma unroll
                for (int bj = 0; bj < 2; ++bj) { f32x4 v0 = acc[ai][bj][m][0] * rs, v1 = acc[ai][bj][m][1] * rs;
#pragma unroll
                    for (int j = 0; j < 4; ++j) { v0[j] = fast_sigmoid(v0[j]); v1[j] = fast_sigmoid(v1[j]); }
                    *(u32x4*)(rowp + bj * 128) = pack8u(v0, v1); } }
    }
};
struct EpiPle {
    static constexpr bool PERM = true;
    const bf16* T; const bf16* XI; bf16* XB; float* SSQ;
    __device__ __forceinline__ void operator()(const f32x4 (&acc)[2][2][4][2], const Unit& u, int wr, int wc, int fr, int fq) const {
        const int row0 = u.pm * 256 + wr * 64 + fr, col0 = u.pn * 256 + wc * 32 + 8 * fq;
#pragma unroll
        for (int ai = 0; ai < 2; ++ai) {
            u32x4 tt[4][2], xx[4][2];
#pragma unroll
            for (int m = 0; m < 4; ++m) { const int r = row0 + ai * 128 + m * 16;
#pragma unroll
                for (int bj = 0; bj < 2; ++bj) { tt[m][bj] = *(const u32x4*)(T + (size_t)r * LDP + col0 + bj * 128); xx[m][bj] = *(const u32x4*)(XI + (size_t)r * XBP + col0 + bj * 128); } }
#pragma unroll
            for (int m = 0; m < 4; ++m) { bf16* xp = XB + (size_t)(row0 + ai * 128 + m * 16) * XBP + col0; float sq = 0.f;
#pragma unroll
                for (int bj = 0; bj < 2; ++bj) { f32x4 t0, t1, x0, x1; unpack8(tt[m][bj], t0, t1); unpack8(xx[m][bj], x0, x1);
                    x0 = x0 + acc[ai][bj][m][0] * t0; x1 = x1 + acc[ai][bj][m][1] * t1; sq += ssq8(x0, x1); *(u32x4*)(xp + bj * 128) = pack8u(x0, x1); }
                ssq_emit(SSQ, sq, u.pn * 4 + wc, row0 + ai * 128 + m * 16, fq); }
            asm volatile("" ::: "memory"); }
    }
};

#define XB_TMO      128
#define XB_XCNT(j)  (256  + 64 * (j))
#define XB_XSUB(j)  (1280 + 64 * (j))
#define XB_XGEN(j)  (2304 + 64 * (j))
#define XB_TOP      3328
#define XB_TOPGEN   3392
#define XCD_BAR_WORDS 3456
#define XB_SPIN_CAP (1u << 18)

__device__ __forceinline__ unsigned xb_ld(unsigned* p)              { return __hip_atomic_load(p, __ATOMIC_RELAXED, __HIP_MEMORY_SCOPE_AGENT); }
__device__ __forceinline__ unsigned xb_add(unsigned* p, unsigned v) { return __hip_atomic_fetch_add(p, v, __ATOMIC_RELAXED, __HIP_MEMORY_SCOPE_AGENT); }
__device__ __forceinline__ unsigned xb_xcc_id() { return (unsigned)__builtin_amdgcn_s_getreg((3 << 11) | 20) & 0xFu; }
#define XB_SPIN(cond, bar) do { unsigned _sp = 0; while (cond) { __builtin_amdgcn_s_sleep(1); \
    if ((++_sp & 255u) == 0u) { if (xb_ld(&(bar)[XB_TMO])) break; if (_sp > XB_SPIN_CAP) { atomicAdd(&(bar)[XB_TMO], 1u); break; } } } } while (0)

__device__ __forceinline__ unsigned xb_lane() { return __builtin_amdgcn_mbcnt_hi(~0u, __builtin_amdgcn_mbcnt_lo(~0u, 0u)); }
struct XcdBarrier {
    unsigned* bar; unsigned x; unsigned w0;
    volatile LAS unsigned* st;
};

__device__ __forceinline__ XcdBarrier xcd_barrier_post(unsigned* bar, volatile LAS unsigned* st, unsigned w0) {
    XcdBarrier b; b.bar = bar; b.x = xb_xcc_id(); b.st = st; b.w0 = w0;
    if (w0 == 0u && xb_lane() == 0u) (void)xb_add(&bar[XB_XCNT(b.x)], 1u);
    return b;
}
__device__ __forceinline__ void xcd_barrier_complete(unsigned* bar, unsigned x, unsigned& nloc, unsigned& nx) {
    const unsigned G = gridDim.x * gridDim.y * gridDim.z;
    unsigned sum, cnt, mine, sp = 0u;
    for (;;) {
        sum = 0u; cnt = 0u; mine = 0u;
#pragma unroll
        for (unsigned j = 0; j < 16; ++j) { const unsigned c = xb_ld(&bar[XB_XCNT(j)]); sum += c; cnt += (c > 0u) ? 1u : 0u; mine = (j == x) ? c : mine; }
        if (sum == G) break;
        __builtin_amdgcn_s_sleep(1);
        if ((++sp & 255u) == 0u) { if (xb_ld(&bar[XB_TMO])) break; if (sp > XB_SPIN_CAP) { atomicAdd(&bar[XB_TMO], 1u); break; } }
    }
    nloc = mine > 0u ? mine : 1u; nx = cnt > 0u ? cnt : 1u;
}

__device__ __forceinline__ void xcd_barrier(const XcdBarrier& b) {
    asm volatile("s_waitcnt vmcnt(0)" ::: "memory");
    __syncthreads();
    if (b.w0 == 0u && xb_lane() == 0u) {
        unsigned* bar = b.bar;
        __builtin_amdgcn_s_waitcnt(0);
        unsigned nloc = b.st[0], nx = b.st[1];
        if (nloc == 0u) { xcd_barrier_complete(bar, b.x, nloc, nx); b.st[0] = nloc; b.st[1] = nx; }
        const unsigned old = xb_add(&bar[XB_XSUB(b.x)], 1u);
        const unsigned gen = old / nloc;
        if (old + 1u == (gen + 1u) * nloc) {
            __builtin_amdgcn_fence(__ATOMIC_RELEASE, "agent");
            asm volatile("s_waitcnt vmcnt(0)" ::: "memory");
            const unsigned og = xb_add(&bar[XB_TOP], 1u);
            const unsigned tg = og / nx;
            if (og + 1u == (tg + 1u) * nx) xb_add(&bar[XB_TOPGEN], 1u);
            else XB_SPIN(xb_ld(&bar[XB_TOPGEN]) == tg, bar);
            __builtin_amdgcn_fence(__ATOMIC_ACQUIRE, "agent");
            xb_add(&bar[XB_XGEN(b.x)], 1u);
            asm volatile("s_waitcnt vmcnt(0)" ::: "memory");
        } else {
            XB_SPIN(xb_ld(&bar[XB_XGEN(b.x)]) == gen, bar);
            __builtin_amdgcn_fence(__ATOMIC_ACQUIRE, "agent");
            asm volatile("s_waitcnt vmcnt(0)" ::: "memory");
        }
    }
    __syncthreads();
}

constexpr size_t MiB = 1u << 20;
constexpr size_t WS_CTL = 0, CTL_ZERO_BYTES = 1 * MiB;
constexpr int CW_BAR = 4096;
constexpr size_t WO_GU1 = 0;
constexpr size_t WO_D1  = WO_GU1 + (size_t)FF2 * KP_D;
constexpr size_t WO_IN  = WO_D1 + (size_t)D * KP_F;
constexpr size_t WO_A   = WO_IN + (size_t)NIN * KP_D;
constexpr size_t WO_B   = WO_A + (size_t)D * KP_D;
constexpr size_t WO_O   = WO_B + (size_t)D * KP_G;
constexpr size_t WO_GU2 = WO_O + (size_t)D * KP_D;
constexpr size_t WO_D2  = WO_GU2 + (size_t)FF2 * KP_D;
constexpr size_t WO_PG  = WO_D2 + (size_t)D * KP_F;
constexpr size_t WO_PP  = WO_PG + (size_t)D * KP_D;
constexpr size_t WO_WS  = WO_PP + (size_t)D * KP_E;
constexpr size_t WO_END = WO_WS + (size_t)8 * 128 * 128;
constexpr size_t WS_W   = 1 * MiB;
constexpr size_t WS_HB  = WS_W + ((WO_END * 2 + 255) / 256) * 256;
constexpr size_t WS_PB  = WS_HB + (size_t)M_TOK * LDH * 2;
constexpr size_t WS_PE  = WS_PB + (size_t)M_TOK * LDP * 2;
constexpr size_t WS_DT  = WS_PE + (size_t)M_TOK * LDE * 2;
constexpr size_t WS_SSQ = WS_DT;
constexpr size_t WS_PART = WS_DT + (size_t)M_TOK * NH * 4;
constexpr size_t WS_RS  = WS_PART + (size_t)8 * (M_TOK - M_P) * D * 4;
constexpr size_t WS_SQ  = WS_RS + (((size_t)M_TOK * 4 + 255) / 256) * 256;
constexpr size_t WS_END = WS_SQ + (size_t)32 * M_TOK * 4;

constexpr int RING_BYTES = 131072;
constexpr int LDS_BYTES = 147456;
constexpr int LDSCTL_OFF = LDS_BYTES - 256;
constexpr int NWAVES = 8, NTHREADS = 512;

constexpr size_t OUT_Y = 0;
constexpr size_t OUT_SSM_P = (size_t)M_TOK * D;
constexpr size_t OUT_CONV_P = OUT_SSM_P + (size_t)DEPTH * NB_P * NH * HD * NS;
constexpr size_t OUT_SSM_S = OUT_CONV_P + (size_t)DEPTH * NB_P * 3 * XBC;
constexpr size_t OUT_CONV_S = OUT_SSM_S + (size_t)DEPTH * NB_S * NH * HD * NS;
constexpr size_t OUT_GV = OUT_CONV_S + (size_t)DEPTH * NB_S * 3 * XBC;
constexpr size_t OUT_END = OUT_GV + (size_t)DEPTH * NB_S * L_S * GMW;

enum { I_XP = 0, I_XS, I_PP, I_PS, I_SCONV, I_SSSM, I_F1N, I_F1G, I_F1U, I_F1D, I_MIXN, I_WIN, I_CONVW, I_CONVB, I_DTB, I_ALOG, I_DSKIP, I_SSDN,
       I_GLNG, I_GLNB, I_GWS, I_GBS, I_WBA, I_WBB, I_WOUT, I_F2N, I_F2G, I_F2U, I_F2D, I_PLEN, I_PLEG, I_PLEP, I_FINN, N_IN };

struct Args { const float* in[N_IN]; float* out; unsigned char* ws; int ph_lo, ph_hi; };
#define CAS __attribute__((address_space(4)))
struct KP { const CAS char* p;
    __device__ __forceinline__ const float* in(int i) const { return *(const float* const CAS*)(p + 8 * i); }
    __device__ __forceinline__ float* out() const { return *(float* const CAS*)(p + 8 * N_IN); }
    __device__ __forceinline__ unsigned char* ws() const { return *(unsigned char* const CAS*)(p + 8 * N_IN + 8); }
    __device__ __forceinline__ int ph_lo() const { return *(const int CAS*)(p + 8 * N_IN + 16); }
    __device__ __forceinline__ int ph_hi() const { return *(const int CAS*)(p + 8 * N_IN + 20); } };
__device__ __forceinline__ KP kp_get() { KP k; k.p = (const CAS char*)__builtin_amdgcn_kernarg_segment_ptr(); asm volatile("" : "+s"(k.p)); return k; }
__device__ __forceinline__ int lane_id() { return (int)__builtin_amdgcn_mbcnt_hi(~0u, __builtin_amdgcn_mbcnt_lo(~0u, 0u)); }

__device__ __forceinline__ float wave_sum(float v) {
#pragma unroll
    for (int o = 1; o < 64; o <<= 1) v += __shfl_xor(v, o);
    return v;
}

struct RowId { __device__ __forceinline__ int operator()(int n) const { return n; } };
struct RowGU { int up; __device__ __forceinline__ int operator()(int n) const { const int pn = n >> 7, o = n & 127; return 256 * pn + 128 * ((o >> 2) & 1) + 32 * (o >> 5) + (up ? 16 : 0) + 4 * ((o >> 3) & 3) + (o & 3); } };
struct RowIn { __device__ __forceinline__ int operator()(int n) const { return n < 5120 ? n : (n < 5152 ? n - 5120 + PC_DT : n - 32); } };
template <class RM>
__device__ __forceinline__ void transpose_item(const float* W, int K, int N, bf16* WT, int ldt, RM rm, LAS float* scr, int item, int lane, const float* kg = nullptr) {
    const int nblk = N / 32, kb = item / nblk, nb = item % nblk, k0 = 64 * kb, n0 = 32 * nb;
#pragma unroll
    for (int i = 0; i < 32; ++i) { const int kk = 2 * i + (lane >> 5); scr[kk * 33 + (lane & 31)] = W[(size_t)(k0 + kk) * N + n0 + (lane & 31)]; }
    asm volatile("s_waitcnt lgkmcnt(0)" ::: "memory");
    const int c = lane & 7;
    f32x4 ga = {1.f, 1.f, 1.f, 1.f}, gb = ga;
    if (kg) { ga = *(const f32x4*)(kg + k0 + 8 * c); gb = *(const f32x4*)(kg + k0 + 8 * c + 4); }
#pragma unroll
    for (int j = 0; j < 4; ++j) { const int n = (lane >> 3) + 8 * j; const LAS float* s = scr + (8 * c) * 33 + n;
        u32x4 o; o.x = pk2(s[0 * 33] * ga[0], s[1 * 33] * ga[1]); o.y = pk2(s[2 * 33] * ga[2], s[3 * 33] * ga[3]); o.z = pk2(s[4 * 33] * gb[0], s[5 * 33] * gb[1]); o.w = pk2(s[6 * 33] * gb[2], s[7 * 33] * gb[3]);
        *(u32x4*)(WT + (size_t)rm(n0 + n) * ldt + k0 + 8 * c) = o; }
    asm volatile("s_waitcnt lgkmcnt(0)" ::: "memory");
}

template <int GRP>
__device__ __forceinline__ void convert_group(const KP a, int layer, bf16* Wb, LAS unsigned char* lds, int w, int nw, int wave, int lane) {
    LAS float* scr = (LAS float*)(lds + wave * 16384);
    constexpr int T_GU = (D / 64) * (FF / 32), T_DN = (FF / 64) * (D / 32), T_IN = (D / 64) * (INC / 32), T_SQ = (D / 64) * (D / 32), T_BB = (GMW / 64) * (D / 32), T_PP = (PLE / 64) * (D / 32);
    constexpr int NITEMS = GRP == 0 ? 2 * T_GU : GRP == 1 ? T_DN + T_IN : GRP == 2 ? 2 * T_SQ + T_BB + 2 * T_GU + T_DN : T_SQ + T_PP;
    const size_t lff = (size_t)layer * D * FF, lsq = (size_t)layer * D * D;
    for (int it = w; it < NITEMS; it += nw) {
        int r = it;
        if constexpr (GRP == 0) {
            if (r < T_GU) { transpose_item(a.in(I_F1G) + lff, D, FF, Wb + WO_GU1, KP_D, RowGU{0}, scr, r, lane, a.in(I_F1N) + layer * D); continue; } r -= T_GU;
            transpose_item(a.in(I_F1U) + lff, D, FF, Wb + WO_GU1, KP_D, RowGU{1}, scr, r, lane, a.in(I_F1N) + layer * D);
        } else if constexpr (GRP == 1) {
            if (r < T_DN) { transpose_item(a.in(I_F1D) + lff, FF, D, Wb + WO_D1, KP_F, RowId{}, scr, r, lane); continue; } r -= T_DN;
            transpose_item(a.in(I_WIN) + (size_t)layer * D * INC, D, INC, Wb + WO_IN, KP_D, RowIn{}, scr, r, lane, a.in(I_MIXN) + layer * D);
        } else if constexpr (GRP == 2) {
            if (r < T_SQ) { transpose_item(a.in(I_WBA) + lsq, DIN, D, Wb + WO_A, KP_D, RowId{}, scr, r, lane); continue; } r -= T_SQ;
            if (r < T_SQ) { transpose_item(a.in(I_WOUT) + lsq, D, D, Wb + WO_O, KP_D, RowId{}, scr, r, lane); continue; } r -= T_SQ;
            if (r < T_BB) { transpose_item(a.in(I_WBB) + (size_t)layer * GMW * D, GMW, D, Wb + WO_B, KP_G, RowId{}, scr, r, lane); continue; } r -= T_BB;
            if (r < T_GU) { transpose_item(a.in(I_F2G) + lff, D, FF, Wb + WO_GU2, KP_D, RowGU{0}, scr, r, lane, a.in(I_F2N) + layer * D); continue; } r -= T_GU;
            if (r < T_GU) { transpose_item(a.in(I_F2U) + lff, D, FF, Wb + WO_GU2, KP_D, RowGU{1}, scr, r, lane, a.in(I_F2N) + layer * D); continue; } r -= T_GU;
            transpose_item(a.in(I_F2D) + lff, FF, D, Wb + WO_D2, KP_F, RowId{}, scr, r, lane);
        } else {
            if (r < T_SQ) { transpose_item(a.in(I_PLEG) + lsq, D, D, Wb + WO_PG, KP_D, RowId{}, scr, r, lane, a.in(I_PLEN) + layer * D); continue; } r -= T_SQ;
            transpose_item(a.in(I_PLEP) + (size_t)layer * PLE * D, PLE, D, Wb + WO_PP, KP_E, RowId{}, scr, r, lane);
        }
    }
}
__device__ __forceinline__ void convert_misc(const KP a, int layer, bf16* Wb, int gtid, int NGT) {
    { u32x4* z = (u32x4*)(Wb + WO_IN + (size_t)INC * KP_D); const int nz = (NIN - INC) * KP_D / 8; for (int i = gtid; i < nz; i += NGT) z[i] = (u32x4){0u, 0u, 0u, 0u}; }
    { const float* wsrc = a.in(I_GWS) + (size_t)layer * 8 * 128 * 128; bf16* wd = Wb + WO_WS;
      for (int i = gtid; i < 8 * 128 * 128 / 8; i += NGT) { const int e0 = i * 8, t = (e0 >> 7) & 127, s0 = e0 & 127; const f32x4 v0 = *(const f32x4*)(wsrc + e0), v1 = *(const f32x4*)(wsrc + e0 + 4);
          float f[8] = {v0[0], v0[1], v0[2], v0[3], v1[0], v1[1], v1[2], v1[3]};
#pragma unroll
          for (int j = 0; j < 8; ++j) if (s0 + j > t) f[j] = 0.f;
          u32x4 o; o.x = pk2(f[0], f[1]); o.y = pk2(f[2], f[3]); o.z = pk2(f[4], f[5]); o.w = pk2(f[6], f[7]); *(u32x4*)(wd + e0) = o; } }
}
__device__ __forceinline__ void convert_pe(const KP a, int layer, bf16* PE, int gtid, int NGT) {
    { const float* pp = a.in(I_PP) + (size_t)layer * M_P * PLE; const float* ps = a.in(I_PS) + (size_t)layer * (M_TOK - M_P) * PLE; const int n8 = M_TOK * PLE / 8, np8 = M_P * PLE / 8;
      for (int i = gtid; i < n8; i += NGT) { const float* s = i < np8 ? pp + (size_t)i * 8 : ps + (size_t)(i - np8) * 8; const f32x4 v0 = *(const f32x4*)s, v1 = *(const f32x4*)(s + 4);
          u32x4 o; o.x = pk2(v0[0], v0[1]); o.y = pk2(v0[2], v0[3]); o.z = pk2(v1[0], v1[1]); o.w = pk2(v1[2], v1[3]); *(u32x4*)(PE + (size_t)(i >> 5) * LDE + (i & 31) * 8) = o; } }
}
#define TAIL_CONVERT(NUNITS, ...) do { const int thr_ = (NUNITS) % G; if (bid >= thr_) { asm volatile("s_waitcnt vmcnt(0) lgkmcnt(0)" ::: "memory"); __syncthreads(); const int tw_ = (bid - thr_) * NWAVES + wave, tn_ = (G - thr_) * NWAVES; __VA_ARGS__ } } while (0)

__device__ __forceinline__ void phase_first(const float* rlo, const float* rhi, bf16* XB, float* RS, int gw, int NGW, int lane) {
    for (int r = gw; r < M_TOK; r += NGW) {
        f32x4 v0[4], v1[4];
        const float* xr = (r < M_P ? rlo + (size_t)r * D : rhi + (size_t)(r - M_P) * D) + 8 * lane;
#pragma unroll
        for (int j = 0; j < 4; ++j) { v0[j] = *(const f32x4*)(xr + 512 * j); v1[j] = *(const f32x4*)(xr + 512 * j + 4); }
        float ss = 0.f;
#pragma unroll
        for (int j = 0; j < 4; ++j) ss += ssq8(v0[j], v1[j]);
        bf16* xo = XB + (size_t)r * XBP + 8 * lane;
#pragma unroll
        for (int j = 0; j < 4; ++j) *(u32x4*)(xo + 512 * j) = pack8u(v0[j], v1[j]);
        ss = wave_sum(ss);
        if (lane == 0) RS[r] = rsqrtf(ss * (1.f / D) + EPS);
    }
}
template <bool FOLD>
__device__ __forceinline__ void phase_rstd(const float* SSQ, float* RS, const float* part, bf16* XB, int gw, int NGW, int lane, int gtid, int NGT) {
    constexpr int NRED = FOLD ? M_P : M_TOK;
    for (int t = gtid; t < NRED * 4; t += NGT) { const int r = t >> 2, q = t & 3; float s = 0.f;
#pragma unroll
        for (int j = 0; j < 8; ++j) s += SSQ[(size_t)(q * 8 + j) * M_TOK + r];
        s += __shfl_xor(s, 1); s += __shfl_xor(s, 2);
        if (q == 0) RS[r] = rsqrtf(s * (1.f / D) + EPS); }
    if (FOLD) for (int r = M_P + (NGW - 1 - gw); r < M_TOK; r += NGW) {
        f32x4 v0[4], v1[4];
        bf16* xo = XB + (size_t)r * XBP + 8 * lane;
#pragma unroll
        for (int j = 0; j < 4; ++j) unpack8(*(const u32x4*)(xo + 512 * j), v0[j], v1[j]);
#pragma unroll 1
        for (int s = 0; s < 8; ++s) { const float* pr = part + ((size_t)s * (M_TOK - M_P) + (size_t)(r - M_P)) * D + 8 * lane;
#pragma unroll
            for (int j = 0; j < 4; ++j) { v0[j] = v0[j] + *(const f32x4*)(pr + 512 * j); v1[j] = v1[j] + *(const f32x4*)(pr + 512 * j + 4); } }
        float ss = 0.f;
#pragma unroll
        for (int j = 0; j < 4; ++j) { ss += ssq8(v0[j], v1[j]); *(u32x4*)(xo + 512 * j) = pack8u(v0[j], v1[j]); }
        ss = wave_sum(ss);
        if (lane == 0) RS[r] = rsqrtf(ss * (1.f / D) + EPS);
    }
}
__device__ __forceinline__ void phase_final_norm(const bf16* XB, float* Y, const float* gain, int gw, int NGW, int lane) {
    for (int r = gw; r < M_TOK; r += NGW) {
        const bf16* xr = XB + (size_t)r * XBP + 8 * lane;
        f32x4 v0[4], v1[4]; float ss = 0.f;
#pragma unroll
        for (int j = 0; j < 4; ++j) unpack8(*(const u32x4*)(xr + 512 * j), v0[j], v1[j]);
#pragma unroll
        for (int j = 0; j < 4; ++j) ss += ssq8(v0[j], v1[j]);
        const float rstd = rsqrtf(wave_sum(ss) * (1.f / D) + EPS);
        float* yo = Y + (size_t)r * D + 8 * lane;
#pragma unroll
        for (int j = 0; j < 4; ++j) { const f32x4 g0 = *(const f32x4*)(gain + 8 * lane + 512 * j), g1 = *(const f32x4*)(gain + 8 * lane + 512 * j + 4); __builtin_nontemporal_store(v0[j] * rstd * g0, (f32x4*)(yo + 512 * j)); __builtin_nontemporal_store(v1[j] * rstd * g1, (f32x4*)(yo + 512 * j + 4)); }
    }
}

__device__ __forceinline__ size_t seq_row0(int sq) { return sq < NB_P ? (size_t)sq * SEQ : (size_t)M_P + (size_t)(sq - NB_P) * L_S; }


typedef pg8::bf16x8 bf16x8;
constexpr int SC = 8, NSC = SEQ / (64 * SC), NSC1 = NSC - 1;
constexpr int XS_LD = 72, TM_LD = 136;
constexpr int SL_XST = 0;
constexpr int SL_BMT = SL_XST + 512 * XS_LD * 2;
constexpr int SL_BM  = SL_BMT + 128 * XS_LD * 2;
constexpr int SL_CM  = SL_BM + 64 * TM_LD * 2;
constexpr int SL_CUM = SL_CM + 64 * TM_LD * 2;
constexpr int SL_DTV = SL_CUM + 2048;
constexpr int SL_WV  = SL_DTV + 2048;
constexpr int SL_SSQ = SL_WV + 2048;
constexpr int SL_GN  = SL_SSQ + 2048;
constexpr int SL_END = SL_GN + 2048;
static_assert(SL_END <= LDSCTL_OFF, "SSD LDS map");
constexpr size_t ST_ELEMS = 128 * 64;
constexpr size_t WSO_ST = 0, WSO_DTOT = (size_t)NB_P * NSC1 * NH * ST_ELEMS * 4;
static_assert(WSO_DTOT + (size_t)NB_P * NSC1 * NH * 4 <= (size_t)128 * MiB, "SSD states fit the first 128 MiB of the y region of d_out");
constexpr size_t WSO_PE2 = (size_t)64 * MiB;
static_assert(WSO_DTOT + (size_t)NB_P * NSC1 * NH * 4 <= WSO_PE2 && WSO_PE2 + (size_t)M_TOK * LDE * 2 <= (size_t)128 * MiB, "second embedding buffer fits the gap");
constexpr size_t WSO_XT = (size_t)128 * MiB;
static_assert(WSO_XT + (size_t)M_TOK * XBP * 2 <= (size_t)M_TOK * D * 4, "second stream buffer fits the y region");

__device__ __forceinline__ bf16x8 ld_pair8(const LAS unsigned char* p0, const LAS unsigned char* p1) {
    const u32x2 a = *(const LAS u32x2*)p0, b = *(const LAS u32x2*)p1; const u32x4 w = {a.x, a.y, b.x, b.y}; return __builtin_bit_cast(bf16x8, w); }
__device__ __forceinline__ bf16x8 pack8(const f32x4 lo, const f32x4 hi) { const u32x4 w = {pk2(lo[0], lo[1]), pk2(lo[2], lo[3]), pk2(hi[0], hi[1]), pk2(hi[2], hi[3])}; return __builtin_bit_cast(bf16x8, w); }
#define MFMA16(a, b, c) __builtin_amdgcn_mfma_f32_16x16x32_bf16((a), (b), (c), 0, 0, 0)
__device__ __forceinline__ void lds_barrier() { asm volatile("s_waitcnt lgkmcnt(0)" ::: "memory"); __builtin_amdgcn_s_barrier(); asm volatile("" ::: "memory"); }

__device__ __forceinline__ int xperm(int n2) { const int c = n2 & 63; return (n2 & ~63) | ((c >> 5) << 5) | (((c >> 2) & 1) << 4) | (((c >> 3) & 3) << 2) | (c & 3); }
__device__ __forceinline__ int xphys(int pb, int i) { return 32 * (pb >> 1) + 8 * (i >> 2) + 4 * (pb & 1) + (i & 3); }
template <bool FULL>
__device__ __forceinline__ void ssd_stage(const KP a, int layer, const bf16* rowp, int hist, const float* cst, float* tail_out, int g, LAS unsigned char* lds, int tid) {
    constexpr int NPAIR = FULL ? 384 : 320, NT = (NPAIR * 4 + NTHREADS - 1) / NTHREADS;
    static_assert(NPAIR % 64 == 0, "a wave's 64 tasks share the token block and the channel kind");
    const int wv = __builtin_amdgcn_readfirstlane(tid >> 6), ln = tid & 63;
    const float* cw = a.in(I_CONVW) + (size_t)layer * 4 * XBC; const float* cb = a.in(I_CONVB) + (size_t)layer * XBC;
    unsigned rr[NT][19];
#pragma unroll
    for (int i = 0; i < NT; ++i) {
        const int tw = wv * 64 + i * NTHREADS;
        const int tq = tw / NPAIR, pw = tw - tq * NPAIR, s0 = 16 * tq;
        const int chw = pw < 256 ? g * 512 + 2 * pw : (pw < 320 ? DIN + g * 128 + 2 * (pw - 256) : DIN + 512 + g * 128 + 2 * (pw - 320));
        if (tw < NPAIR * 4) {
            const bf16* pb = rowp + PC_XBC + chw + 2 * ln;
#pragma unroll
            for (int j = 0; j < 19; ++j) {
                const int s = s0 + j - 3;
                if (j >= 3 || s >= 0 || hist == 1) rr[i][j] = *(const unsigned*)(pb + (long)s * LDP);
                else if (hist == 2) { const f32x2 v = *(const f32x2*)(cst + (size_t)(s + 3) * XBC + chw + 2 * ln); rr[i][j] = pk2(v[0], v[1]); }
                else rr[i][j] = 0u;
            }
        } else {
#pragma unroll
            for (int j = 0; j < 19; ++j) rr[i][j] = 0u;
        }
    }
#pragma unroll
    for (int i = 0; i < NT; ++i) {
        const int tw = wv * 64 + i * NTHREADS; if (tw >= NPAIR * 4) break;
        const int tq = tw / NPAIR, pw = tw - tq * NPAIR, s0 = 16 * tq;
        const int kind = pw < 256 ? 0 : (pw < 320 ? 1 : 2);
        const int n2 = 2 * (pw - (kind == 0 ? 0 : (kind == 1 ? 256 : 320))) + 2 * ln;
        const int ch = (kind == 0 ? g * 512 : (kind == 1 ? DIN + g * 128 : DIN + 512 + g * 128)) + n2;
        float w0[4], w1[4];
#pragma unroll
        for (int k = 0; k < 4; ++k) { const f32x2 wv2 = *(const f32x2*)(cw + (size_t)k * XBC + ch); w0[k] = wv2[0]; w1[k] = wv2[1]; }
        const f32x2 bv = *(const f32x2*)(cb + ch);
        if (tail_out && tq == 3) {
#pragma unroll
            for (int k = 0; k < 3; ++k) *(f32x2*)(tail_out + (size_t)k * XBC + ch) = (f32x2){bflo(rr[i][16 + k]), bfhi(rr[i][16 + k])}; }
        unsigned q0[8], q1[8];
        LAS unsigned char* dtm = lds + (kind == 1 ? SL_BM : SL_CM) + s0 * (TM_LD * 2) + n2 * 2;
#pragma unroll
        for (int e = 0; e < 8; ++e) { float oa[2], ob[2];
#pragma unroll
            for (int u = 0; u < 2; ++u) { const int j = 2 * e + u;
                const float c0 = bv[0] + w0[0] * bflo(rr[i][j]) + w0[1] * bflo(rr[i][j + 1]) + w0[2] * bflo(rr[i][j + 2]) + w0[3] * bflo(rr[i][j + 3]), c1 = bv[1] + w1[0] * bfhi(rr[i][j]) + w1[1] * bfhi(rr[i][j + 1]) + w1[2] * bfhi(rr[i][j + 2]) + w1[3] * bfhi(rr[i][j + 3]);
                oa[u] = fast_silu(c0); ob[u] = fast_silu(c1);
                if (FULL && kind >= 1) *(LAS unsigned*)(dtm + j * (TM_LD * 2)) = pk2(oa[u], ob[u]); }
            q0[e] = pk2(oa[0], oa[1]); q1[e] = pk2(ob[0], ob[1]); }
        if (kind <= 1) {
            LAS unsigned char* d = lds + (kind == 0 ? SL_XST : SL_BMT) + n2 * (XS_LD * 2) + s0 * 2;
            *(LAS u32x4*)d = (u32x4){q0[0], q0[1], q0[2], q0[3]}; *(LAS u32x4*)(d + 16) = (u32x4){q0[4], q0[5], q0[6], q0[7]};
            *(LAS u32x4*)(d + XS_LD * 2) = (u32x4){q1[0], q1[1], q1[2], q1[3]}; *(LAS u32x4*)(d + XS_LD * 2 + 16) = (u32x4){q1[4], q1[5], q1[6], q1[7]};
        }
    }
}
__device__ __forceinline__ float ssd_cum(float dtv, float av, LAS unsigned char* lds, int wave, int lane) {
    float c = dtv * av;
#pragma unroll
    for (int o = 1; o < 64; o <<= 1) { const float t = __shfl_up(c, o); if (lane >= o) c += t; }
    const float c63 = __shfl(c, 63);
    ((LAS float*)(lds + SL_CUM))[wave * 64 + lane] = c; ((LAS float*)(lds + SL_DTV))[wave * 64 + lane] = dtv; ((LAS float*)(lds + SL_WV))[wave * 64 + lane] = __expf(c63 - c) * dtv;
    return c63;
}
__device__ __forceinline__ void ssd_state_update(f32x4 (&H)[8][4], float c63, const LAS unsigned char* lds, int wave, int lr, int q) {
    const float dec = __expf(c63);
#pragma unroll
    for (int nb = 0; nb < 8; ++nb)
#pragma unroll
        for (int pb = 0; pb < 4; ++pb) H[nb][pb] = H[nb][pb] * dec;
    const LAS float* wv = (const LAS float*)(lds + SL_WV) + wave * 64;
#pragma unroll
    for (int i = 0; i < 2; ++i) {
        const f32x4 wa = *(const LAS f32x4*)(wv + 32 * i + 4 * q), wb = *(const LAS f32x4*)(wv + 32 * i + 16 + 4 * q);
        bf16x8 xw[4];
#pragma unroll
        for (int pb = 0; pb < 4; ++pb) { const LAS unsigned char* xr = lds + SL_XST + (wave * 64 + xphys(pb, lr)) * (XS_LD * 2) + (32 * i + 4 * q) * 2;
            const u32x2 ua = *(const LAS u32x2*)xr, ub = *(const LAS u32x2*)(xr + 32);
            const f32x4 lo = {bflo(ua.x) * wa[0], bfhi(ua.x) * wa[1], bflo(ua.y) * wa[2], bfhi(ua.y) * wa[3]}, hi = {bflo(ub.x) * wb[0], bfhi(ub.x) * wb[1], bflo(ub.y) * wb[2], bfhi(ub.y) * wb[3]};
            xw[pb] = pack8(lo, hi); }
#pragma unroll
        for (int nb = 0; nb < 8; ++nb) { const LAS unsigned char* br = lds + SL_BMT + (16 * nb + lr) * (XS_LD * 2) + (32 * i + 4 * q) * 2; const bf16x8 bfA = ld_pair8(br, br + 32);
#pragma unroll
            for (int pb = 0; pb < 4; ++pb) H[nb][pb] = MFMA16(bfA, xw[pb], H[nb][pb]); }
        __builtin_amdgcn_sched_barrier(0);
    }
}
__device__ __forceinline__ void ssd_state_load(f32x4 (&H)[8][4], const float* st, int lane) {
#pragma unroll
    for (int nb = 0; nb < 8; ++nb)
#pragma unroll
        for (int pb = 0; pb < 4; ++pb)
#pragma unroll
            for (int r = 0; r < 4; ++r) H[nb][pb][r] = st[(size_t)(((nb * 4 + pb) * 4 + r) * 64 + lane)];
}
__device__ __forceinline__ void ssd_state_store(const f32x4 (&H)[8][4], float* st, int lane) {
#pragma unroll
    for (int nb = 0; nb < 8; ++nb)
#pragma unroll
        for (int pb = 0; pb < 4; ++pb)
#pragma unroll
            for (int r = 0; r < 4; ++r) st[(size_t)(((nb * 4 + pb) * 4 + r) * 64 + lane)] = H[nb][pb][r];
}

__device__ __forceinline__ void ssd1_item(const KP a, int layer, int b, int k, int g, const bf16* PB, const float* DT, unsigned char* hbreg, LAS unsigned char* lds, int tid, int wave, int lane) {
    const int h = g * 8 + wave; (void)tid;
    const float av = -__expf(a.in(I_ALOG)[layer * NH + h]);
    f32x4 H[8][4];
#pragma unroll
    for (int nb = 0; nb < 8; ++nb)
#pragma unroll
        for (int pb = 0; pb < 4; ++pb) H[nb][pb] = (f32x4){0.f, 0.f, 0.f, 0.f};
    float dsum = 0.f;
    float dtn = DT[((size_t)b * SEQ + (size_t)(k * SC) * 64 + lane) * NH + h];
#pragma unroll 1
    for (int c = 0; c < SC; ++c) {
        int ln = lane; asm volatile("" : "+v"(ln));
        const int lr = ln & 15, q = ln >> 4;
        const size_t rowc = (size_t)b * SEQ + (size_t)(k * SC + c) * 64;
        const float dtc = dtn; if (c + 1 < SC) dtn = DT[(rowc + 64 + ln) * NH + h];
        ssd_stage<false>(a, layer, PB + rowc * LDP, (k == 0 && c == 0) ? 0 : 1, nullptr, nullptr, g, lds, wave * 64 + ln);
        const float c63 = ssd_cum(dtc, av, lds, wave, ln);
        dsum += c63;
        lds_barrier();
        ssd_state_update(H, c63, lds, wave, lr, q);
        lds_barrier();
    }
    const size_t si = ((size_t)b * NSC1 + k) * NH + h;
    { int ln = lane; asm volatile("" : "+v"(ln));
      ssd_state_store(H, (float*)(hbreg + WSO_ST) + si * ST_ELEMS, ln);
      if (ln == 0) ((float*)(hbreg + WSO_DTOT))[si] = __expf(dsum); }
}
__device__ __forceinline__ void ssd2_phase(unsigned char* hbreg, int gw, int NGW, int lane) {
    for (int it = gw; it < NB_P * NH * 32; it += NGW) {
        const int bh = it >> 5, part = it & 31, b = bh / NH, h = bh % NH;
        float* s0 = (float*)(hbreg + WSO_ST) + (((size_t)b * NSC1) * NH + h) * ST_ELEMS + (size_t)part * 4 * 64 + lane; const float* d0 = (const float*)(hbreg + WSO_DTOT) + ((size_t)b * NSC1) * NH + h;
        float sv[NSC1][4], dk[NSC1];
#pragma unroll
        for (int k = 0; k < NSC1; ++k) { dk[k] = d0[(size_t)k * NH];
#pragma unroll
            for (int j = 0; j < 4; ++j) sv[k][j] = s0[(size_t)k * NH * ST_ELEMS + j * 64]; }
        float run[4] = {0.f, 0.f, 0.f, 0.f};
#pragma unroll
        for (int k = 0; k < NSC1; ++k)
#pragma unroll
            for (int j = 0; j < 4; ++j) { run[j] = run[j] * dk[k] + sv[k][j]; s0[(size_t)k * NH * ST_ELEMS + j * 64] = run[j]; }
    }
}
__device__ __forceinline__ void ssd3_item(const KP a, int layer, size_t row0, int nchunk, int g, const float* st_init  , const float* sinit  ,
                                          int hist0, const float* cst, float* ssm_out  , float* conv_out  ,
                                          bf16* PB, const float* DT, LAS unsigned char* lds, int tid, int wave, int lane, bf16* dry = nullptr) {
    const int h = g * 8 + wave; (void)tid;
#ifdef S3_DRY_SKIP
    const int skip = dry ? S3_DRY_SKIP : 0; if (dry) { ssm_out = nullptr; conv_out = nullptr; }
#else
    constexpr int skip = 0;
#endif
    const float av = -__expf(a.in(I_ALOG)[layer * NH + h]), Dk = a.in(I_DSKIP)[layer * NH + h];
    f32x4 H[8][4];
    { const int lr = lane & 15, q = lane >> 4;
    if (st_init) ssd_state_load(H, st_init + (size_t)h * ST_ELEMS, lane);
    else if (sinit) {
#pragma unroll
        for (int nb = 0; nb < 8; ++nb)
#pragma unroll
            for (int pb = 0; pb < 4; ++pb) H[nb][pb] = *(const f32x4*)(sinit + ((size_t)h * HD + xphys(pb, lr)) * NS + 16 * nb + 4 * q);
    } else {
#pragma unroll
        for (int nb = 0; nb < 8; ++nb)
#pragma unroll
            for (int pb = 0; pb < 4; ++pb) H[nb][pb] = (f32x4){0.f, 0.f, 0.f, 0.f};
    } }
    ((LAS float*)(lds + SL_GN))[wave * 64 + lane] = a.in(I_SSDN)[(size_t)layer * DIN + h * 64 + lane];
    float dtn = DT[(row0 + lane) * NH + h];
#pragma unroll 1
    for (int c = 0; c < nchunk; ++c) {
        const size_t rowc = row0 + (size_t)c * 64;
        const float dtc = dtn; if (c + 1 < nchunk) dtn = DT[(rowc + 64 + lane) * NH + h];
        if (!(skip & 1)) { int ln = lane; asm volatile("" : "+v"(ln));
          ssd_stage<true>(a, layer, PB + rowc * LDP, c == 0 ? hist0 : 1, cst, (c == nchunk - 1) ? conv_out : nullptr, g, lds, wave * 64 + ln); }
        float c63; { int ln = lane; asm volatile("" : "+v"(ln)); c63 = ssd_cum(dtc, av, lds, wave, ln); }
        lds_barrier();
        const LAS float* cumv = (const LAS float*)(lds + SL_CUM) + wave * 64; const LAS float* dtv = (const LAS float*)(lds + SL_DTV) + wave * 64;
#pragma unroll 1
        for (int th = (skip & 2) ? 2 : 0; th < 2; ++th) {
            int ln = lane; asm volatile("" : "+v"(ln)); const int lr = ln & 15, q = ln >> 4;
            u32x4 zpre[2][2];
#pragma unroll
            for (int tbi = 0; tbi < 2; ++tbi) { const bf16* zr = PB + (rowc + 16 * (2 * th + tbi) + lr) * LDP + PC_Z + h * 64 + 8 * q;
#pragma unroll
                for (int m = 0; m < 2; ++m) zpre[tbi][m] = (skip & 8) ? (u32x4){0x3f803f80u, 0x3f803f80u, 0x3f803f80u, 0x3f803f80u} : *(const u32x4*)(zr + 32 * m); }
            f32x4 cbt[4][2];
#pragma unroll
            for (int sb = 0; sb < 4; ++sb) { cbt[sb][0] = (f32x4){0.f, 0.f, 0.f, 0.f}; cbt[sb][1] = (f32x4){0.f, 0.f, 0.f, 0.f}; }
#pragma unroll
            for (int kk = 0; kk < 4; ++kk) {
                bf16x8 cf[2];
#pragma unroll
                for (int tbi = 0; tbi < 2; ++tbi) cf[tbi] = *(const LAS bf16x8*)(lds + SL_CM + (16 * (2 * th + tbi) + lr) * (TM_LD * 2) + (32 * kk + 8 * q) * 2);
#pragma unroll
                for (int sb = 0; sb < 4; ++sb) { const bf16x8 bfA = *(const LAS bf16x8*)(lds + SL_BM + (16 * sb + lr) * (TM_LD * 2) + (32 * kk + 8 * q) * 2);
                    cbt[sb][0] = MFMA16(bfA, cf[0], cbt[sb][0]); cbt[sb][1] = MFMA16(bfA, cf[1], cbt[sb][1]); }
                __builtin_amdgcn_sched_barrier(0);
            }
            float ct[2]; ct[0] = cumv[16 * (2 * th) + lr]; ct[1] = cumv[16 * (2 * th + 1) + lr];
            bf16x8 mf[2][2];
#pragma unroll
            for (int sb = 0; sb < 4; ++sb) { const f32x4 cs = *(const LAS f32x4*)(cumv + 16 * sb + 4 * q), ds = *(const LAS f32x4*)(dtv + 16 * sb + 4 * q);
#pragma unroll
                for (int tbi = 0; tbi < 2; ++tbi) { const int t = 16 * (2 * th + tbi) + lr;
#pragma unroll
                    for (int r = 0; r < 4; ++r) { const int s = 16 * sb + 4 * q + r; const float f = (s <= t) ? __expf(ct[tbi] - cs[r]) * ds[r] : 0.f; cbt[sb][tbi][r] = cbt[sb][tbi][r] * f + ((s == t) ? Dk : 0.f); } } }
#pragma unroll
            for (int i = 0; i < 2; ++i) { mf[i][0] = pack8(cbt[2 * i][0], cbt[2 * i + 1][0]); mf[i][1] = pack8(cbt[2 * i][1], cbt[2 * i + 1][1]); }
            __builtin_amdgcn_sched_barrier(0);
            f32x4 y[4][2];
#pragma unroll
            for (int pb = 0; pb < 4; ++pb) { y[pb][0] = (f32x4){0.f, 0.f, 0.f, 0.f}; y[pb][1] = (f32x4){0.f, 0.f, 0.f, 0.f}; }
#pragma unroll
            for (int kk = 0; kk < 4; ++kk) {
                bf16x8 cf[2];
#pragma unroll
                for (int tbi = 0; tbi < 2; ++tbi) { const LAS unsigned char* cr = lds + SL_CM + (16 * (2 * th + tbi) + lr) * (TM_LD * 2) + (32 * kk + 4 * q) * 2; cf[tbi] = ld_pair8(cr, cr + 32); }
#pragma unroll
                for (int pb = 0; pb < 4; ++pb) { asm volatile("" : "+v"(H[2 * kk][pb]), "+v"(H[2 * kk + 1][pb]));
                    const bf16x8 hf = pack8(H[2 * kk][pb], H[2 * kk + 1][pb]); y[pb][0] = MFMA16(hf, cf[0], y[pb][0]); y[pb][1] = MFMA16(hf, cf[1], y[pb][1]); }
                __builtin_amdgcn_sched_barrier(0);
            }
            { const float e0 = __expf(ct[0]), e1 = __expf(ct[1]);
#pragma unroll
              for (int pb = 0; pb < 4; ++pb) { y[pb][0] = y[pb][0] * e0; y[pb][1] = y[pb][1] * e1; } }
#pragma unroll
            for (int i = 0; i < 2; ++i)
#pragma unroll
                for (int pb = 0; pb < 4; ++pb) { const LAS unsigned char* xr = lds + SL_XST + (wave * 64 + xphys(pb, lr)) * (XS_LD * 2) + (32 * i + 4 * q) * 2; const bf16x8 xf = ld_pair8(xr, xr + 32);
                    y[pb][0] = MFMA16(xf, mf[i][0], y[pb][0]); y[pb][1] = MFMA16(xf, mf[i][1], y[pb][1]); }
            __builtin_amdgcn_sched_barrier(0);
            float ssq[2] = {0.f, 0.f};
#pragma unroll
            for (int tbi = 0; tbi < 2; ++tbi)
#pragma unroll
                for (int pb = 0; pb < 4; ++pb) { const u32x4 z4 = zpre[tbi][pb >> 1]; const unsigned zx = (pb & 1) ? z4.z : z4.x, zy = (pb & 1) ? z4.w : z4.y; const float zf[4] = {bflo(zx), bfhi(zx), bflo(zy), bfhi(zy)};
#pragma unroll
                    for (int r = 0; r < 4; ++r) { const float v = y[pb][tbi][r] * zf[r]; y[pb][tbi][r] = v; ssq[tbi] += v * v; } }
#pragma unroll
            for (int tbi = 0; tbi < 2; ++tbi) { float s = ssq[tbi]; s += __shfl_xor(s, 16); s += __shfl_xor(s, 32); if (q == 0) ((LAS float*)(lds + SL_SSQ))[(th * 32 + 16 * tbi + lr) * 8 + wave] = s; }
            lds_barrier();
#pragma unroll
            for (int tbi = 0; tbi < 2; ++tbi) { const int t = 16 * (2 * th + tbi) + lr; const LAS f32x4* sp = (const LAS f32x4*)((LAS float*)(lds + SL_SSQ) + (th * 32 + 16 * tbi + lr) * 8);
                const f32x4 s0 = sp[0], s1 = sp[1]; const float rstd = rsqrtf(((s0[0] + s0[1]) + (s0[2] + s0[3]) + (s1[0] + s1[1]) + (s1[2] + s1[3])) * (1.f / 512.f) + EPS);
                bf16* zr = dry ? dry + ((rowc + t) & 8191) * 2048 + h * 64 + 8 * q : PB + (rowc + t) * LDP + PC_Z + h * 64 + 8 * q;
#pragma unroll
                for (int m = 0; m < 2; ++m) { const LAS f32x4* gp = (const LAS f32x4*)((const LAS float*)(lds + SL_GN) + wave * 64 + 32 * m + 8 * q); const f32x4 ga = gp[0], gb = gp[1];
                    const f32x4 va = y[2 * m][tbi], vb = y[2 * m + 1][tbi];
                    u32x4 o; o.x = pk2(va[0] * rstd * ga[0], va[1] * rstd * ga[1]); o.y = pk2(va[2] * rstd * ga[2], va[3] * rstd * ga[3]); o.z = pk2(vb[0] * rstd * gb[0], vb[1] * rstd * gb[1]); o.w = pk2(vb[2] * rstd * gb[2], vb[3] * rstd * gb[3]);
                    if (!(skip & 16)) *(u32x4*)(zr + 32 * m) = o; else asm volatile("" :: "v"(o.x), "v"(o.y), "v"(o.z), "v"(o.w)); } }
        }
        if (!(skip & 4)) { int ln = lane; asm volatile("" : "+v"(ln)); ssd_state_update(H, c63, lds, wave, ln & 15, ln >> 4); }
        lds_barrier();
    }
    if (ssm_out) { int ln = lane; asm volatile("" : "+v"(ln)); const int lr = ln & 15, q = ln >> 4;
#pragma unroll
        for (int nb = 0; nb < 8; ++nb)
#pragma unroll
            for (int pb = 0; pb < 4; ++pb) *(f32x4*)(ssm_out + ((size_t)h * HD + xphys(pb, lr)) * NS + 16 * nb + 4 * q) = H[nb][pb];
    }
}

constexpr int GV_LD = 136;
constexpr int GL_MU = 0, GL_RS = 512, GL_VT = 1024, GL_VT_BYTES = 128 * GV_LD * 2;
static_assert(GL_VT + 2 * GL_VT_BYTES <= LDSCTL_OFF, "gMLP LDS map");

template <int T>
__device__ __forceinline__ void gmlp_stage(const KP a, int layer, const bf16* P0  , int g, float* vout  , LAS unsigned char* lds, int buf, int tid) {
    const LAS float* mu = (const LAS float*)(lds + GL_MU); const LAS float* rs = (const LAS float*)(lds + GL_RS);
#pragma unroll 1
    for (int task = tid; task < 64 * (T / 16); task += NTHREADS) {
        const int tq = task >> 6, pi = task & 63, s0 = 16 * tq, c2 = 2 * pi, cg = g * 128 + c2;
        const f32x2 gg = *(const f32x2*)(a.in(I_GLNG) + (size_t)layer * GMW + cg), gb = *(const f32x2*)(a.in(I_GLNB) + (size_t)layer * GMW + cg);
        unsigned rr[16];
#pragma unroll
        for (int j = 0; j < 16; ++j) rr[j] = *(const unsigned*)(P0 + (size_t)(s0 + j) * LDP + PC_V + cg);
        unsigned q0[8], q1[8];
#pragma unroll
        for (int e = 0; e < 8; ++e) { float oa[2], ob[2];
#pragma unroll
            for (int u = 0; u < 2; ++u) { const int j = 2 * e + u; const float m = mu[s0 + j], r = rs[s0 + j];
                oa[u] = (bflo(rr[j]) - m) * r * gg[0] + gb[0]; ob[u] = (bfhi(rr[j]) - m) * r * gg[1] + gb[1];
                if (vout) *(f32x2*)(vout + (size_t)(s0 + j) * GMW + cg) = (f32x2){oa[u], ob[u]}; }
            q0[e] = pk2(oa[0], oa[1]); q1[e] = pk2(ob[0], ob[1]); }
        LAS unsigned char* d = lds + GL_VT + buf * GL_VT_BYTES + c2 * (GV_LD * 2) + s0 * 2;
        *(LAS u32x4*)d = (u32x4){q0[0], q0[1], q0[2], q0[3]}; *(LAS u32x4*)(d + 16) = (u32x4){q0[4], q0[5], q0[6], q0[7]};
        *(LAS u32x4*)(d + GV_LD * 2) = (u32x4){q1[0], q1[1], q1[2], q1[3]}; *(LAS u32x4*)(d + GV_LD * 2 + 16) = (u32x4){q1[4], q1[5], q1[6], q1[7]};
    }
}
template <int T>
__device__ __forceinline__ void gmlp_item(const KP a, int layer, size_t r0  , float* vout, bf16* PB, const bf16* Wsb  , LAS unsigned char* lds, int tid, int wave, int lane, bf16* dry = nullptr) {
    constexpr int NTB = T / 16;
    bf16* P0 = PB + r0 * LDP;
    { LAS float* mu = (LAS float*)(lds + GL_MU); LAS float* rs = (LAS float*)(lds + GL_RS);
#pragma unroll 1
      for (int t0 = wave * (T / 8); t0 < (wave + 1) * (T / 8); t0 += 8) {
          u32x4 qa[8], qb[8];
#pragma unroll
          for (int i = 0; i < 8; ++i) { const bf16* vr = P0 + (size_t)(t0 + i) * LDP + PC_V + lane * 16; qa[i] = *(const u32x4*)vr; qb[i] = *(const u32x4*)(vr + 8); }
#pragma unroll
          for (int i = 0; i < 8; ++i) {
              const float f[16] = { bflo(qa[i].x), bfhi(qa[i].x), bflo(qa[i].y), bfhi(qa[i].y), bflo(qa[i].z), bfhi(qa[i].z), bflo(qa[i].w), bfhi(qa[i].w), bflo(qb[i].x), bfhi(qb[i].x), bflo(qb[i].y), bfhi(qb[i].y), bflo(qb[i].z), bfhi(qb[i].z), bflo(qb[i].w), bfhi(qb[i].w) };
              float s = 0.f;
#pragma unroll
              for (int j = 0; j < 16; ++j) s += f[j];
              const float mean = wave_sum(s) * (1.f / GMW); float qq = 0.f;
#pragma unroll
              for (int j = 0; j < 16; ++j) { const float d = f[j] - mean; qq += d * d; }
              const float var = wave_sum(qq) * (1.f / GMW);
              if (lane == 0) { mu[t0 + i] = mean; rs[t0 + i] = rsqrtf(var + EPS); } }
      } }
    lds_barrier();
    gmlp_stage<T>(a, layer, P0, 0, vout, lds, 0, tid);
    lds_barrier();
#pragma unroll 1
    for (int g = 0; g < 8; ++g) {
        int ln = lane; asm volatile("" : "+v"(ln)); const int lr = ln & 15, q = ln >> 4;
        if (g + 1 < 8) gmlp_stage<T>(a, layer, P0, g + 1, vout, lds, (g + 1) & 1, wave * 64 + ln);
        const LAS unsigned char* vt = lds + GL_VT + (g & 1) * GL_VT_BYTES + (16 * wave + lr) * (GV_LD * 2);
        bf16x8 af[T / 32];
#pragma unroll
        for (int kk = 0; kk < T / 32; ++kk) af[kk] = *(const LAS bf16x8*)(vt + (32 * kk + 8 * q) * 2);
        const bf16* wg = Wsb + (size_t)g * 128 * 128;
        bf16x8 wf[NTB][T / 32]; float bsv[NTB]; u32x2 uu[NTB];
#pragma unroll
        for (int tb = 0; tb < NTB; ++tb) {
#pragma unroll
            for (int kk = 0; kk <= tb / 2; ++kk) wf[tb][kk] = *(const bf16x8*)(wg + (size_t)(16 * tb + lr) * 128 + 32 * kk + 8 * q);
            bsv[tb] = a.in(I_GBS)[(size_t)(layer * 8 + g) * 128 + 16 * tb + lr];
            uu[tb] = *(const u32x2*)(P0 + (size_t)(16 * tb + lr) * LDP + PC_U + g * 128 + 16 * wave + 4 * q); }
#pragma unroll
        for (int tb = 0; tb < NTB; ++tb) {
            f32x4 acc = {0.f, 0.f, 0.f, 0.f};
#pragma unroll
            for (int kk = 0; kk <= tb / 2; ++kk) acc = MFMA16(af[kk], wf[tb][kk], acc);
            bf16* up = dry ? dry + ((r0 + 16 * tb + lr) & 8191) * 2048 + g * 128 + 16 * wave + 4 * q : P0 + (size_t)(16 * tb + lr) * LDP + PC_U + g * 128 + 16 * wave + 4 * q;
            u32x2 o; o.x = pk2(bflo(uu[tb].x) * (acc[0] + bsv[tb]), bfhi(uu[tb].x) * (acc[1] + bsv[tb])); o.y = pk2(bflo(uu[tb].y) * (acc[2] + bsv[tb]), bfhi(uu[tb].y) * (acc[3] + bsv[tb])); *(u32x2*)up = o;
        }
        lds_barrier();
    }
}

static_assert(GL_VT + 4 * GL_VT_BYTES <= LDSCTL_OFF, "gMLP decode LDS map");
__device__ __forceinline__ void gmlp_stage_dec(const KP a, int layer, const bf16* P0, int g, float* vout, LAS unsigned char* lds, int buf, int tid) {
    const LAS float* mu = (const LAS float*)(lds + GL_MU); const LAS float* rs = (const LAS float*)(lds + GL_RS);
    if (tid < 256) {
        const int tq = tid >> 6, pi = tid & 63, s0 = 16 * tq, c2 = 2 * pi, cg = g * 128 + c2;
        const f32x2 gg = *(const f32x2*)(a.in(I_GLNG) + (size_t)layer * GMW + cg), gb = *(const f32x2*)(a.in(I_GLNB) + (size_t)layer * GMW + cg);
        unsigned rr[16];
#pragma unroll
        for (int j = 0; j < 16; ++j) rr[j] = *(const unsigned*)(P0 + (size_t)(s0 + j) * LDP + PC_V + cg);
        unsigned h0[8], h1[8], l0[8], l1[8];
#pragma unroll
        for (int e = 0; e < 8; ++e) { float oa[2], ob[2];
#pragma unroll
            for (int u = 0; u < 2; ++u) { const int j = 2 * e + u; const float m = mu[s0 + j], r = rs[s0 + j];
                oa[u] = (bflo(rr[j]) - m) * r * gg[0] + gb[0]; ob[u] = (bfhi(rr[j]) - m) * r * gg[1] + gb[1];
                *(f32x2*)(vout + (size_t)(s0 + j) * GMW + cg) = (f32x2){oa[u], ob[u]}; }
            h0[e] = pk2(oa[0], oa[1]); h1[e] = pk2(ob[0], ob[1]);
            l0[e] = pk2(oa[0] - bflo(h0[e]), oa[1] - bfhi(h0[e])); l1[e] = pk2(ob[0] - bflo(h1[e]), ob[1] - bfhi(h1[e])); }
        LAS unsigned char* d = lds + GL_VT + buf * GL_VT_BYTES + c2 * (GV_LD * 2) + s0 * 2;
        *(LAS u32x4*)d = (u32x4){h0[0], h0[1], h0[2], h0[3]}; *(LAS u32x4*)(d + 16) = (u32x4){h0[4], h0[5], h0[6], h0[7]};
        *(LAS u32x4*)(d + GV_LD * 2) = (u32x4){h1[0], h1[1], h1[2], h1[3]}; *(LAS u32x4*)(d + GV_LD * 2 + 16) = (u32x4){h1[4], h1[5], h1[6], h1[7]};
        d += 2 * GL_VT_BYTES;
        *(LAS u32x4*)d = (u32x4){l0[0], l0[1], l0[2], l0[3]}; *(LAS u32x4*)(d + 16) = (u32x4){l0[4], l0[5], l0[6], l0[7]};
        *(LAS u32x4*)(d + GV_LD * 2) = (u32x4){l1[0], l1[1], l1[2], l1[3]}; *(LAS u32x4*)(d + GV_LD * 2 + 16) = (u32x4){l1[4], l1[5], l1[6], l1[7]};
    }
}
__device__ __forceinline__ void gmlp_item_dec(const KP a, int layer, size_t r0, float* vout, bf16* PB, LAS unsigned char* lds, int tid, int wave, int lane) {
    constexpr int T = 64, NTB = 4;
    bf16* P0 = PB + r0 * LDP;
    { LAS float* mu = (LAS float*)(lds + GL_MU); LAS float* rs = (LAS float*)(lds + GL_RS);
      const int t0 = wave * 8;
      u32x4 qa[8], qb[8];
#pragma unroll
      for (int i = 0; i < 8; ++i) { const bf16* vr = P0 + (size_t)(t0 + i) * LDP + PC_V + lane * 16; qa[i] = *(const u32x4*)vr; qb[i] = *(const u32x4*)(vr + 8); }
#pragma unroll
      for (int i = 0; i < 8; ++i) {
          const float f[16] = { bflo(qa[i].x), bfhi(qa[i].x), bflo(qa[i].y), bfhi(qa[i].y), bflo(qa[i].z), bfhi(qa[i].z), bflo(qa[i].w), bfhi(qa[i].w), bflo(qb[i].x), bfhi(qb[i].x), bflo(qb[i].y), bfhi(qb[i].y), bflo(qb[i].z), bfhi(qb[i].z), bflo(qb[i].w), bfhi(qb[i].w) };
          float s = 0.f;
#pragma unroll
          for (int j = 0; j < 16; ++j) s += f[j];
          const float mean = wave_sum(s) * (1.f / GMW); float qq = 0.f;
#pragma unroll
          for (int j = 0; j < 16; ++j) { const float d = f[j] - mean; qq += d * d; }
          const float var = wave_sum(qq) * (1.f / GMW);
          if (lane == 0) { mu[t0 + i] = mean; rs[t0 + i] = rsqrtf(var + EPS); } } }
    lds_barrier();
    gmlp_stage_dec(a, layer, P0, 0, vout, lds, 0, tid);
    lds_barrier();
#pragma unroll 1
    for (int g = 0; g < 8; ++g) {
        int ln = lane; asm volatile("" : "+v"(ln)); const int lr = ln & 15, q = ln >> 4;
        if (g + 1 < 8) gmlp_stage_dec(a, layer, P0, g + 1, vout, lds, (g + 1) & 1, wave * 64 + ln);
        const LAS unsigned char* vt = lds + GL_VT + (g & 1) * GL_VT_BYTES + (16 * wave + lr) * (GV_LD * 2);
        bf16x8 ah[T / 32], al[T / 32];
#pragma unroll
        for (int kk = 0; kk < T / 32; ++kk) { ah[kk] = *(const LAS bf16x8*)(vt + (32 * kk + 8 * q) * 2); al[kk] = *(const LAS bf16x8*)(vt + 2 * GL_VT_BYTES + (32 * kk + 8 * q) * 2); }
        const float* w32 = a.in(I_GWS) + (size_t)(layer * 8 + g) * 128 * 128;
        bf16x8 wh[NTB][T / 32], wl[NTB][T / 32]; float bsv[NTB]; u32x2 uu[NTB];
#pragma unroll
        for (int tb = 0; tb < NTB; ++tb) { const int t = 16 * tb + lr;
#pragma unroll
            for (int kk = 0; kk <= tb / 2; ++kk) { const float* wp = w32 + (size_t)t * 128 + 32 * kk + 8 * q; const f32x4 w0 = *(const f32x4*)wp, w1 = *(const f32x4*)(wp + 4);
                float f[8] = {w0[0], w0[1], w0[2], w0[3], w1[0], w1[1], w1[2], w1[3]};
#pragma unroll
                for (int e = 0; e < 8; ++e) if (32 * kk + 8 * q + e > t) f[e] = 0.f;
                const u32x4 hi = {pk2(f[0], f[1]), pk2(f[2], f[3]), pk2(f[4], f[5]), pk2(f[6], f[7])};
                const u32x4 lo = {pk2(f[0] - bflo(hi.x), f[1] - bfhi(hi.x)), pk2(f[2] - bflo(hi.y), f[3] - bfhi(hi.y)), pk2(f[4] - bflo(hi.z), f[5] - bfhi(hi.z)), pk2(f[6] - bflo(hi.w), f[7] - bfhi(hi.w))};
                wh[tb][kk] = __builtin_bit_cast(bf16x8, hi); wl[tb][kk] = __builtin_bit_cast(bf16x8, lo); }
            bsv[tb] = a.in(I_GBS)[(size_t)(layer * 8 + g) * 128 + t];
            uu[tb] = *(const u32x2*)(P0 + (size_t)t * LDP + PC_U + g * 128 + 16 * wave + 4 * q); }
#pragma unroll
        for (int tb = 0; tb < NTB; ++tb) {
            f32x4 acc = {0.f, 0.f, 0.f, 0.f};
#pragma unroll
            for (int kk = 0; kk <= tb / 2; ++kk) { acc = MFMA16(al[kk], wh[tb][kk], acc); acc = MFMA16(ah[kk], wl[tb][kk], acc); acc = MFMA16(ah[kk], wh[tb][kk], acc); }
            bf16* up = P0 + (size_t)(16 * tb + lr) * LDP + PC_U + g * 128 + 16 * wave + 4 * q;
            u32x2 o; o.x = pk2(bflo(uu[tb].x) * (acc[0] + bsv[tb]), bfhi(uu[tb].x) * (acc[1] + bsv[tb])); o.y = pk2(bflo(uu[tb].y) * (acc[2] + bsv[tb]), bfhi(uu[tb].y) * (acc[3] + bsv[tb])); *(u32x2*)up = o;
        }
        lds_barrier();
    }
}

#ifndef MK_PER_PHASE
#define MK_PER_PHASE 0
#endif
constexpr int WGM_WIDE = 8;
constexpr int WGM_N2K = 4;
constexpr int FFN_R1 = 64 * 256;
constexpr int PH_PER_LAYER = 15, N_PHASES = DEPTH * PH_PER_LAYER + 1;

__global__ void __launch_bounds__(NTHREADS, 2) mk_fwd(Args a_unused) {
    (void)a_unused;
    extern __shared__ __attribute__((aligned(16))) unsigned char lds_raw[];
    LAS unsigned char* lds = (LAS unsigned char*)lds_raw;
    const int G = gridDim.x, bid = blockIdx.x;
    const int wave0 = __builtin_amdgcn_readfirstlane(threadIdx.x >> 6);
    { volatile LAS unsigned* M0 = (volatile LAS unsigned*)(lds + LDSCTL_OFF); if (threadIdx.x < 64) M0[threadIdx.x] = 0u; }
    __syncthreads();
    int lo, hi; XcdBarrier bar;
    { const KP k0 = kp_get(); lo = k0.ph_lo(); hi = k0.ph_hi();
      bar.bar = (unsigned*)(k0.ws() + WS_CTL) + CW_BAR; bar.x = 0; bar.st = (volatile LAS unsigned*)(lds + LDSCTL_OFF) + 8; bar.w0 = (unsigned)wave0;
      if (hi - lo > 1) bar = xcd_barrier_post((unsigned*)(k0.ws() + WS_CTL) + CW_BAR, (volatile LAS unsigned*)(lds + LDSCTL_OFF) + 8, (unsigned)wave0); }
#define PH_LOCALS \
    const KP a = kp_get(); int lane = lane_id(); asm volatile("" : "+v"(lane)); unsigned char* wsb = a.ws(); float* X = a.out(); \
    const int wave = wave0, tid = wave * 64 + lane, gw = bid * NWAVES + wave, NGW = G * NWAVES, gtid = bid * NTHREADS + tid, NGT = G * NTHREADS; \
    bf16* Wb = (bf16*)(wsb + WS_W); bf16* XS = (bf16*)(wsb + WS_HB); bf16* XT = (bf16*)((unsigned char*)X + WSO_XT); bf16* PE2 = (bf16*)((unsigned char*)X + WSO_PE2); float* RS = (float*)(wsb + WS_RS); float* SSQ = (float*)(wsb + WS_SQ); bf16* PB = (bf16*)(wsb + WS_PB); bf16* AB = PB; bf16* PE = (bf16*)(wsb + WS_PE); float* DT = (float*)(wsb + WS_DT); float* PART = (float*)(wsb + WS_PART); \
    (void)tid; (void)gw; (void)NGW; (void)gtid; (void)NGT; (void)Wb; (void)XS; (void)XT; (void)PE2; (void)RS; (void)SSQ; (void)PB; (void)AB; (void)PE; (void)DT; (void)PART; (void)X;

    int ph = 0;
#define PH_ON (lo <= ph && ph < hi)
#define PH_END do { if (PH_ON && ph + 1 < hi) xcd_barrier(bar); ++ph; } while (0)

    if (PH_ON) { PH_LOCALS convert_group<0>(a, 0, Wb, lds, gw, NGW, wave, lane); convert_group<1>(a, 0, Wb, lds, gw, NGW, wave, lane);
        convert_group<3>(a, 0, Wb, lds, gw, NGW, wave, lane); convert_misc(a, 0, Wb, gtid, NGT); convert_pe(a, 0, PE, gtid, NGT);
        phase_first(a.in(I_XP), a.in(I_XS), XS, RS, gw, NGW, lane);
#ifdef DBG_FILL
        if (0 == 0) for (size_t i = OUT_SSM_P + gtid; i < OUT_END; i += NGT) a.out()[i] = 0.f;
#endif
    }
    PH_END;
    if (PH_ON) { PH_LOCALS pg8::Gemm g{XS, Wb + WO_GU1, XBP, KP_D, M_TOK, FF2, D}; pg8::StaticOrder S; S.init(M_TOK, FF2, D, G, bid, WGM_WIDE);
        EpiGU E{AB, LDF, RS}; pg8::gemm_phase<EpiGU, pg8::StaticOrder, true, true>(lds, g, S, E, wave); }
    PH_END;
    if (PH_ON) { PH_LOCALS
        pg8::Gemm g{AB, Wb + WO_D1, LDF, KP_F, M_TOK, D, FF}; pg8::TailSplitOrder S; S.init(M_P, M_TOK - M_P, M_P / 256, D, FF, G, bid, WGM_N2K, 0);
        EpiRes<false> E{nullptr, nullptr, XS, M_P, 0.5f, PART, SSQ}; pg8::gemm_phase<EpiRes<false>, pg8::TailSplitOrder, true, true>(lds, g, S, E, wave); }
    PH_END;
    if (PH_ON) { PH_LOCALS phase_rstd<true>(SSQ, RS, PART, XS, gw, NGW, lane, gtid, NGT); }
    PH_END;
    if (PH_ON) { PH_LOCALS pg8::Gemm g{XS, Wb + WO_IN, XBP, KP_D, M_TOK, NIN, D}; pg8::StaticOrder S; S.init(M_TOK, NIN, D, G, bid, WGM_WIDE);
        EpiInProj E{PB, DT, a.in(I_DTB) + 0 * NH, RS}; pg8::gemm_phase<EpiInProj, pg8::StaticOrder, true, true>(lds, g, S, E, wave);
        TAIL_CONVERT((M_TOK / 256) * (NIN / 256), convert_group<2>(a, 0, Wb, lds, tw_, tn_, wave, lane);); }
    PH_END;
    if (PH_ON) { PH_LOCALS
        constexpr int N_S1 = NB_P * NSC1 * NG, N_GM = NB_P * (SEQ / 128) + NB_S;
        for (int it = bid; it < N_S1; it += G) ssd1_item(a, 0, it / (NSC1 * NG), (it / NG) % NSC1, it % NG, PB, DT, (unsigned char*)X, lds, tid, wave, lane);
        for (int j = bid; j < NB_P * (SEQ / 128); j += G) gmlp_item<128>(a, 0, (size_t)(j / (SEQ / 128)) * SEQ + (size_t)(j % (SEQ / 128)) * 128, nullptr, PB, Wb + WO_WS, lds, tid, wave, lane);
        for (int bs = (G >= NB_S) ? bid - (G - NB_S) : bid; bs < NB_S; bs += G) if (bs >= 0)
            gmlp_item_dec(a, 0, (size_t)M_P + (size_t)bs * L_S, X + OUT_GV + (size_t)(0 * NB_S + bs) * L_S * GMW, PB, lds, tid, wave, lane);
        (void)N_GM;
    }
    PH_END;
    if (PH_ON) { PH_LOCALS
        constexpr int N_S3D = NB_S * NG;
        if (G > N_S3D) {
            if (bid < N_S3D) { const int bs = bid / NG, g = bid % NG;
                ssd3_item(a, 0, (size_t)M_P + (size_t)bs * L_S, 1, g, nullptr, a.in(I_SSSM) + (size_t)(0 * NB_S + bs) * NH * HD * NS, 2, a.in(I_SCONV) + (size_t)(0 * NB_S + bs) * 3 * XBC,
                          X + OUT_SSM_S + (size_t)(0 * NB_S + bs) * NH * HD * NS, X + OUT_CONV_S + (size_t)(0 * NB_S + bs) * 3 * XBC, PB, DT, lds, tid, wave, lane); }
            else ssd2_phase((unsigned char*)X, gw - N_S3D * NWAVES, NGW - N_S3D * NWAVES, lane);
        } else {
            for (int j = bid; j < N_S3D; j += G) { const int bs = j / NG, g = j % NG;
                ssd3_item(a, 0, (size_t)M_P + (size_t)bs * L_S, 1, g, nullptr, a.in(I_SSSM) + (size_t)(0 * NB_S + bs) * NH * HD * NS, 2, a.in(I_SCONV) + (size_t)(0 * NB_S + bs) * 3 * XBC,
                          X + OUT_SSM_S + (size_t)(0 * NB_S + bs) * NH * HD * NS, X + OUT_CONV_S + (size_t)(0 * NB_S + bs) * 3 * XBC, PB, DT, lds, tid, wave, lane); }
            ssd2_phase((unsigned char*)X, gw, NGW, lane);
        }
    }
    PH_END;
    if (PH_ON) { PH_LOCALS
        constexpr int N_S3P = NB_P * NSC * NG;
        for (int it = bid; it < N_S3P; it += G) {
            { const int b = it / (NSC * NG), k = (it / NG) % NSC, g = it % NG; const bool lastk = (k == NSC - 1);
                ssd3_item(a, 0, (size_t)b * SEQ + (size_t)k * SC * 64, SC, g, k ? (const float*)((unsigned char*)X + WSO_ST) + ((size_t)b * NSC1 + (k - 1)) * NH * ST_ELEMS : nullptr, nullptr, k ? 1 : 0, nullptr,
                          lastk ? X + OUT_SSM_P + (size_t)(0 * NB_P + b) * NH * HD * NS : nullptr, lastk ? X + OUT_CONV_P + (size_t)(0 * NB_P + b) * 3 * XBC : nullptr, PB, DT, lds, tid, wave, lane); }
        }
    }
    PH_END;
    if (PH_ON) { PH_LOCALS
        { pg8::Gemm g{PB + PC_Z, Wb + WO_A, LDP, KP_D, M_TOK, D, DIN}; pg8::StaticOrder S; S.init(M_TOK, D, DIN, G, bid, WGM_N2K);
          EpiMerge<0> E{PB + PC_GA, PB + PC_MRG}; pg8::gemm_phase<EpiMerge<0>, pg8::StaticOrder, true, true>(lds, g, S, E, wave); }
        { pg8::Gemm g{PB + PC_U, Wb + WO_B, LDP, KP_G, M_TOK, D, GMW}; pg8::StaticOrder S; S.init(M_TOK, D, GMW, G, bid, WGM_N2K);
          EpiMerge<1> E{PB + PC_GB, PB + PC_MRG}; pg8::gemm_phase<EpiMerge<1>, pg8::StaticOrder, true, true>(lds, g, S, E, wave); }
        TAIL_CONVERT((M_TOK / 256) * (D / 256), convert_group<0>(a, 1, Wb, lds, tw_, tn_, wave, lane); convert_group<1>(a, 1, Wb, lds, tw_, tn_, wave, lane); convert_pe(a, 1, PE2, tw_ * 64 + lane, tn_ * 64););
    }
    PH_END;
    if (PH_ON) { PH_LOCALS pg8::Gemm g{PB + PC_MRG, Wb + WO_O, LDP, KP_D, M_TOK, D, D}; pg8::TailSplitOrder S; S.init(M_P, M_TOK - M_P, M_P / 256, D, D, G, bid, WGM_N2K, 0);
        EpiRes<false> E{nullptr, nullptr, XS, M_P, 1.0f, PART, SSQ}; pg8::gemm_phase<EpiRes<false>, pg8::TailSplitOrder, true, true>(lds, g, S, E, wave); }
    PH_END;
    if (PH_ON) { PH_LOCALS phase_rstd<true>(SSQ, RS, PART, XS, gw, NGW, lane, gtid, NGT); }
    PH_END;
    if (PH_ON) { PH_LOCALS pg8::Gemm g{XS, Wb + WO_GU2, XBP, KP_D, M_TOK, FF2, D}; pg8::StaticOrder S; S.init(M_TOK, FF2, D, G, bid, WGM_WIDE);
        EpiGU E{AB, LDF, RS}; pg8::gemm_phase<EpiGU, pg8::StaticOrder, true, true>(lds, g, S, E, wave); }
    PH_END;
    if (PH_ON) { PH_LOCALS
        pg8::Gemm g{AB, Wb + WO_D2, LDF, KP_F, M_TOK, D, FF}; pg8::TailSplitOrder S; S.init(M_P, M_TOK - M_P, M_P / 256, D, FF, G, bid, WGM_N2K, 0);
        EpiRes<false> E{nullptr, nullptr, XS, M_P, 0.5f, PART, SSQ}; pg8::gemm_phase<EpiRes<false>, pg8::TailSplitOrder, true, true>(lds, g, S, E, wave); }
    PH_END;
    if (PH_ON) { PH_LOCALS phase_rstd<true>(SSQ, RS, PART, XS, gw, NGW, lane, gtid, NGT); }
    PH_END;
    if (PH_ON) { PH_LOCALS
        { pg8::Gemm g{XS, Wb + WO_PG, XBP, KP_D, M_TOK, D, D}; pg8::StaticOrder S; S.init(M_TOK, D, D, G, bid, WGM_N2K);
          EpiPg E{PB + PC_TMP, RS}; pg8::gemm_phase<EpiPg, pg8::StaticOrder, true, true>(lds, g, S, E, wave); }
        { pg8::Gemm g{PE, Wb + WO_PP, LDE, KP_E, M_TOK, D, PLE}; pg8::StaticOrder S; S.init(M_TOK, D, PLE, G, bid, WGM_N2K);
          EpiPle E{PB + PC_TMP, XS, XT, SSQ}; pg8::gemm_phase<EpiPle, pg8::StaticOrder, true, true>(lds, g, S, E, wave); }
        TAIL_CONVERT((M_TOK / 256) * (D / 256), convert_group<2>(a, 1, Wb, lds, tw_, tn_, wave, lane););
    }
    PH_END;
    if (PH_ON) { PH_LOCALS
        convert_group<3>(a, 1, Wb, lds, gw, NGW, wave, lane); convert_misc(a, 1, Wb, gtid, NGT);
        phase_rstd<false>(SSQ, RS, PART, XT, gw, NGW, lane, gtid, NGT);
#ifdef DBG_FILL
        if (1 == 0) for (size_t i = OUT_SSM_P + gtid; i < OUT_END; i += NGT) a.out()[i] = 0.f;
#endif
    }
    PH_END;
    if (PH_ON) { PH_LOCALS pg8::Gemm g{XT, Wb + WO_GU1, XBP, KP_D, M_TOK, FF2, D}; pg8::StaticOrder S; S.init(M_TOK, FF2, D, G, bid, WGM_WIDE);
        EpiGU E{AB, LDF, RS}; pg8::gemm_phase<EpiGU, pg8::StaticOrder, true, true>(lds, g, S, E, wave); }
    PH_END;
    if (PH_ON) { PH_LOCALS
        pg8::Gemm g{AB, Wb + WO_D1, LDF, KP_F, M_TOK, D, FF}; pg8::TailSplitOrder S; S.init(M_P, M_TOK - M_P, M_P / 256, D, FF, G, bid, WGM_N2K, 0);
        EpiRes<false> E{nullptr, nullptr, XT, M_P, 0.5f, PART, SSQ}; pg8::gemm_phase<EpiRes<false>, pg8::TailSplitOrder, true, true>(lds, g, S, E, wave); }
    PH_END;
    if (PH_ON) { PH_LOCALS phase_rstd<true>(SSQ, RS, PART, XT, gw, NGW, lane, gtid, NGT); }
    PH_END;
    if (PH_ON) { PH_LOCALS pg8::Gemm g{XT, Wb + WO_IN, XBP, KP_D, M_TOK, NIN, D}; pg8::StaticOrder S; S.init(M_TOK, NIN, D, G, bid, WGM_WIDE);
        EpiInProj E{PB, DT, a.in(I_DTB) + 1 * NH, RS}; pg8::gemm_phase<EpiInProj, pg8::StaticOrder, true, true>(lds, g, S, E, wave); }
    PH_END;
    if (PH_ON) { PH_LOCALS
        constexpr int N_S1 = NB_P * NSC1 * NG, N_GM = NB_P * (SEQ / 128) + NB_S;
        for (int it = bid; it < N_S1; it += G) ssd1_item(a, 1, it / (NSC1 * NG), (it / NG) % NSC1, it % NG, PB, DT, (unsigned char*)X, lds, tid, wave, lane);
        for (int j = bid; j < NB_P * (SEQ / 128); j += G) gmlp_item<128>(a, 1, (size_t)(j / (SEQ / 128)) * SEQ + (size_t)(j % (SEQ / 128)) * 128, nullptr, PB, Wb + WO_WS, lds, tid, wave, lane);
        for (int bs = (G >= NB_S) ? bid - (G - NB_S) : bid; bs < NB_S; bs += G) if (bs >= 0)
            gmlp_item_dec(a, 1, (size_t)M_P + (size_t)bs * L_S, X + OUT_GV + (size_t)(1 * NB_S + bs) * L_S * GMW, PB, lds, tid, wave, lane);
        (void)N_GM;
    }
    PH_END;
    if (PH_ON) { PH_LOCALS
        constexpr int N_S3D = NB_S * NG;
        if (G > N_S3D) {
            if (bid < N_S3D) { const int bs = bid / NG, g = bid % NG;
                ssd3_item(a, 1, (size_t)M_P + (size_t)bs * L_S, 1, g, nullptr, a.in(I_SSSM) + (size_t)(1 * NB_S + bs) * NH * HD * NS, 2, a.in(I_SCONV) + (size_t)(1 * NB_S + bs) * 3 * XBC,
                          X + OUT_SSM_S + (size_t)(1 * NB_S + bs) * NH * HD * NS, X + OUT_CONV_S + (size_t)(1 * NB_S + bs) * 3 * XBC, PB, DT, lds, tid, wave, lane); }
            else ssd2_phase((unsigned char*)X, gw - N_S3D * NWAVES, NGW - N_S3D * NWAVES, lane);
        } else {
            for (int j = bid; j < N_S3D; j += G) { const int bs = j / NG, g = j % NG;
                ssd3_item(a, 1, (size_t)M_P + (size_t)bs * L_S, 1, g, nullptr, a.in(I_SSSM) + (size_t)(1 * NB_S + bs) * NH * HD * NS, 2, a.in(I_SCONV) + (size_t)(1 * NB_S + bs) * 3 * XBC,
                          X + OUT_SSM_S + (size_t)(1 * NB_S + bs) * NH * HD * NS, X + OUT_CONV_S + (size_t)(1 * NB_S + bs) * 3 * XBC, PB, DT, lds, tid, wave, lane); }
            ssd2_phase((unsigned char*)X, gw, NGW, lane);
        }
    }
    PH_END;
    if (PH_ON) { PH_LOCALS
        constexpr int N_S3P = NB_P * NSC * NG;
        for (int it = bid; it < N_S3P; it += G) {
            { const int b = it / (NSC * NG), k = (it / NG) % NSC, g = it % NG; const bool lastk = (k == NSC - 1);
                ssd3_item(a, 1, (size_t)b * SEQ + (size_t)k * SC * 64, SC, g, k ? (const float*)((unsigned char*)X + WSO_ST) + ((size_t)b * NSC1 + (k - 1)) * NH * ST_ELEMS : nullptr, nullptr, k ? 1 : 0, nullptr,
                          lastk ? X + OUT_SSM_P + (size_t)(1 * NB_P + b) * NH * HD * NS : nullptr, lastk ? X + OUT_CONV_P + (size_t)(1 * NB_P + b) * 3 * XBC : nullptr, PB, DT, lds, tid, wave, lane); }
        }
    }
    PH_END;
    if (PH_ON) { PH_LOCALS
        { pg8::Gemm g{PB + PC_Z, Wb + WO_A, LDP, KP_D, M_TOK, D, DIN}; pg8::StaticOrder S; S.init(M_TOK, D, DIN, G, bid, WGM_N2K);
          EpiMerge<0> E{PB + PC_GA, PB + PC_MRG}; pg8::gemm_phase<EpiMerge<0>, pg8::StaticOrder, true, true>(lds, g, S, E, wave); }
        { pg8::Gemm g{PB + PC_U, Wb + WO_B, LDP, KP_G, M_TOK, D, GMW}; pg8::StaticOrder S; S.init(M_TOK, D, GMW, G, bid, WGM_N2K);
          EpiMerge<1> E{PB + PC_GB, PB + PC_MRG}; pg8::gemm_phase<EpiMerge<1>, pg8::StaticOrder, true, true>(lds, g, S, E, wave); }
    }
    PH_END;
    if (PH_ON) { PH_LOCALS pg8::Gemm g{PB + PC_MRG, Wb + WO_O, LDP, KP_D, M_TOK, D, D}; pg8::TailSplitOrder S; S.init(M_P, M_TOK - M_P, M_P / 256, D, D, G, bid, WGM_N2K, 0);
        EpiRes<false> E{nullptr, nullptr, XT, M_P, 1.0f, PART, SSQ}; pg8::gemm_phase<EpiRes<false>, pg8::TailSplitOrder, true, true>(lds, g, S, E, wave); }
    PH_END;
    if (PH_ON) { PH_LOCALS phase_rstd<true>(SSQ, RS, PART, XT, gw, NGW, lane, gtid, NGT); }
    PH_END;
    if (PH_ON) { PH_LOCALS pg8::Gemm g{XT, Wb + WO_GU2, XBP, KP_D, M_TOK, FF2, D}; pg8::StaticOrder S; S.init(M_TOK, FF2, D, G, bid, WGM_WIDE);
        EpiGU E{AB, LDF, RS}; pg8::gemm_phase<EpiGU, pg8::StaticOrder, true, true>(lds, g, S, E, wave); }
    PH_END;
    if (PH_ON) { PH_LOCALS
        pg8::Gemm g{AB, Wb + WO_D2, LDF, KP_F, M_TOK, D, FF}; pg8::TailSplitOrder S; S.init(M_P, M_TOK - M_P, M_P / 256, D, FF, G, bid, WGM_N2K, 0);
        EpiRes<false> E{nullptr, nullptr, XT, M_P, 0.5f, PART, SSQ}; pg8::gemm_phase<EpiRes<false>, pg8::TailSplitOrder, true, true>(lds, g, S, E, wave); }
    PH_END;
    if (PH_ON) { PH_LOCALS phase_rstd<true>(SSQ, RS, PART, XT, gw, NGW, lane, gtid, NGT); }
    PH_END;
    if (PH_ON) { PH_LOCALS
        { pg8::Gemm g{XT, Wb + WO_PG, XBP, KP_D, M_TOK, D, D}; pg8::StaticOrder S; S.init(M_TOK, D, D, G, bid, WGM_N2K);
          EpiPg E{PB + PC_TMP, RS}; pg8::gemm_phase<EpiPg, pg8::StaticOrder, true, true>(lds, g, S, E, wave); }
        { pg8::Gemm g{PE2, Wb + WO_PP, LDE, KP_E, M_TOK, D, PLE}; pg8::StaticOrder S; S.init(M_TOK, D, PLE, G, bid, WGM_N2K);
          EpiPle E{PB + PC_TMP, XT, XS, SSQ}; pg8::gemm_phase<EpiPle, pg8::StaticOrder, true, true>(lds, g, S, E, wave); }
    }
    PH_END;
    if (PH_ON) { PH_LOCALS phase_final_norm(XS, X, a.in(I_FINN), gw, NGW, lane); }
    PH_END;
#undef PH_ON
#undef PH_END
}

extern "C" void kernel_launch(void* const* d_in, const int* in_sizes, int n_in, void* d_out, int out_size, void* d_ws, size_t ws_size, hipStream_t stream) {
    static int grid = 0;
    if (grid == 0) {
        if (n_in != N_IN || (size_t)out_size != OUT_END || ws_size < WS_END) { fprintf(stderr, "kernel_launch: unexpected problem: n_in %d out %d ws %zu (need %zu)\n", n_in, out_size, ws_size, (size_t)WS_END); grid = -1; return; }
        int dev = 0, cus = 0, per_cu = 0;
        if (hipGetDevice(&dev) != hipSuccess || hipDeviceGetAttribute(&cus, hipDeviceAttributeMultiprocessorCount, dev) != hipSuccess) { grid = -1; return; }
        if (hipFuncSetAttribute((const void*)mk_fwd, hipFuncAttributeMaxDynamicSharedMemorySize, LDS_BYTES) != hipSuccess) { fprintf(stderr, "kernel_launch: hipFuncSetAttribute failed\n"); grid = -1; return; }
        if (hipOccupancyMaxActiveBlocksPerMultiprocessor(&per_cu, (const void*)mk_fwd, NTHREADS, LDS_BYTES) != hipSuccess || per_cu < 1) { fprintf(stderr, "kernel_launch: occupancy query says %d blocks per CU\n", per_cu); (void)hipGetLastError(); grid = -1; return; }
        grid = cus;
    }
    if (grid < 0) return;
    (void)in_sizes;
    if (hipMemsetAsync((char*)d_ws + WS_CTL, 0, CTL_ZERO_BYTES, stream) != hipSuccess) return;
    Args a{};
    for (int i = 0; i < N_IN; ++i) a.in[i] = (const float*)d_in[i];
    a.out = (float*)d_out; a.ws = (unsigned char*)d_ws;
#if MK_PER_PHASE
    #ifndef DBG_LIMIT
#define DBG_LIMIT N_PHASES
#endif
    for (int p = 0; p < DBG_LIMIT; ++p) { a.ph_lo = p; a.ph_hi = p + 1; hipLaunchKernelGGL(mk_fwd, dim3(grid), dim3(NTHREADS), LDS_BYTES, stream, a); }
#else
    a.ph_lo = 0; a.ph_hi = N_PHASES; hipLaunchKernelGGL(mk_fwd, dim3(grid), dim3(NTHREADS), LDS_BYTES, stream, a);
#endif
    const hipError_t le = hipPeekAtLastError();
    if (le != hipSuccess) fprintf(stderr, "kernel_launch: launch failed: %s\n", hipGetErrorName(le));
}
```

```cpp
#include <hip/hip_runtime.h>
#include <cstdio>
#include <cstdint>

namespace pg8 {
#define PG8_LAS __attribute__((address_space(3)))
typedef unsigned short bf16_t;
typedef short bf16x8 __attribute__((ext_vector_type(8)));
typedef float f32x4 __attribute__((ext_vector_type(4)));
typedef float f32x2 __attribute__((ext_vector_type(2)));
typedef unsigned u32x4 __attribute__((ext_vector_type(4)));
typedef unsigned u32x2 __attribute__((ext_vector_type(2)));
constexpr int BM = 256, BK = 64, HALF = 128, HTB = HALF * BK * 2  , STAGE_BYTES = 8 * HTB, NXCD = 8, WGM = 8;

__host__ __device__ __forceinline__ int lds_byte(int r, int c) { const int st = (r >> 4) * 2 + (c >> 5), rr = r & 15, cc = c & 31, ob = rr * 64 + cc * 2; return st * 1024 + (ob ^ (((ob >> 9) & 1) << 5)); }
__host__ __device__ __forceinline__ void stage_rc(int b, int& R, int& C) { const int st = b / 1024, sb = b % 1024, swz = sb ^ (((sb >> 9) & 1) << 5); R = (st >> 1) * 16 + swz / 64; C = (st & 1) * 32 + (swz % 64) / 2; }
__host__ __device__ __forceinline__ int perm32(int rho) { const int n = rho >> 4, i = rho & 15; return 8 * (i >> 2) + 4 * n + (i & 3); }

struct Unit { int pm, pn, kt0, ktn, slice; };
struct Gemm { const bf16_t* A; const bf16_t* Bt; int lda, ldb, M, N, K; };

struct StaticOrder {
    int nM, nN, nwg, G, c, ntk, wgm, pmb;
    __host__ __device__ __forceinline__ void init(int M, int N, int K, int G_, int c_, int wgm_ = WGM, int pmb_ = 0) { nM = M / BM; nN = N / BM; nwg = nM * nN; G = G_; c = c_; ntk = K / BK; wgm = wgm_; pmb = pmb_; }
    __host__ __device__ __forceinline__ void tile_of(int L, int& pm, int& pn) const {
        int wgid = L; { const int q = nwg / NXCD, r = nwg % NXCD, xcd = wgid % NXCD, off = wgid / NXCD; wgid = (xcd < r ? xcd * (q + 1) : r * (q + 1) + (xcd - r) * q) + off; }
        const int nig = wgm * nN, gid = wgid / nig, fm = gid * wgm, gsz = (nM - fm) < wgm ? (nM - fm) : wgm;
        pm = pmb + fm + ((wgid % nig) % gsz); pn = (wgid % nig) / gsz;
    }
    __host__ __device__ __forceinline__ bool next(int i, Unit& u) const {
        const long L = (long)i * G + c; const bool ok = L < nwg;
        int pm, pn; tile_of(ok ? (int)L : 0, pm, pn);
        u.pm = pm; u.pn = pn; u.kt0 = 0; u.ktn = ntk; u.slice = -1; return ok;
    }
    __device__ __forceinline__ void a_ready(const Unit&) const {}
    __device__ __forceinline__ void done(const Unit&) const {}
};
struct TailSplitOrder : StaticOrder {
    int nmain, ntail, pm0;
    __host__ __device__ __forceinline__ void init(int M_main, int M_tail, int pmt, int N, int K, int G_, int c_, int wgm_ = WGM, int pmb_ = 0) { StaticOrder::init(M_main, N, K, G_, c_, wgm_, pmb_); nmain = nwg; pm0 = pmt; ntail = M_tail / BM * nN * 8; }
    __host__ __device__ __forceinline__ bool next(int i, Unit& u) const {
        const long L = (long)i * G + c; const bool is_main = L < nmain; const long ti = L - nmain; const bool ok = is_main || ti < ntail;
        int pm, pn; tile_of(is_main ? (int)L : 0, pm, pn);
        const int idx = (!is_main && ok) ? (int)ti : 0, tl = idx >> 3, sl = idx & 7, half = ntk >> 1, q = half >> 3, r = half & 7;
        u.pm = is_main ? pm : pm0 + tl / nN; u.pn = is_main ? pn : tl % nN;
        u.kt0 = is_main ? 0 : 2 * (sl * q + (sl < r ? sl : r)); u.ktn = is_main ? ntk : 2 * (q + (sl < r ? 1 : 0)); u.slice = is_main ? -1 : sl; return ok;
    }
};

typedef __bf16 bf16x2_hw __attribute__((ext_vector_type(2)));
__device__ __forceinline__ unsigned cvt_pk_bf16(float lo, float hi) { const f32x2 v = {lo, hi}; const bf16x2_hw b = __builtin_convertvector(v, bf16x2_hw); return __builtin_bit_cast(unsigned, b); }

template <class Epi, class Sched, bool ALIGN_EPI = false, bool SP2 = false>
__device__ __forceinline__ void gemm_phase(PG8_LAS unsigned char* lds, const Gemm g, const Sched& S, const Epi& E, const int wid  ) {
    int lane = (int)__builtin_amdgcn_mbcnt_hi(~0u, __builtin_amdgcn_mbcnt_lo(~0u, 0u)); asm volatile("" : "+v"(lane));
    const int tid = wid * 64 + lane, wr = wid >> 2, wc = wid & 3, fr = lane & 15, fq = lane >> 4;
    unsigned voffA[2], voffB[2];
#pragma unroll
    for (int i = 0; i < 2; ++i) { int R, C; stage_rc(tid * 16 + i * 8192, R, C); const int Rb = Epi::PERM ? ((R & ~31) + perm32(R & 31)) : R;
        voffA[i] = (unsigned)(R * g.lda + C) * 2u; voffB[i] = (unsigned)(Rb * g.ldb + C) * 2u; }
    const size_t kstep = (size_t)(BK * 2);
    const size_t hsA = (size_t)HALF * g.lda * 2, hsB = (size_t)HALF * g.ldb * 2;
    const size_t tsA = 2 * hsA, tsB = 2 * hsB;
    const unsigned ldsw = (unsigned)wid * 1024u;
    const int aoff = lds_byte(wr * 64 + fr, fq * 8), boff = lds_byte(wc * 32 + fr, fq * 8);
#define PG8_SA(b, h) (((b) * 2 + (h)) * HTB)
#define PG8_SB(b, h) ((4 + (b) * 2 + (h)) * HTB)
#define PG8_STAGE(bufoff, gbase, voff) do { _Pragma("unroll") for (int _i = 0; _i < 2; ++_i) \
        __builtin_amdgcn_global_load_lds((const unsigned*)((const char*)(gbase) + (voff)[_i]), (PG8_LAS unsigned*)(lds + (bufoff) + ldsw + _i * 8192), 16, 0, 0); } while (0)
#define PG8_LDA(dst, b, h) do { _Pragma("unroll") for (int m = 0; m < 4; ++m) _Pragma("unroll") for (int k = 0; k < 2; ++k) dst[m][k] = *(const PG8_LAS bf16x8*)(lds + PG8_SA(b, h) + aoff + m * 2048 + k * 1024); } while (0)
#define PG8_LDB(dst, b, h) do { _Pragma("unroll") for (int n = 0; n < 2; ++n) _Pragma("unroll") for (int k = 0; k < 2; ++k) dst[n][k] = *(const PG8_LAS bf16x8*)(lds + PG8_SB(b, h) + boff + n * 2048 + k * 1024); } while (0)
#define PG8_MMA(ai, bj, At, Bt) do { __builtin_amdgcn_s_setprio(1); _Pragma("unroll") for (int m = 0; m < 4; ++m) _Pragma("unroll") for (int n = 0; n < 2; ++n) _Pragma("unroll") for (int k = 0; k < 2; ++k) \
        acc[ai][bj][m][n] = __builtin_amdgcn_mfma_f32_16x16x32_bf16(Bt[n][k], At[m][k], acc[ai][bj][m][n], 0, 0, 0); __builtin_amdgcn_s_setprio(0); } while (0)
#define PG8_WAIT_V(n) asm volatile("s_waitcnt vmcnt(" #n ")" ::: "memory")
#define PG8_WAIT_L(n) asm volatile("s_waitcnt lgkmcnt(" #n ")" ::: "memory")
#define PG8_BAR __builtin_amdgcn_s_barrier()
#define PG8_SCHED __builtin_amdgcn_sched_barrier(0)
    Unit cur, nxt; int ui = 0;
    if (!S.next(0, cur)) return;
    f32x4 acc[2][2][4][2];
#pragma unroll
    for (int a = 0; a < 2; ++a)
#pragma unroll
        for (int b = 0; b < 2; ++b)
#pragma unroll
            for (int m = 0; m < 4; ++m)
#pragma unroll
                for (int n = 0; n < 2; ++n) acc[a][b][m][n] = (f32x4){0.f, 0.f, 0.f, 0.f};
    bf16x8 At[4][2], B0[2][2], B1[2][2];
    const char* cA = (const char*)g.A + (size_t)cur.pm * tsA + (size_t)cur.kt0 * kstep; const char* cB = (const char*)g.Bt + (size_t)cur.pn * tsB + (size_t)cur.kt0 * kstep;
    S.a_ready(cur);
    if constexpr (SP2) {
        PG8_STAGE(PG8_SB(0, 0), cB, voffB); PG8_STAGE(PG8_SB(0, 1), cB + hsB, voffB); PG8_STAGE(PG8_SA(0, 0), cA, voffA); PG8_STAGE(PG8_SA(0, 1), cA + hsA, voffA);
        if (wr == 1) PG8_BAR;
        PG8_WAIT_V(2); PG8_BAR;
        PG8_STAGE(PG8_SB(1, 0), cB + kstep, voffB); PG8_STAGE(PG8_SA(1, 0), cA + kstep, voffA); PG8_STAGE(PG8_SB(1, 1), cB + hsB + kstep, voffB);
        PG8_WAIT_V(6); PG8_BAR;
    } else {
        PG8_STAGE(PG8_SB(0, 0), cB, voffB); PG8_STAGE(PG8_SA(0, 0), cA, voffA); PG8_STAGE(PG8_SB(0, 1), cB + hsB, voffB); PG8_STAGE(PG8_SA(0, 1), cA + hsA, voffA);
        if (wr == 1) PG8_BAR;
        PG8_WAIT_V(4); PG8_BAR;
        PG8_STAGE(PG8_SB(1, 0), cB + kstep, voffB); PG8_STAGE(PG8_SA(1, 0), cA + kstep, voffA); PG8_STAGE(PG8_SB(1, 1), cB + hsB + kstep, voffB);
        PG8_WAIT_V(6); PG8_BAR;
    }
    for (;;) {
        const bool has_next = S.next(ui + 1, nxt); const int nt = cur.ktn;
        const char* nA = has_next ? (const char*)g.A + (size_t)nxt.pm * tsA + (size_t)nxt.kt0 * kstep : cA; const char* nB = has_next ? (const char*)g.Bt + (size_t)nxt.pn * tsB + (size_t)nxt.kt0 * kstep : cB;
        for (int t = 0; t < nt; t += 2) {
            const bool last = (t == nt - 2);
            const char* a1 = cA + (size_t)(t + 1) * kstep;
            const char* a2 = last ? nA : cA + (size_t)(t + 2) * kstep; const char* b2 = last ? nB : cB + (size_t)(t + 2) * kstep;
            const char* a3 = a2 + kstep; const char* b3 = b2 + kstep;
            if (last && has_next) S.a_ready(nxt);
            if constexpr (SP2) {
            PG8_LDB(B0, 0, 0); PG8_LDB(B1, 0, 1); PG8_SCHED; PG8_LDA(At, 0, 0); PG8_STAGE(PG8_SA(1, 1), a1 + hsA, voffA);
            PG8_WAIT_V(8); PG8_WAIT_L(0); PG8_BAR; PG8_MMA(0, 0, At, B0); PG8_MMA(0, 1, At, B1); PG8_BAR; PG8_SCHED;
            PG8_LDA(At, 0, 1); PG8_STAGE(PG8_SB(0, 0), b2, voffB); PG8_STAGE(PG8_SB(0, 1), b2 + hsB, voffB); PG8_STAGE(PG8_SA(0, 0), a2, voffA);
            PG8_WAIT_V(8); PG8_WAIT_L(0); PG8_BAR; PG8_MMA(1, 0, At, B0); PG8_MMA(1, 1, At, B1); PG8_BAR; PG8_SCHED;
            PG8_LDB(B0, 1, 0); PG8_LDB(B1, 1, 1); PG8_SCHED; PG8_LDA(At, 1, 0); PG8_STAGE(PG8_SA(0, 1), a2 + hsA, voffA);
            PG8_WAIT_V(8); PG8_WAIT_L(0); PG8_BAR; PG8_MMA(0, 0, At, B0); PG8_MMA(0, 1, At, B1); PG8_BAR; PG8_SCHED;
            PG8_LDA(At, 1, 1); PG8_STAGE(PG8_SB(1, 0), b3, voffB); PG8_STAGE(PG8_SB(1, 1), b3 + hsB, voffB); PG8_STAGE(PG8_SA(1, 0), a3, voffA);
            PG8_WAIT_V(8); PG8_WAIT_L(0); PG8_BAR; PG8_MMA(1, 0, At, B0); PG8_MMA(1, 1, At, B1); PG8_BAR; PG8_SCHED;
            } else {
            PG8_LDB(B0, 0, 0); PG8_SCHED; PG8_LDA(At, 0, 0); PG8_STAGE(PG8_SA(1, 1), a1 + hsA, voffA);
            PG8_WAIT_L(8); PG8_BAR; PG8_WAIT_L(0); PG8_MMA(0, 0, At, B0); PG8_BAR; PG8_SCHED;
            PG8_LDB(B1, 0, 1); PG8_STAGE(PG8_SB(0, 0), b2, voffB);
            PG8_BAR; PG8_WAIT_L(0); PG8_MMA(0, 1, At, B1); PG8_BAR;
            PG8_LDA(At, 0, 1); PG8_STAGE(PG8_SA(0, 0), a2, voffA);
            PG8_BAR; PG8_WAIT_L(0); PG8_MMA(1, 0, At, B0); PG8_BAR; PG8_SCHED;
            PG8_STAGE(PG8_SB(0, 1), b2 + hsB, voffB);
            PG8_WAIT_V(6); PG8_BAR; PG8_MMA(1, 1, At, B1); PG8_BAR;
            PG8_LDB(B0, 1, 0); PG8_SCHED; PG8_LDA(At, 1, 0); PG8_STAGE(PG8_SA(0, 1), a2 + hsA, voffA);
            PG8_WAIT_L(8); PG8_BAR; PG8_WAIT_L(0); PG8_MMA(0, 0, At, B0); PG8_BAR; PG8_SCHED;
            PG8_LDB(B1, 1, 1); PG8_STAGE(PG8_SB(1, 0), b3, voffB);
            PG8_BAR; PG8_WAIT_L(0); PG8_MMA(0, 1, At, B1); PG8_BAR;
            PG8_LDA(At, 1, 1); PG8_STAGE(PG8_SA(1, 0), a3, voffA);
            PG8_BAR; PG8_WAIT_L(0); PG8_MMA(1, 0, At, B0); PG8_BAR; PG8_SCHED;
            PG8_STAGE(PG8_SB(1, 1), b3 + hsB, voffB);
            PG8_WAIT_V(6); PG8_BAR; PG8_MMA(1, 1, At, B1); PG8_BAR;
            }
        }
        if constexpr (ALIGN_EPI) { if (wr == 0) PG8_BAR; }
        E(acc, cur, wr, wc, fr, fq); S.done(cur);
        if (!has_next) break;
#pragma unroll
        for (int a = 0; a < 2; ++a)
#pragma unroll
            for (int b = 0; b < 2; ++b)
#pragma unroll
                for (int m = 0; m < 4; ++m)
#pragma unroll
                    for (int n = 0; n < 2; ++n) acc[a][b][m][n] = (f32x4){0.f, 0.f, 0.f, 0.f};
        cur = nxt; cA = nA; cB = nB; ++ui;
        if constexpr (ALIGN_EPI) { if (wr == 1) PG8_BAR; }
    }
    PG8_WAIT_V(0);
    if constexpr (!ALIGN_EPI) { if (wr == 0) PG8_BAR; }
    PG8_BAR;
#undef PG8_SA
#undef PG8_SB
#undef PG8_STAGE
#undef PG8_LDA
#undef PG8_LDB
#undef PG8_MMA
#undef PG8_WAIT_V
#undef PG8_WAIT_L
#undef PG8_BAR
#undef PG8_SCHED
}
}

constexpr int D = 2048, SEQ = 8192, NB_P = 4, NB_S = 16, L_S = 64, DEPTH = 2;
constexpr int M_P = NB_P * SEQ;
constexpr int M_TOK = M_P + NB_S * L_S;
constexpr int FF = 5632, FF2 = 2 * FF;
constexpr int NH = 32, HD = 64, NG = 4, NS = 128, XBC = 3072, DIN = 2048;
constexpr int GMW = 1024, PLE = 256, INC = 11296;
constexpr int NIN = 11520;
constexpr int LDP = 11520;
constexpr int LDH = 2048, LDF = 5632, LDE = 256;
constexpr int KP_D = 2048, KP_F = 5632, KP_G = 1024, KP_E = 256;
constexpr int PC_Z = 0, PC_XBC = 2048, PC_U = 5120, PC_V = 6144, PC_GA = 7168, PC_GB = 9216, PC_DT = 11264;
constexpr int PC_MRG = 2048;
constexpr int PC_TMP = 0;
constexpr float EPS = 1e-6f;

typedef unsigned short bf16;
typedef pg8::f32x4 f32x4;
typedef pg8::f32x2 f32x2;
typedef pg8::u32x4 u32x4;
typedef pg8::u32x2 u32x2;
#define LAS __attribute__((address_space(3)))

__device__ __forceinline__ float bf2f(bf16 b) { return __uint_as_float(((unsigned)b) << 16); }
__device__ __forceinline__ float bflo(unsigned w) { return __uint_as_float(w << 16); }
__device__ __forceinline__ float bfhi(unsigned w) { return __uint_as_float(w & 0xffff0000u); }
__device__ __forceinline__ bf16 f2bf(float f) { return (bf16)(pg8::cvt_pk_bf16(f, 0.f) & 0xffffu); }
__device__ __forceinline__ unsigned pk2(float lo, float hi) { return pg8::cvt_pk_bf16(lo, hi); }
__device__ __forceinline__ float fast_sigmoid(float x) { return __builtin_amdgcn_rcpf(1.f + __builtin_amdgcn_exp2f(-1.4426950409f * x)); }
__device__ __forceinline__ float fast_silu(float x) { return x * fast_sigmoid(x); }
__device__ __forceinline__ float fast_gelu_tanh(float x) { const float y = 0.7978845608f * (x + 0.044715f * x * x * x); return x * fast_sigmoid(2.f * y); }
__device__ __forceinline__ float softplus_f(float x) { return x > 20.f ? x : log1pf(expf(x)); }

using pg8::Unit;
struct EpiGU {
    static constexpr bool PERM = false;
    bf16* O; int ldc; const float* RS;
    mutable int pmc; mutable float rs[2][4];
    __device__ __forceinline__ void operator()(const f32x4 (&acc)[2][2][4][2], const Unit& u, int wr, int wc, int fr, int fq) const {
        const int row0 = u.pm * 256 + wr * 64 + fr, col0 = u.pn * 128 + wc * 32 + 8 * fq;
        if (pmc != u.pm + 1) { pmc = u.pm + 1;
#pragma unroll
            for (int ai = 0; ai < 2; ++ai)
#pragma unroll
                for (int m = 0; m < 4; ++m) rs[ai][m] = RS[row0 + ai * 128 + m * 16]; }
#pragma unroll
        for (int ai = 0; ai < 2; ++ai)
#pragma unroll
            for (int m = 0; m < 4; ++m) { bf16* rowp = O + (size_t)(row0 + ai * 128 + m * 16) * ldc + col0;
                const float rl = -1.4426950409f * rs[ai][m], r2 = rs[ai][m] * rs[ai][m];
                const f32x4 g0 = acc[ai][0][m][0], u0 = acc[ai][0][m][1], g1 = acc[ai][1][m][0], u1 = acc[ai][1][m][1];
                const f32x4 p0 = g0 * u0 * r2, p1 = g1 * u1 * r2, e0 = g0 * rl, e1 = g1 * rl;
                float o[8];
#pragma unroll
                for (int j = 0; j < 4; ++j) { o[j] = p0[j] * __builtin_amdgcn_rcpf(1.f + __builtin_amdgcn_exp2f(e0[j])); o[4 + j] = p1[j] * __builtin_amdgcn_rcpf(1.f + __builtin_amdgcn_exp2f(e1[j])); }
                u32x4 w; w.x = pk2(o[0], o[1]); w.y = pk2(o[2], o[3]); w.z = pk2(o[4], o[5]); w.w = pk2(o[6], o[7]);
                *(u32x4*)rowp = w; }
    }
};
__device__ __forceinline__ float ssq8(const f32x4 a, const f32x4 b) { return ((a[0] * a[0] + a[1] * a[1]) + (a[2] * a[2] + a[3] * a[3])) + ((b[0] * b[0] + b[1] * b[1]) + (b[2] * b[2] + b[3] * b[3])); }
__device__ __forceinline__ void ssq_emit(float* SSQ, float s, int plane, int row, int fq) { s += __shfl_xor(s, 16); s += __shfl_xor(s, 32); if (fq == 0) SSQ[(size_t)plane * M_TOK + row] = s; }
constexpr int XBP = D;
__device__ __forceinline__ void unpack8(const u32x4 w, f32x4& lo, f32x4& hi) { lo = (f32x4){bflo(w.x), bfhi(w.x), bflo(w.y), bfhi(w.y)}; hi = (f32x4){bflo(w.z), bfhi(w.z), bflo(w.w), bfhi(w.w)}; }
__device__ __forceinline__ u32x4 pack8u(const f32x4 lo, const f32x4 hi) { return (u32x4){pk2(lo[0], lo[1]), pk2(lo[2], lo[3]), pk2(hi[0], hi[1]), pk2(hi[2], hi[3])}; }
template <bool SRC_F32> struct EpiRes {
    static constexpr bool PERM = true;
    const float* rlo; const float* rhi; bf16* XB; int split; float alpha; float* part; float* SSQ;
    __device__ __forceinline__ void operator()(const f32x4 (&acc)[2][2][4][2], const Unit& u, int wr, int wc, int fr, int fq) const {
        const int row0 = u.pm * 256 + wr * 64 + fr, col0 = u.pn * 256 + wc * 32 + 8 * fq;
        if (u.slice >= 0) {
#pragma unroll
            for (int ai = 0; ai < 2; ++ai)
#pragma unroll
                for (int m = 0; m < 4; ++m) { float* pp = part + ((size_t)u.slice * (M_TOK - M_P) + (size_t)(row0 + ai * 128 + m * 16 - split)) * D + col0;
#pragma unroll
                    for (int bj = 0; bj < 2; ++bj) { *(f32x4*)(pp + bj * 128) = alpha * acc[ai][bj][m][0]; *(f32x4*)(pp + bj * 128 + 4) = alpha * acc[ai][bj][m][1]; } }
            return;
        }
#pragma unroll
        for (int ai = 0; ai < 2; ++ai) {
            f32x4 r0[4][2], r1[4][2];
#pragma unroll
            for (int m = 0; m < 4; ++m) { const int r = row0 + ai * 128 + m * 16;
#pragma unroll
                for (int bj = 0; bj < 2; ++bj) {
                    if (SRC_F32) { const float* rp = (r < split ? rlo + (size_t)r * D : rhi + (size_t)(r - split) * D) + col0 + bj * 128; r0[m][bj] = *(const f32x4*)rp; r1[m][bj] = *(const f32x4*)(rp + 4); }
                    else unpack8(*(const u32x4*)(XB + (size_t)r * XBP + col0 + bj * 128), r0[m][bj], r1[m][bj]); } }
#pragma unroll
            for (int m = 0; m < 4; ++m) { bf16* xp = XB + (size_t)(row0 + ai * 128 + m * 16) * XBP + col0; float sq = 0.f;
#pragma unroll
                for (int bj = 0; bj < 2; ++bj) { const f32x4 x0 = r0[m][bj] + alpha * acc[ai][bj][m][0], x1 = r1[m][bj] + alpha * acc[ai][bj][m][1]; sq += ssq8(x0, x1); *(u32x4*)(xp + bj * 128) = pack8u(x0, x1); }
                ssq_emit(SSQ, sq, u.pn * 4 + wc, row0 + ai * 128 + m * 16, fq); }
            asm volatile("" ::: "memory"); }
    }
};
struct EpiInProj {
    static constexpr bool PERM = true;
    bf16* P; float* DT; const float* dt_bias; const float* RS;
    mutable int pmc; mutable float rsc[2][4];
    __device__ __forceinline__ void operator()(const f32x4 (&acc)[2][2][4][2], const Unit& u, int wr, int wc, int fr, int fq) const {
        const int row0 = u.pm * 256 + wr * 64 + fr, col0 = u.pn * 256 + wc * 32 + 8 * fq;
        const int mode = u.pn < 8 ? 0 : u.pn < 20 ? 1 : u.pn < 28 ? 2 : u.pn < 44 ? 3 : 4;
        if (pmc != u.pm + 1) { pmc = u.pm + 1;
#pragma unroll
            for (int ai = 0; ai < 2; ++ai)
#pragma unroll
                for (int m = 0; m < 4; ++m) rsc[ai][m] = RS[row0 + ai * 128 + m * 16]; }
        if (mode == 4) {
            if (wc == 0) {
                const f32x4 b0 = *(const f32x4*)(dt_bias + 8 * fq), b1 = *(const f32x4*)(dt_bias + 8 * fq + 4);
#pragma unroll
                for (int ai = 0; ai < 2; ++ai)
#pragma unroll
                    for (int m = 0; m < 4; ++m) { float* dp = DT + (size_t)(row0 + ai * 128 + m * 16) * 32 + 8 * fq; const float rs = rsc[ai][m];
                        f32x4 v0 = acc[ai][0][m][0] * rs + b0, v1 = acc[ai][0][m][1] * rs + b1;
#pragma unroll
                        for (int j = 0; j < 4; ++j) { v0[j] = softplus_f(v0[j]); v1[j] = softplus_f(v1[j]); }
                        *(f32x4*)dp = v0; *(f32x4*)(dp + 4) = v1; }
            }
            return;
        }
#pragma unroll
        for (int ai = 0; ai < 2; ++ai)
#pragma unroll
            for (int m = 0; m < 4; ++m) { bf16* rowp = P + (size_t)(row0 + ai * 128 + m * 16) * LDP + col0; const float rs = rsc[ai][m];
#pragma unroll
                for (int bj = 0; bj < 2; ++bj) { f32x4 v0 = acc[ai][bj][m][0] * rs, v1 = acc[ai][bj][m][1] * rs;
                    if (mode == 0) {
#pragma unroll
                        for (int j = 0; j < 4; ++j) { v0[j] = fast_silu(v0[j]); v1[j] = fast_silu(v1[j]); } }
                    else if (mode == 2) {
#pragma unroll
                        for (int j = 0; j < 4; ++j) { v0[j] = fast_gelu_tanh(v0[j]); v1[j] = fast_gelu_tanh(v1[j]); } }
                    else if (mode == 3) {
#pragma unroll
                        for (int j = 0; j < 4; ++j) { v0[j] = fast_sigmoid(v0[j]); v1[j] = fast_sigmoid(v1[j]); } }
                    u32x4 w; w.x = pk2(v0[0], v0[1]); w.y = pk2(v0[2], v0[3]); w.z = pk2(v1[0], v1[1]); w.w = pk2(v1[2], v1[3]);
                    *(u32x4*)(rowp + bj * 128) = w; } }
    }
};
template <int MODE> struct EpiMerge {
    static constexpr bool PERM = true;
    const bf16* Gt; bf16* T;
    __device__ __forceinline__ void operator()(const f32x4 (&acc)[2][2][4][2], const Unit& u, int wr, int wc, int fr, int fq) const {
        const int row0 = u.pm * 256 + wr * 64 + fr, col0 = u.pn * 256 + wc * 32 + 8 * fq;
#pragma unroll
        for (int ai = 0; ai < 2; ++ai) {
            u32x4 gg[4][2], tt[4][2];
#pragma unroll
            for (int m = 0; m < 4; ++m) { const size_t ro = (size_t)(row0 + ai * 128 + m * 16) * LDP + col0;
#pragma unroll
                for (int bj = 0; bj < 2; ++bj) { gg[m][bj] = *(const u32x4*)(Gt + ro + bj * 128); if (MODE == 1) tt[m][bj] = *(const u32x4*)(T + ro + bj * 128); } }
#pragma unroll
            for (int m = 0; m < 4; ++m) { const size_t ro = (size_t)(row0 + ai * 128 + m * 16) * LDP + col0;
#pragma unroll
                for (int bj = 0; bj < 2; ++bj) { const u32x4 g4 = gg[m][bj];
                    f32x4 v0 = acc[ai][bj][m][0], v1 = acc[ai][bj][m][1];
                    v0[0] *= bflo(g4.x); v0[1] *= bfhi(g4.x); v0[2] *= bflo(g4.y); v0[3] *= bfhi(g4.y); v1[0] *= bflo(g4.z); v1[1] *= bfhi(g4.z); v1[2] *= bflo(g4.w); v1[3] *= bfhi(g4.w);
                    if (MODE == 1) { const u32x4 t4 = tt[m][bj];
                        v0[0] += bflo(t4.x); v0[1] += bfhi(t4.x); v0[2] += bflo(t4.y); v0[3] += bfhi(t4.y); v1[0] += bflo(t4.z); v1[1] += bfhi(t4.z); v1[2] += bflo(t4.w); v1[3] += bfhi(t4.w); }
                    u32x4 w; w.x = pk2(v0[0], v0[1]); w.y = pk2(v0[2], v0[3]); w.z = pk2(v1[0], v1[1]); w.w = pk2(v1[2], v1[3]);
                    *(u32x4*)(T + ro + bj * 128) = w; } }
            asm volatile("" ::: "memory"); }
    }
};
struct EpiPg {
    static constexpr bool PERM = true;
    bf16* T; const float* RS;
    __device__ __forceinline__ void operator()(const f32x4 (&acc)[2][2][4][2], const Unit& u, int wr, int wc, int fr, int fq) const {
        const int row0 = u.pm * 256 + wr * 64 + fr, col0 = u.pn * 256 + wc * 32 + 8 * fq;
#pragma unroll
        for (int ai = 0; ai < 2; ++ai)
#pragma unroll
            for (int m = 0; m < 4; ++m) { bf16* rowp = T + (size_t)(row0 + ai * 128 + m * 16) * LDP + col0; const float rs = RS[row0 + ai * 128 + m * 16];
#pragma unroll
                for (int bj = 0; bj < 2; ++bj) { f32x4 v0 = acc[ai][bj][m][0] * rs, v1 = acc[ai][bj][m][1] * rs;
#pragma unroll
                    for (int j = 0; j < 4; ++j) { v0[j] = fast_sigmoid(v0[j]); v1[j] = fast_sigmoid(v1[j]); }
                    *(u32x4*)(rowp + bj * 128) = pack8u(v0, v1); } }
    }
};
struct EpiPle {
    static constexpr bool PERM = true;
    const bf16* T; const bf16* XI; bf16* XB; float* SSQ;
    __device__ __forceinline__ void operator()(const f32x4 (&acc)[2][2][4][2], const Unit& u, int wr, int wc, int fr, int fq) const {
        const int row0 = u.pm * 256 + wr * 64 + fr, col0 = u.pn * 256 + wc * 32 + 8 * fq;
#pragma unroll
        for (int ai = 0; ai < 2; ++ai) {
            u32x4 tt[4][2], xx[4][2];
#pragma unroll
            for (int m = 0; m < 4; ++m) { const int r = row0 + ai * 128 + m * 16;
#pragma unroll
                for (int bj = 0; bj < 2; ++bj) { tt[m][bj] = *(const u32x4*)(T + (size_t)r * LDP + col0 + bj * 128); xx[m][bj] = *(const u32x4*)(XI + (size_t)r * XBP + col0 + bj * 128); } }
#pragma unroll
            for (int m = 0; m < 4; ++m) { bf16* xp = XB + (size_t)(row0 + ai * 128 + m * 16) * XBP + col0; float sq = 0.f;
#pragma unroll
                for (int bj = 0; bj < 2; ++bj) { f32x4 t0, t1, x0, x1; unpack8(tt[m][bj], t0, t1); unpack8(xx[m][bj], x0, x1);
                    x0 = x0 + acc[ai][bj][m][0] * t0; x1 = x1 + acc[ai][bj][m][1] * t1; sq += ssq8(x0, x1); *(u32x4*)(xp + bj * 128) = pack8u(x0, x1); }
                ssq_emit(SSQ, sq, u.pn * 4 + wc, row0 + ai * 128 + m * 16, fq); }
            asm volatile("" ::: "memory"); }
    }
};

#define XB_TMO      128
#define XB_XCNT(j)  (256  + 64 * (j))
#define XB_XSUB(j)  (1280 + 64 * (j))
#define XB_XGEN(j)  (2304 + 64 * (j))
#define XB_TOP      3328
#define XB_TOPGEN   3392
#define XCD_BAR_WORDS 3456
#define XB_SPIN_CAP (1u << 18)

__device__ __forceinline__ unsigned xb_ld(unsigned* p)              { return __hip_atomic_load(p, __ATOMIC_RELAXED, __HIP_MEMORY_SCOPE_AGENT); }
__device__ __forceinline__ unsigned xb_add(unsigned* p, unsigned v) { return __hip_atomic_fetch_add(p, v, __ATOMIC_RELAXED, __HIP_MEMORY_SCOPE_AGENT); }
__device__ __forceinline__ unsigned xb_xcc_id() { return (unsigned)__builtin_amdgcn_s_getreg((3 << 11) | 20) & 0xFu; }
#define XB_SPIN(cond, bar) do { unsigned _sp = 0; while (cond) { __builtin_amdgcn_s_sleep(1); \
    if ((++_sp & 255u) == 0u) { if (xb_ld(&(bar)[XB_TMO])) break; if (_sp > XB_SPIN_CAP) { atomicAdd(&(bar)[XB_TMO], 1u); break; } } } } while (0)

__device__ __forceinline__ unsigned xb_lane() { return __builtin_amdgcn_mbcnt_hi(~0u, __builtin_amdgcn_mbcnt_lo(~0u, 0u)); }
struct XcdBarrier {
    unsigned* bar; unsigned x; unsigned w0;
    volatile LAS unsigned* st;
};

__device__ __forceinline__ XcdBarrier xcd_barrier_post(unsigned* bar, volatile LAS unsigned* st, unsigned w0) {
    XcdBarrier b; b.bar = bar; b.x = xb_xcc_id(); b.st = st; b.w0 = w0;
    if (w0 == 0u && xb_lane() == 0u) (void)xb_add(&bar[XB_XCNT(b.x)], 1u);
    return b;
}
__device__ __forceinline__ void xcd_barrier_complete(unsigned* bar, unsigned x, unsigned& nloc, unsigned& nx) {
    const unsigned G = gridDim.x * gridDim.y * gridDim.z;
    unsigned sum, cnt, mine, sp = 0u;
    for (;;) {
        sum = 0u; cnt = 0u; mine = 0u;
#pragma unroll
        for (unsigned j = 0; j < 16; ++j) { const unsigned c = xb_ld(&bar[XB_XCNT(j)]); sum += c; cnt += (c > 0u) ? 1u : 0u; mine = (j == x) ? c : mine; }
        if (sum == G) break;
        __builtin_amdgcn_s_sleep(1);
        if ((++sp & 255u) == 0u) { if (xb_ld(&bar[XB_TMO])) break; if (sp > XB_SPIN_CAP) { atomicAdd(&bar[XB_TMO], 1u); break; } }
    }
    nloc = mine > 0u ? mine : 1u; nx = cnt > 0u ? cnt : 1u;
}

__device__ __forceinline__ void xcd_barrier(const XcdBarrier& b) {
    asm volatile("s_waitcnt vmcnt(0)" ::: "memory");
    __syncthreads();
    if (b.w0 == 0u && xb_lane() == 0u) {
        unsigned* bar = b.bar;
        __builtin_amdgcn_s_waitcnt(0);
        unsigned nloc = b.st[0], nx = b.st[1];
        if (nloc == 0u) { xcd_barrier_complete(bar, b.x, nloc, nx); b.st[0] = nloc; b.st[1] = nx; }
        const unsigned old = xb_add(&bar[XB_XSUB(b.x)], 1u);
        const unsigned gen = old / nloc;
        if (old + 1u == (gen + 1u) * nloc) {
            __builtin_amdgcn_fence(__ATOMIC_RELEASE, "agent");
            asm volatile("s_waitcnt vmcnt(0)" ::: "memory");
            const unsigned og = xb_add(&bar[XB_TOP], 1u);
            const unsigned tg = og / nx;
            if (og + 1u == (tg + 1u) * nx) xb_add(&bar[XB_TOPGEN], 1u);
            else XB_SPIN(xb_ld(&bar[XB_TOPGEN]) == tg, bar);
            __builtin_amdgcn_fence(__ATOMIC_ACQUIRE, "agent");
            xb_add(&bar[XB_XGEN(b.x)], 1u);
            asm volatile("s_waitcnt vmcnt(0)" ::: "memory");
        } else {
            XB_SPIN(xb_ld(&bar[XB_XGEN(b.x)]) == gen, bar);
            __builtin_amdgcn_fence(__ATOMIC_ACQUIRE, "agent");
            asm volatile("s_waitcnt vmcnt(0)" ::: "memory");
        }
    }
    __syncthreads();
}

constexpr size_t MiB = 1u << 20;
constexpr size_t WS_CTL = 0, CTL_ZERO_BYTES = 1 * MiB;
constexpr int CW_BAR = 4096;
constexpr size_t WO_GU1 = 0;
constexpr size_t WO_D1  = WO_GU1 + (size_t)FF2 * KP_D;
constexpr size_t WO_IN  = WO_D1 + (size_t)D * KP_F;
constexpr size_t WO_A   = WO_IN + (size_t)NIN * KP_D;
constexpr size_t WO_B   = WO_A + (size_t)D * KP_D;
constexpr size_t WO_O   = WO_B + (size_t)D * KP_G;
constexpr size_t WO_GU2 = WO_O + (size_t)D * KP_D;
constexpr size_t WO_D2  = WO_GU2 + (size_t)FF2 * KP_D;
constexpr size_t WO_PG  = WO_D2 + (size_t)D * KP_F;
constexpr size_t WO_PP  = WO_PG + (size_t)D * KP_D;
constexpr size_t WO_WS  = WO_PP + (size_t)D * KP_E;
constexpr size_t WO_END = WO_WS + (size_t)8 * 128 * 128;
constexpr size_t WS_W   = 1 * MiB;
constexpr size_t WS_HB  = WS_W + ((WO_END * 2 + 255) / 256) * 256;
constexpr size_t WS_PB  = WS_HB + (size_t)M_TOK * LDH * 2;
constexpr size_t WS_PE  = WS_PB + (size_t)M_TOK * LDP * 2;
constexpr size_t WS_DT  = WS_PE + (size_t)M_TOK * LDE * 2;
constexpr size_t WS_SSQ = WS_DT;
constexpr size_t WS_PART = WS_DT + (size_t)M_TOK * NH * 4;
constexpr size_t WS_RS  = WS_PART + (size_t)8 * (M_TOK - M_P) * D * 4;
constexpr size_t WS_SQ  = WS_RS + (((size_t)M_TOK * 4 + 255) / 256) * 256;
constexpr size_t WS_END = WS_SQ + (size_t)32 * M_TOK * 4;

constexpr int RING_BYTES = 131072;
constexpr int LDS_BYTES = 147456;
constexpr int LDSCTL_OFF = LDS_BYTES - 256;
constexpr int NWAVES = 8, NTHREADS = 512;

constexpr size_t OUT_Y = 0;
constexpr size_t OUT_SSM_P = (size_t)M_TOK * D;
constexpr size_t OUT_CONV_P = OUT_SSM_P + (size_t)DEPTH * NB_P * NH * HD * NS;
constexpr size_t OUT_SSM_S = OUT_CONV_P + (size_t)DEPTH * NB_P * 3 * XBC;
constexpr size_t OUT_CONV_S = OUT_SSM_S + (size_t)DEPTH * NB_S * NH * HD * NS;
constexpr size_t OUT_GV = OUT_CONV_S + (size_t)DEPTH * NB_S * 3 * XBC;
constexpr size_t OUT_END = OUT_GV + (size_t)DEPTH * NB_S * L_S * GMW;

enum { I_XP = 0, I_XS, I_PP, I_PS, I_SCONV, I_SSSM, I_F1N, I_F1G, I_F1U, I_F1D, I_MIXN, I_WIN, I_CONVW, I_CONVB, I_DTB, I_ALOG, I_DSKIP, I_SSDN,
       I_GLNG, I_GLNB, I_GWS, I_GBS, I_WBA, I_WBB, I_WOUT, I_F2N, I_F2G, I_F2U, I_F2D, I_PLEN, I_PLEG, I_PLEP, I_FINN, N_IN };

struct Args { const float* in[N_IN]; float* out; unsigned char* ws; int ph_lo, ph_hi; };
#define CAS __attribute__((address_space(4)))
struct KP { const CAS char* p;
    __device__ __forceinline__ const float* in(int i) const { return *(const float* const CAS*)(p + 8 * i); }
    __device__ __forceinline__ float* out() const { return *(float* const CAS*)(p + 8 * N_IN); }
    __device__ __forceinline__ unsigned char* ws() const { return *(unsigned char* const CAS*)(p + 8 * N_IN + 8); }
    __device__ __forceinline__ int ph_lo() const { return *(const int CAS*)(p + 8 * N_IN + 16); }
    __device__ __forceinline__ int ph_hi() const { return *(const int CAS*)(p + 8 * N_IN + 20); } };
__device__ __forceinline__ KP kp_get() { KP k; k.p = (const CAS char*)__builtin_amdgcn_kernarg_segment_ptr(); asm volatile("" : "+s"(k.p)); return k; }
__device__ __forceinline__ int lane_id() { return (int)__builtin_amdgcn_mbcnt_hi(~0u, __builtin_amdgcn_mbcnt_lo(~0u, 0u)); }

__device__ __forceinline__ float wave_sum(float v) {
#pragma unroll
    for (int o = 1; o < 64; o <<= 1) v += __shfl_xor(v, o);
    return v;
}

struct RowId { __device__ __forceinline__ int operator()(int n) const { return n; } };
struct RowGU { int up; __device__ __forceinline__ int operator()(int n) const { const int pn = n >> 7, o = n & 127; return 256 * pn + 128 * ((o >> 2) & 1) + 32 * (o >> 5) + (up ? 16 : 0) + 4 * ((o >> 3) & 3) + (o & 3); } };
struct RowIn { __device__ __forceinline__ int operator()(int n) const { return n < 5120 ? n : (n < 5152 ? n - 5120 + PC_DT : n - 32); } };
template <class RM>
__device__ __forceinline__ void transpose_item(const float* W, int K, int N, bf16* WT, int ldt, RM rm, LAS float* scr, int item, int lane, const float* kg = nullptr) {
    const int nblk = N / 32, kb = item / nblk, nb = item % nblk, k0 = 64 * kb, n0 = 32 * nb;
#pragma unroll
    for (int i = 0; i < 32; ++i) { const int kk = 2 * i + (lane >> 5); scr[kk * 33 + (lane & 31)] = W[(size_t)(k0 + kk) * N + n0 + (lane & 31)]; }
    asm volatile("s_waitcnt lgkmcnt(0)" ::: "memory");
    const int c = lane & 7;
    f32x4 ga = {1.f, 1.f, 1.f, 1.f}, gb = ga;
    if (kg) { ga = *(const f32x4*)(kg + k0 + 8 * c); gb = *(const f32x4*)(kg + k0 + 8 * c + 4); }
#pragma unroll
    for (int j = 0; j < 4; ++j) { const int n = (lane >> 3) + 8 * j; const LAS float* s = scr + (8 * c) * 33 + n;
        u32x4 o; o.x = pk2(s[0 * 33] * ga[0], s[1 * 33] * ga[1]); o.y = pk2(s[2 * 33] * ga[2], s[3 * 33] * ga[3]); o.z = pk2(s[4 * 33] * gb[0], s[5 * 33] * gb[1]); o.w = pk2(s[6 * 33] * gb[2], s[7 * 33] * gb[3]);
        *(u32x4*)(WT + (size_t)rm(n0 + n) * ldt + k0 + 8 * c) = o; }
    asm volatile("s_waitcnt lgkmcnt(0)" ::: "memory");
}

template <int GRP>
__device__ __forceinline__ void convert_group(const KP a, int layer, bf16* Wb, LAS unsigned char* lds, int w, int nw, int wave, int lane) {
    LAS float* scr = (LAS float*)(lds + wave * 16384);
    constexpr int T_GU = (D / 64) * (FF / 32), T_DN = (FF / 64) * (D / 32), T_IN = (D / 64) * (INC / 32), T_SQ = (D / 64) * (D / 32), T_BB = (GMW / 64) * (D / 32), T_PP = (PLE / 64) * (D / 32);
    constexpr int NITEMS = GRP == 0 ? 2 * T_GU : GRP == 1 ? T_DN + T_IN : GRP == 2 ? 2 * T_SQ + T_BB + 2 * T_GU + T_DN : T_SQ + T_PP;
    const size_t lff = (size_t)layer * D * FF, lsq = (size_t)layer * D * D;
    for (int it = w; it < NITEMS; it += nw) {
        int r = it;
        if constexpr (GRP == 0) {
            if (r < T_GU) { transpose_item(a.in(I_F1G) + lff, D, FF, Wb + WO_GU1, KP_D, RowGU{0}, scr, r, lane, a.in(I_F1N) + layer * D); continue; } r -= T_GU;
            transpose_item(a.in(I_F1U) + lff, D, FF, Wb + WO_GU1, KP_D, RowGU{1}, scr, r, lane, a.in(I_F1N) + layer * D);
        } else if constexpr (GRP == 1) {
            if (r < T_DN) { transpose_item(a.in(I_F1D) + lff, FF, D, Wb + WO_D1, KP_F, RowId{}, scr, r, lane); continue; } r -= T_DN;
            transpose_item(a.in(I_WIN) + (size_t)layer * D * INC, D, INC, Wb + WO_IN, KP_D, RowIn{}, scr, r, lane, a.in(I_MIXN) + layer * D);
        } else if constexpr (GRP == 2) {
            if (r < T_SQ) { transpose_item(a.in(I_WBA) + lsq, DIN, D, Wb + WO_A, KP_D, RowId{}, scr, r, lane); continue; } r -= T_SQ;
            if (r < T_SQ) { transpose_item(a.in(I_WOUT) + lsq, D, D, Wb + WO_O, KP_D, RowId{}, scr, r, lane); continue; } r -= T_SQ;
            if (r < T_BB) { transpose_item(a.in(I_WBB) + (size_t)layer * GMW * D, GMW, D, Wb + WO_B, KP_G, RowId{}, scr, r, lane); continue; } r -= T_BB;
            if (r < T_GU) { transpose_item(a.in(I_F2G) + lff, D, FF, Wb + WO_GU2, KP_D, RowGU{0}, scr, r, lane, a.in(I_F2N) + layer * D); continue; } r -= T_GU;
            if (r < T_GU) { transpose_item(a.in(I_F2U) + lff, D, FF, Wb + WO_GU2, KP_D, RowGU{1}, scr, r, lane, a.in(I_F2N) + layer * D); continue; } r -= T_GU;
            transpose_item(a.in(I_F2D) + lff, FF, D, Wb + WO_D2, KP_F, RowId{}, scr, r, lane);
        } else {
            if (r < T_SQ) { transpose_item(a.in(I_PLEG) + lsq, D, D, Wb + WO_PG, KP_D, RowId{}, scr, r, lane, a.in(I_PLEN) + layer * D); continue; } r -= T_SQ;
            transpose_item(a.in(I_PLEP) + (size_t)layer * PLE * D, PLE, D, Wb + WO_PP, KP_E, RowId{}, scr, r, lane);
        }
    }
}
__device__ __forceinline__ void convert_misc(const KP a, int layer, bf16* Wb, bf16* PE, int gtid, int NGT) {
    { u32x4* z = (u32x4*)(Wb + WO_IN + (size_t)INC * KP_D); const int nz = (NIN - INC) * KP_D / 8; for (int i = gtid; i < nz; i += NGT) z[i] = (u32x4){0u, 0u, 0u, 0u}; }
    { const float* wsrc = a.in(I_GWS) + (size_t)layer * 8 * 128 * 128; bf16* wd = Wb + WO_WS;
      for (int i = gtid; i < 8 * 128 * 128 / 8; i += NGT) { const int e0 = i * 8, t = (e0 >> 7) & 127, s0 = e0 & 127; const f32x4 v0 = *(const f32x4*)(wsrc + e0), v1 = *(const f32x4*)(wsrc + e0 + 4);
          float f[8] = {v0[0], v0[1], v0[2], v0[3], v1[0], v1[1], v1[2], v1[3]};
#pragma unroll
          for (int j = 0; j < 8; ++j) if (s0 + j > t) f[j] = 0.f;
          u32x4 o; o.x = pk2(f[0], f[1]); o.y = pk2(f[2], f[3]); o.z = pk2(f[4], f[5]); o.w = pk2(f[6], f[7]); *(u32x4*)(wd + e0) = o; } }
    { const float* pp = a.in(I_PP) + (size_t)layer * M_P * PLE; const float* ps = a.in(I_PS) + (size_t)layer * (M_TOK - M_P) * PLE; const int n8 = M_TOK * PLE / 8, np8 = M_P * PLE / 8;
      for (int i0 = gtid; i0 < n8; i0 += 4 * NGT) {
          f32x4 v0[4], v1[4];
#pragma unroll
          for (int u = 0; u < 4; ++u) { const int i = i0 + u * NGT < n8 ? i0 + u * NGT : i0; const float* s = i < np8 ? pp + (size_t)i * 8 : ps + (size_t)(i - np8) * 8; v0[u] = *(const f32x4*)s; v1[u] = *(const f32x4*)(s + 4); }
#pragma unroll
          for (int u = 0; u < 4; ++u) { const int i = i0 + u * NGT; if (i < n8) { u32x4 o; o.x = pk2(v0[u][0], v0[u][1]); o.y = pk2(v0[u][2], v0[u][3]); o.z = pk2(v1[u][0], v1[u][1]); o.w = pk2(v1[u][2], v1[u][3]); *(u32x4*)(PE + (size_t)(i >> 5) * LDE + (i & 31) * 8) = o; } } } }
}
#define TAIL_CONVERT(NUNITS, ...) do { const int thr_ = (NUNITS) % G; if (bid >= thr_) { asm volatile("s_waitcnt vmcnt(0) lgkmcnt(0)" ::: "memory"); __syncthreads(); const int tw_ = (bid - thr_) * NWAVES + wave, tn_ = (G - thr_) * NWAVES; __VA_ARGS__ } } while (0)

__device__ __forceinline__ void phase_first(const float* rlo, const float* rhi, bf16* XB, float* RS, int gw, int NGW, int lane) {
    for (int r0 = gw; r0 < M_TOK; r0 += 2 * NGW) {
        const int r1 = r0 + NGW; const bool two = r1 < M_TOK;
        f32x4 v0[2][4], v1[2][4];
#pragma unroll
        for (int u = 0; u < 2; ++u) { const int r = u ? (two ? r1 : r0) : r0;
            const float* xr = (r < M_P ? rlo + (size_t)r * D : rhi + (size_t)(r - M_P) * D) + 8 * lane;
#pragma unroll
            for (int j = 0; j < 4; ++j) { v0[u][j] = *(const f32x4*)(xr + 512 * j); v1[u][j] = *(const f32x4*)(xr + 512 * j + 4); } }
#pragma unroll
        for (int u = 0; u < 2; ++u) { const int r = u ? r1 : r0; if (u && !two) break;
            float ss = 0.f;
#pragma unroll
            for (int j = 0; j < 4; ++j) ss += ssq8(v0[u][j], v1[u][j]);
            bf16* xo = XB + (size_t)r * XBP + 8 * lane;
#pragma unroll
            for (int j = 0; j < 4; ++j) *(u32x4*)(xo + 512 * j) = pack8u(v0[u][j], v1[u][j]);
            ss = wave_sum(ss);
            if (lane == 0) RS[r] = rsqrtf(ss * (1.f / D) + EPS); }
    }
}
template <bool FOLD>
__device__ __forceinline__ void phase_rstd(const float* SSQ, float* RS, const float* part, bf16* XB, int gw, int NGW, int lane, int gtid, int NGT) {
    constexpr int NRED = FOLD ? M_P : M_TOK;
    for (int t = gtid; t < NRED * 4; t += NGT) { const int r = t >> 2, q = t & 3; float s = 0.f;
#pragma unroll
        for (int j = 0; j < 8; ++j) s += SSQ[(size_t)(q * 8 + j) * M_TOK + r];
        s += __shfl_xor(s, 1); s += __shfl_xor(s, 2);
        if (q == 0) RS[r] = rsqrtf(s * (1.f / D) + EPS); }
    if (FOLD) for (int r = M_P + (NGW - 1 - gw); r < M_TOK; r += NGW) {
        f32x4 v0[4], v1[4];
        bf16* xo = XB + (size_t)r * XBP + 8 * lane;
#pragma unroll
        for (int j = 0; j < 4; ++j) unpack8(*(const u32x4*)(xo + 512 * j), v0[j], v1[j]);
#pragma unroll 1
        for (int s = 0; s < 8; ++s) { const float* pr = part + ((size_t)s * (M_TOK - M_P) + (size_t)(r - M_P)) * D + 8 * lane;
#pragma unroll
            for (int j = 0; j < 4; ++j) { v0[j] = v0[j] + *(const f32x4*)(pr + 512 * j); v1[j] = v1[j] + *(const f32x4*)(pr + 512 * j + 4); } }
        float ss = 0.f;
#pragma unroll
        for (int j = 0; j < 4; ++j) { ss += ssq8(v0[j], v1[j]); *(u32x4*)(xo + 512 * j) = pack8u(v0[j], v1[j]); }
        ss = wave_sum(ss);
        if (lane == 0) RS[r] = rsqrtf(ss * (1.f / D) + EPS);
    }
}
__device__ __forceinline__ void phase_final_norm(const bf16* XB, float* Y, const float* gain, int gw, int NGW, int lane) {
    for (int r0 = gw; r0 < M_TOK; r0 += 2 * NGW) {
        const int r1 = r0 + NGW; const bool two = r1 < M_TOK;
        u32x4 w[2][4];
#pragma unroll
        for (int u = 0; u < 2; ++u) { const bf16* xr = XB + (size_t)(u ? (two ? r1 : r0) : r0) * XBP + 8 * lane;
#pragma unroll
            for (int j = 0; j < 4; ++j) w[u][j] = *(const u32x4*)(xr + 512 * j); }
#pragma unroll
        for (int u = 0; u < 2; ++u) { const int r = u ? r1 : r0; if (u && !two) break;
            f32x4 v0[4], v1[4]; float ss = 0.f;
#pragma unroll
            for (int j = 0; j < 4; ++j) { unpack8(w[u][j], v0[j], v1[j]); ss += ssq8(v0[j], v1[j]); }
            const float rstd = rsqrtf(wave_sum(ss) * (1.f / D) + EPS);
            float* yo = Y + (size_t)r * D + 8 * lane;
#pragma unroll
            for (int j = 0; j < 4; ++j) { const f32x4 g0 = *(const f32x4*)(gain + 8 * lane + 512 * j), g1 = *(const f32x4*)(gain + 8 * lane + 512 * j + 4); __builtin_nontemporal_store(v0[j] * rstd * g0, (f32x4*)(yo + 512 * j)); __builtin_nontemporal_store(v1[j] * rstd * g1, (f32x4*)(yo + 512 * j + 4)); }
        }
    }
}

__device__ __forceinline__ size_t seq_row0(int sq) { return sq < NB_P ? (size_t)sq * SEQ : (size_t)M_P + (size_t)(sq - NB_P) * L_S; }


typedef pg8::bf16x8 bf16x8;
constexpr int SC = 8, NSC = SEQ / (64 * SC), NSC1 = NSC - 1;
constexpr int XS_LD = 72, TM_LD = 136;
constexpr int SL_XST = 0;
constexpr int SL_BMT = SL_XST + 512 * XS_LD * 2;
constexpr int SL_BM  = SL_BMT + 128 * XS_LD * 2;
constexpr int SL_CM  = SL_BM + 64 * TM_LD * 2;
constexpr int SL_CUM = SL_CM + 64 * TM_LD * 2;
constexpr int SL_DTV = SL_CUM + 2048;
constexpr int SL_WV  = SL_DTV + 2048;
constexpr int SL_SSQ = SL_WV + 2048;
constexpr int SL_GN  = SL_SSQ + 2048;
constexpr int SL_END = SL_GN + 2048;
static_assert(SL_END <= LDSCTL_OFF, "SSD LDS map");
constexpr size_t ST_ELEMS = 128 * 64;
constexpr size_t WSO_ST = 0, WSO_DTOT = (size_t)NB_P * NSC1 * NH * ST_ELEMS * 4;
static_assert(WSO_DTOT + (size_t)NB_P * NSC1 * NH * 4 <= (size_t)128 * MiB, "SSD states fit the first 128 MiB of the y region of d_out");
constexpr size_t WSO_XT = (size_t)128 * MiB;
static_assert(WSO_XT + (size_t)M_TOK * XBP * 2 <= (size_t)M_TOK * D * 4, "second stream buffer fits the y region");

__device__ __forceinline__ bf16x8 ld_pair8(const LAS unsigned char* p0, const LAS unsigned char* p1) {
    const u32x2 a = *(const LAS u32x2*)p0, b = *(const LAS u32x2*)p1; const u32x4 w = {a.x, a.y, b.x, b.y}; return __builtin_bit_cast(bf16x8, w); }
__device__ __forceinline__ bf16x8 pack8(const f32x4 lo, const f32x4 hi) { const u32x4 w = {pk2(lo[0], lo[1]), pk2(lo[2], lo[3]), pk2(hi[0], hi[1]), pk2(hi[2], hi[3])}; return __builtin_bit_cast(bf16x8, w); }
#define MFMA16(a, b, c) __builtin_amdgcn_mfma_f32_16x16x32_bf16((a), (b), (c), 0, 0, 0)
__device__ __forceinline__ void lds_barrier() { asm volatile("s_waitcnt lgkmcnt(0)" ::: "memory"); __builtin_amdgcn_s_barrier(); asm volatile("" ::: "memory"); }

__device__ __forceinline__ int xperm(int n2) { const int c = n2 & 63; return (n2 & ~63) | ((c >> 5) << 5) | (((c >> 2) & 1) << 4) | (((c >> 3) & 3) << 2) | (c & 3); }
__device__ __forceinline__ int xphys(int pb, int i) { return 32 * (pb >> 1) + 8 * (i >> 2) + 4 * (pb & 1) + (i & 3); }
template <bool FULL>
__device__ __forceinline__ void ssd_stage(const KP a, int layer, const bf16* rowp, int hist, const float* cst, float* tail_out, int g, LAS unsigned char* lds, int tid) {
    constexpr int NPAIR = FULL ? 384 : 320, NT = (NPAIR * 4 + NTHREADS - 1) / NTHREADS;
    static_assert(NPAIR % 64 == 0, "a wave's 64 tasks share the token block and the channel kind");
    const int wv = __builtin_amdgcn_readfirstlane(tid >> 6), ln = tid & 63;
    const float* cw = a.in(I_CONVW) + (size_t)layer * 4 * XBC; const float* cb = a.in(I_CONVB) + (size_t)layer * XBC;
    unsigned rr[NT][19];
#pragma unroll
    for (int i = 0; i < NT; ++i) {
        const int tw = wv * 64 + i * NTHREADS;
        const int tq = tw / NPAIR, pw = tw - tq * NPAIR, s0 = 16 * tq;
        const int chw = pw < 256 ? g * 512 + 2 * pw : (pw < 320 ? DIN + g * 128 + 2 * (pw - 256) : DIN + 512 + g * 128 + 2 * (pw - 320));
        if (tw < NPAIR * 4) {
            const bf16* pb = rowp + PC_XBC + chw + 2 * ln;
#pragma unroll
            for (int j = 0; j < 19; ++j) {
                const int s = s0 + j - 3;
                if (j >= 3 || s >= 0 || hist == 1) rr[i][j] = *(const unsigned*)(pb + (long)s * LDP);
                else if (hist == 2) { const f32x2 v = *(const f32x2*)(cst + (size_t)(s + 3) * XBC + chw + 2 * ln); rr[i][j] = pk2(v[0], v[1]); }
                else rr[i][j] = 0u;
            }
        } else {
#pragma unroll
            for (int j = 0; j < 19; ++j) rr[i][j] = 0u;
        }
    }
#pragma unroll
    for (int i = 0; i < NT; ++i) {
        const int tw = wv * 64 + i * NTHREADS; if (tw >= NPAIR * 4) break;
        const int tq = tw / NPAIR, pw = tw - tq * NPAIR, s0 = 16 * tq;
        const int kind = pw < 256 ? 0 : (pw < 320 ? 1 : 2);
        const int n2 = 2 * (pw - (kind == 0 ? 0 : (kind == 1 ? 256 : 320))) + 2 * ln;
        const int ch = (kind == 0 ? g * 512 : (kind == 1 ? DIN + g * 128 : DIN + 512 + g * 128)) + n2;
        float w0[4], w1[4];
#pragma unroll
        for (int k = 0; k < 4; ++k) { const f32x2 wv2 = *(const f32x2*)(cw + (size_t)k * XBC + ch); w0[k] = wv2[0]; w1[k] = wv2[1]; }
        const f32x2 bv = *(const f32x2*)(cb + ch);
        if (tail_out && tq == 3) {
#pragma unroll
            for (int k = 0; k < 3; ++k) *(f32x2*)(tail_out + (size_t)k * XBC + ch) = (f32x2){bflo(rr[i][16 + k]), bfhi(rr[i][16 + k])}; }
        unsigned q0[8], q1[8];
        LAS unsigned char* dtm = lds + (kind == 1 ? SL_BM : SL_CM) + s0 * (TM_LD * 2) + n2 * 2;
#pragma unroll
        for (int e = 0; e < 8; ++e) { float oa[2], ob[2];
#pragma unroll
            for (int u = 0; u < 2; ++u) { const int j = 2 * e + u;
                const float c0 = bv[0] + w0[0] * bflo(rr[i][j]) + w0[1] * bflo(rr[i][j + 1]) + w0[2] * bflo(rr[i][j + 2]) + w0[3] * bflo(rr[i][j + 3]), c1 = bv[1] + w1[0] * bfhi(rr[i][j]) + w1[1] * bfhi(rr[i][j + 1]) + w1[2] * bfhi(rr[i][j + 2]) + w1[3] * bfhi(rr[i][j + 3]);
                oa[u] = fast_silu(c0); ob[u] = fast_silu(c1);
                if (FULL && kind >= 1) *(LAS unsigned*)(dtm + j * (TM_LD * 2)) = pk2(oa[u], ob[u]); }
            q0[e] = pk2(oa[0], oa[1]); q1[e] = pk2(ob[0], ob[1]); }
        if (kind <= 1) {
            LAS unsigned char* d = lds + (kind == 0 ? SL_XST : SL_BMT) + n2 * (XS_LD * 2) + s0 * 2;
            *(LAS u32x4*)d = (u32x4){q0[0], q0[1], q0[2], q0[3]}; *(LAS u32x4*)(d + 16) = (u32x4){q0[4], q0[5], q0[6], q0[7]};
            *(LAS u32x4*)(d + XS_LD * 2) = (u32x4){q1[0], q1[1], q1[2], q1[3]}; *(LAS u32x4*)(d + XS_LD * 2 + 16) = (u32x4){q1[4], q1[5], q1[6], q1[7]};
        }
    }
}
__device__ __forceinline__ float ssd_cum(float dtv, float av, LAS unsigned char* lds, int wave, int lane) {
    float c = dtv * av;
#pragma unroll
    for (int o = 1; o < 64; o <<= 1) { const float t = __shfl_up(c, o); if (lane >= o) c += t; }
    const float c63 = __shfl(c, 63);
    ((LAS float*)(lds + SL_CUM))[wave * 64 + lane] = c; ((LAS float*)(lds + SL_DTV))[wave * 64 + lane] = dtv; ((LAS float*)(lds + SL_WV))[wave * 64 + lane] = __expf(c63 - c) * dtv;
    return c63;
}
__device__ __forceinline__ void ssd_state_update(f32x4 (&H)[8][4], float c63, const LAS unsigned char* lds, int wave, int lr, int q) {
    const float dec = __expf(c63);
#pragma unroll
    for (int nb = 0; nb < 8; ++nb)
#pragma unroll
        for (int pb = 0; pb < 4; ++pb) H[nb][pb] = H[nb][pb] * dec;
    const LAS float* wv = (const LAS float*)(lds + SL_WV) + wave * 64;
#pragma unroll
    for (int i = 0; i < 2; ++i) {
        const f32x4 wa = *(const LAS f32x4*)(wv + 32 * i + 4 * q), wb = *(const LAS f32x4*)(wv + 32 * i + 16 + 4 * q);
        bf16x8 xw[4];
#pragma unroll
        for (int pb = 0; pb < 4; ++pb) { const LAS unsigned char* xr = lds + SL_XST + (wave * 64 + xphys(pb, lr)) * (XS_LD * 2) + (32 * i + 4 * q) * 2;
            const u32x2 ua = *(const LAS u32x2*)xr, ub = *(const LAS u32x2*)(xr + 32);
            const f32x4 lo = {bflo(ua.x) * wa[0], bfhi(ua.x) * wa[1], bflo(ua.y) * wa[2], bfhi(ua.y) * wa[3]}, hi = {bflo(ub.x) * wb[0], bfhi(ub.x) * wb[1], bflo(ub.y) * wb[2], bfhi(ub.y) * wb[3]};
            xw[pb] = pack8(lo, hi); }
#pragma unroll
        for (int nb = 0; nb < 8; ++nb) { const LAS unsigned char* br = lds + SL_BMT + (16 * nb + lr) * (XS_LD * 2) + (32 * i + 4 * q) * 2; const bf16x8 bfA = ld_pair8(br, br + 32);
#pragma unroll
            for (int pb = 0; pb < 4; ++pb) H[nb][pb] = MFMA16(bfA, xw[pb], H[nb][pb]); }
        __builtin_amdgcn_sched_barrier(0);
    }
}
__device__ __forceinline__ void ssd_state_load(f32x4 (&H)[8][4], const float* st, int lane) {
#pragma unroll
    for (int nb = 0; nb < 8; ++nb)
#pragma unroll
        for (int pb = 0; pb < 4; ++pb)
#pragma unroll
            for (int r = 0; r < 4; ++r) H[nb][pb][r] = st[(size_t)(((nb * 4 + pb) * 4 + r) * 64 + lane)];
}
__device__ __forceinline__ void ssd_state_store(const f32x4 (&H)[8][4], float* st, int lane) {
#pragma unroll
    for (int nb = 0; nb < 8; ++nb)
#pragma unroll
        for (int pb = 0; pb < 4; ++pb)
#pragma unroll
            for (int r = 0; r < 4; ++r) st[(size_t)(((nb * 4 + pb) * 4 + r) * 64 + lane)] = H[nb][pb][r];
}

__device__ __forceinline__ void ssd1_item(const KP a, int layer, int b, int k, int g, const bf16* PB, const float* DT, unsigned char* hbreg, LAS unsigned char* lds, int tid, int wave, int lane) {
    const int h = g * 8 + wave; (void)tid;
    const float av = -__expf(a.in(I_ALOG)[layer * NH + h]);
    f32x4 H[8][4];
#pragma unroll
    for (int nb = 0; nb < 8; ++nb)
#pragma unroll
        for (int pb = 0; pb < 4; ++pb) H[nb][pb] = (f32x4){0.f, 0.f, 0.f, 0.f};
    float dsum = 0.f;
    float dtn = DT[((size_t)b * SEQ + (size_t)(k * SC) * 64 + lane) * NH + h];
#pragma unroll 1
    for (int c = 0; c < SC; ++c) {
        int ln = lane; asm volatile("" : "+v"(ln));
        const int lr = ln & 15, q = ln >> 4;
        const size_t rowc = (size_t)b * SEQ + (size_t)(k * SC + c) * 64;
        const float dtc = dtn; if (c + 1 < SC) dtn = DT[(rowc + 64 + ln) * NH + h];
        ssd_stage<false>(a, layer, PB + rowc * LDP, (k == 0 && c == 0) ? 0 : 1, nullptr, nullptr, g, lds, wave * 64 + ln);
        const float c63 = ssd_cum(dtc, av, lds, wave, ln);
        dsum += c63;
        lds_barrier();
        ssd_state_update(H, c63, lds, wave, lr, q);
        lds_barrier();
    }
    const size_t si = ((size_t)b * NSC1 + k) * NH + h;
    { int ln = lane; asm volatile("" : "+v"(ln));
      ssd_state_store(H, (float*)(hbreg + WSO_ST) + si * ST_ELEMS, ln);
      if (ln == 0) ((float*)(hbreg + WSO_DTOT))[si] = __expf(dsum); }
}
__device__ __forceinline__ void ssd2_phase(unsigned char* hbreg, int gw, int NGW, int lane) {
    for (int it = gw; it < NB_P * NH * 32; it += NGW) {
        const int bh = it >> 5, part = it & 31, b = bh / NH, h = bh % NH;
        float* s0 = (float*)(hbreg + WSO_ST) + (((size_t)b * NSC1) * NH + h) * ST_ELEMS + (size_t)part * 4 * 64 + lane; const float* d0 = (const float*)(hbreg + WSO_DTOT) + ((size_t)b * NSC1) * NH + h;
        float sv[NSC1][4], dk[NSC1];
#pragma unroll
        for (int k = 0; k < NSC1; ++k) { dk[k] = d0[(size_t)k * NH];
#pragma unroll
            for (int j = 0; j < 4; ++j) sv[k][j] = s0[(size_t)k * NH * ST_ELEMS + j * 64]; }
        float run[4] = {0.f, 0.f, 0.f, 0.f};
#pragma unroll
        for (int k = 0; k < NSC1; ++k)
#pragma unroll
            for (int j = 0; j < 4; ++j) { run[j] = run[j] * dk[k] + sv[k][j]; s0[(size_t)k * NH * ST_ELEMS + j * 64] = run[j]; }
    }
}
__device__ __forceinline__ void ssd3_item(const KP a, int layer, size_t row0, int nchunk, int g, const float* st_init  , const float* sinit  ,
                                          int hist0, const float* cst, float* ssm_out  , float* conv_out  ,
                                          bf16* PB, const float* DT, LAS unsigned char* lds, int tid, int wave, int lane, bf16* dry = nullptr) {
    const int h = g * 8 + wave; (void)tid;
#ifdef S3_DRY_SKIP
    const int skip = dry ? S3_DRY_SKIP : 0; if (dry) { ssm_out = nullptr; conv_out = nullptr; }
#else
    constexpr int skip = 0;
#endif
    const float av = -__expf(a.in(I_ALOG)[layer * NH + h]), Dk = a.in(I_DSKIP)[layer * NH + h];
    f32x4 H[8][4];
    { const int lr = lane & 15, q = lane >> 4;
    if (st_init) ssd_state_load(H, st_init + (size_t)h * ST_ELEMS, lane);
    else if (sinit) {
#pragma unroll
        for (int nb = 0; nb < 8; ++nb)
#pragma unroll
            for (int pb = 0; pb < 4; ++pb) H[nb][pb] = *(const f32x4*)(sinit + ((size_t)h * HD + xphys(pb, lr)) * NS + 16 * nb + 4 * q);
    } else {
#pragma unroll
        for (int nb = 0; nb < 8; ++nb)
#pragma unroll
            for (int pb = 0; pb < 4; ++pb) H[nb][pb] = (f32x4){0.f, 0.f, 0.f, 0.f};
    } }
    ((LAS float*)(lds + SL_GN))[wave * 64 + lane] = a.in(I_SSDN)[(size_t)layer * DIN + h * 64 + lane];
    float dtn = DT[(row0 + lane) * NH + h];
#pragma unroll 1
    for (int c = 0; c < nchunk; ++c) {
        const size_t rowc = row0 + (size_t)c * 64;
        const float dtc = dtn; if (c + 1 < nchunk) dtn = DT[(rowc + 64 + lane) * NH + h];
        if (!(skip & 1)) { int ln = lane; asm volatile("" : "+v"(ln));
          ssd_stage<true>(a, layer, PB + rowc * LDP, c == 0 ? hist0 : 1, cst, (c == nchunk - 1) ? conv_out : nullptr, g, lds, wave * 64 + ln); }
        float c63; { int ln = lane; asm volatile("" : "+v"(ln)); c63 = ssd_cum(dtc, av, lds, wave, ln); }
        lds_barrier();
        const LAS float* cumv = (const LAS float*)(lds + SL_CUM) + wave * 64; const LAS float* dtv = (const LAS float*)(lds + SL_DTV) + wave * 64;
#pragma unroll 1
        for (int th = (skip & 2) ? 2 : 0; th < 2; ++th) {
            int ln = lane; asm volatile("" : "+v"(ln)); const int lr = ln & 15, q = ln >> 4;
            u32x4 zpre[2][2];
#pragma unroll
            for (int tbi = 0; tbi < 2; ++tbi) { const bf16* zr = PB + (rowc + 16 * (2 * th + tbi) + lr) * LDP + PC_Z + h * 64 + 8 * q;
#pragma unroll
                for (int m = 0; m < 2; ++m) zpre[tbi][m] = (skip & 8) ? (u32x4){0x3f803f80u, 0x3f803f80u, 0x3f803f80u, 0x3f803f80u} : *(const u32x4*)(zr + 32 * m); }
            f32x4 cbt[4][2];
#pragma unroll
            for (int sb = 0; sb < 4; ++sb) { cbt[sb][0] = (f32x4){0.f, 0.f, 0.f, 0.f}; cbt[sb][1] = (f32x4){0.f, 0.f, 0.f, 0.f}; }
#pragma unroll
            for (int kk = 0; kk < 4; ++kk) {
                bf16x8 cf[2];
#pragma unroll
                for (int tbi = 0; tbi < 2; ++tbi) cf[tbi] = *(const LAS bf16x8*)(lds + SL_CM + (16 * (2 * th + tbi) + lr) * (TM_LD * 2) + (32 * kk + 8 * q) * 2);
#pragma unroll
                for (int sb = 0; sb < 4; ++sb) { const bf16x8 bfA = *(const LAS bf16x8*)(lds + SL_BM + (16 * sb + lr) * (TM_LD * 2) + (32 * kk + 8 * q) * 2);
                    cbt[sb][0] = MFMA16(bfA, cf[0], cbt[sb][0]); cbt[sb][1] = MFMA16(bfA, cf[1], cbt[sb][1]); }
                __builtin_amdgcn_sched_barrier(0);
            }
            float ct[2]; ct[0] = cumv[16 * (2 * th) + lr]; ct[1] = cumv[16 * (2 * th + 1) + lr];
            bf16x8 mf[2][2];
#pragma unroll
            for (int sb = 0; sb < 4; ++sb) { const f32x4 cs = *(const LAS f32x4*)(cumv + 16 * sb + 4 * q), ds = *(const LAS f32x4*)(dtv + 16 * sb + 4 * q);
#pragma unroll
                for (int tbi = 0; tbi < 2; ++tbi) { const int t = 16 * (2 * th + tbi) + lr;
#pragma unroll
                    for (int r = 0; r < 4; ++r) { const int s = 16 * sb + 4 * q + r; const float f = (s <= t) ? __expf(ct[tbi] - cs[r]) * ds[r] : 0.f; cbt[sb][tbi][r] = cbt[sb][tbi][r] * f + ((s == t) ? Dk : 0.f); } } }
#pragma unroll
            for (int i = 0; i < 2; ++i) { mf[i][0] = pack8(cbt[2 * i][0], cbt[2 * i + 1][0]); mf[i][1] = pack8(cbt[2 * i][1], cbt[2 * i + 1][1]); }
            __builtin_amdgcn_sched_barrier(0);
            f32x4 y[4][2];
#pragma unroll
            for (int pb = 0; pb < 4; ++pb) { y[pb][0] = (f32x4){0.f, 0.f, 0.f, 0.f}; y[pb][1] = (f32x4){0.f, 0.f, 0.f, 0.f}; }
#pragma unroll
            for (int kk = 0; kk < 4; ++kk) {
                bf16x8 cf[2];
#pragma unroll
                for (int tbi = 0; tbi < 2; ++tbi) { const LAS unsigned char* cr = lds + SL_CM + (16 * (2 * th + tbi) + lr) * (TM_LD * 2) + (32 * kk + 4 * q) * 2; cf[tbi] = ld_pair8(cr, cr + 32); }
#pragma unroll
                for (int pb = 0; pb < 4; ++pb) { asm volatile("" : "+v"(H[2 * kk][pb]), "+v"(H[2 * kk + 1][pb]));
                    const bf16x8 hf = pack8(H[2 * kk][pb], H[2 * kk + 1][pb]); y[pb][0] = MFMA16(hf, cf[0], y[pb][0]); y[pb][1] = MFMA16(hf, cf[1], y[pb][1]); }
                __builtin_amdgcn_sched_barrier(0);
            }
            { const float e0 = __expf(ct[0]), e1 = __expf(ct[1]);
#pragma unroll
              for (int pb = 0; pb < 4; ++pb) { y[pb][0] = y[pb][0] * e0; y[pb][1] = y[pb][1] * e1; } }
#pragma unroll
            for (int i = 0; i < 2; ++i)
#pragma unroll
                for (int pb = 0; pb < 4; ++pb) { const LAS unsigned char* xr = lds + SL_XST + (wave * 64 + xphys(pb, lr)) * (XS_LD * 2) + (32 * i + 4 * q) * 2; const bf16x8 xf = ld_pair8(xr, xr + 32);
                    y[pb][0] = MFMA16(xf, mf[i][0], y[pb][0]); y[pb][1] = MFMA16(xf, mf[i][1], y[pb][1]); }
            __builtin_amdgcn_sched_barrier(0);
            float ssq[2] = {0.f, 0.f};
#pragma unroll
            for (int tbi = 0; tbi < 2; ++tbi)
#pragma unroll
                for (int pb = 0; pb < 4; ++pb) { const u32x4 z4 = zpre[tbi][pb >> 1]; const unsigned zx = (pb & 1) ? z4.z : z4.x, zy = (pb & 1) ? z4.w : z4.y; const float zf[4] = {bflo(zx), bfhi(zx), bflo(zy), bfhi(zy)};
#pragma unroll
                    for (int r = 0; r < 4; ++r) { const float v = y[pb][tbi][r] * zf[r]; y[pb][tbi][r] = v; ssq[tbi] += v * v; } }
#pragma unroll
            for (int tbi = 0; tbi < 2; ++tbi) { float s = ssq[tbi]; s += __shfl_xor(s, 16); s += __shfl_xor(s, 32); if (q == 0) ((LAS float*)(lds + SL_SSQ))[(th * 32 + 16 * tbi + lr) * 8 + wave] = s; }
            lds_barrier();
#pragma unroll
            for (int tbi = 0; tbi < 2; ++tbi) { const int t = 16 * (2 * th + tbi) + lr; const LAS f32x4* sp = (const LAS f32x4*)((LAS float*)(lds + SL_SSQ) + (th * 32 + 16 * tbi + lr) * 8);
                const f32x4 s0 = sp[0], s1 = sp[1]; const float rstd = rsqrtf(((s0[0] + s0[1]) + (s0[2] + s0[3]) + (s1[0] + s1[1]) + (s1[2] + s1[3])) * (1.f / 512.f) + EPS);
                bf16* zr = dry ? dry + ((rowc + t) & 8191) * 2048 + h * 64 + 8 * q : PB + (rowc + t) * LDP + PC_Z + h * 64 + 8 * q;
#pragma unroll
                for (int m = 0; m < 2; ++m) { const LAS f32x4* gp = (const LAS f32x4*)((const LAS float*)(lds + SL_GN) + wave * 64 + 32 * m + 8 * q); const f32x4 ga = gp[0], gb = gp[1];
                    const f32x4 va = y[2 * m][tbi], vb = y[2 * m + 1][tbi];
                    u32x4 o; o.x = pk2(va[0] * rstd * ga[0], va[1] * rstd * ga[1]); o.y = pk2(va[2] * rstd * ga[2], va[3] * rstd * ga[3]); o.z = pk2(vb[0] * rstd * gb[0], vb[1] * rstd * gb[1]); o.w = pk2(vb[2] * rstd * gb[2], vb[3] * rstd * gb[3]);
                    if (!(skip & 16)) *(u32x4*)(zr + 32 * m) = o; else asm volatile("" :: "v"(o.x), "v"(o.y), "v"(o.z), "v"(o.w)); } }
        }
        if (!(skip & 4)) { int ln = lane; asm volatile("" : "+v"(ln)); ssd_state_update(H, c63, lds, wave, ln & 15, ln >> 4); }
        lds_barrier();
    }
    if (ssm_out) { int ln = lane; asm volatile("" : "+v"(ln)); const int lr = ln & 15, q = ln >> 4;
#pragma unroll
        for (int nb = 0; nb < 8; ++nb)
#pragma unroll
            for (int pb = 0; pb < 4; ++pb) *(f32x4*)(ssm_out + ((size_t)h * HD + xphys(pb, lr)) * NS + 16 * nb + 4 * q) = H[nb][pb];
    }
}

constexpr int GV_LD = 136;
constexpr int GL_MU = 0, GL_RS = 512, GL_VT = 1024, GL_VT_BYTES = 128 * GV_LD * 2;
static_assert(GL_VT + 2 * GL_VT_BYTES <= LDSCTL_OFF, "gMLP LDS map");

template <int T>
__device__ __forceinline__ void gmlp_stage(const KP a, int layer, const bf16* P0  , int g, float* vout  , LAS unsigned char* lds, int buf, int tid) {
    const LAS float* mu = (const LAS float*)(lds + GL_MU); const LAS float* rs = (const LAS float*)(lds + GL_RS);
#pragma unroll 1
    for (int task = tid; task < 64 * (T / 16); task += NTHREADS) {
        const int tq = task >> 6, pi = task & 63, s0 = 16 * tq, c2 = 2 * pi, cg = g * 128 + c2;
        const f32x2 gg = *(const f32x2*)(a.in(I_GLNG) + (size_t)layer * GMW + cg), gb = *(const f32x2*)(a.in(I_GLNB) + (size_t)layer * GMW + cg);
        unsigned rr[16];
#pragma unroll
        for (int j = 0; j < 16; ++j) rr[j] = *(const unsigned*)(P0 + (size_t)(s0 + j) * LDP + PC_V + cg);
        unsigned q0[8], q1[8];
#pragma unroll
        for (int e = 0; e < 8; ++e) { float oa[2], ob[2];
#pragma unroll
            for (int u = 0; u < 2; ++u) { const int j = 2 * e + u; const float m = mu[s0 + j], r = rs[s0 + j];
                oa[u] = (bflo(rr[j]) - m) * r * gg[0] + gb[0]; ob[u] = (bfhi(rr[j]) - m) * r * gg[1] + gb[1];
                if (vout) *(f32x2*)(vout + (size_t)(s0 + j) * GMW + cg) = (f32x2){oa[u], ob[u]}; }
            q0[e] = pk2(oa[0], oa[1]); q1[e] = pk2(ob[0], ob[1]); }
        LAS unsigned char* d = lds + GL_VT + buf * GL_VT_BYTES + c2 * (GV_LD * 2) + s0 * 2;
        *(LAS u32x4*)d = (u32x4){q0[0], q0[1], q0[2], q0[3]}; *(LAS u32x4*)(d + 16) = (u32x4){q0[4], q0[5], q0[6], q0[7]};
        *(LAS u32x4*)(d + GV_LD * 2) = (u32x4){q1[0], q1[1], q1[2], q1[3]}; *(LAS u32x4*)(d + GV_LD * 2 + 16) = (u32x4){q1[4], q1[5], q1[6], q1[7]};
    }
}
template <int T>
__device__ __forceinline__ void gmlp_item(const KP a, int layer, size_t r0  , float* vout, bf16* PB, const bf16* Wsb  , LAS unsigned char* lds, int tid, int wave, int lane, bf16* dry = nullptr) {
    constexpr int NTB = T / 16;
    bf16* P0 = PB + r0 * LDP;
    { LAS float* mu = (LAS float*)(lds + GL_MU); LAS float* rs = (LAS float*)(lds + GL_RS);
#pragma unroll 1
      for (int t0 = wave * (T / 8); t0 < (wave + 1) * (T / 8); t0 += 8) {
          u32x4 qa[8], qb[8];
#pragma unroll
          for (int i = 0; i < 8; ++i) { const bf16* vr = P0 + (size_t)(t0 + i) * LDP + PC_V + lane * 16; qa[i] = *(const u32x4*)vr; qb[i] = *(const u32x4*)(vr + 8); }
#pragma unroll
          for (int i = 0; i < 8; ++i) {
              const float f[16] = { bflo(qa[i].x), bfhi(qa[i].x), bflo(qa[i].y), bfhi(qa[i].y), bflo(qa[i].z), bfhi(qa[i].z), bflo(qa[i].w), bfhi(qa[i].w), bflo(qb[i].x), bfhi(qb[i].x), bflo(qb[i].y), bfhi(qb[i].y), bflo(qb[i].z), bfhi(qb[i].z), bflo(qb[i].w), bfhi(qb[i].w) };
              float s = 0.f;
#pragma unroll
              for (int j = 0; j < 16; ++j) s += f[j];
              const float mean = wave_sum(s) * (1.f / GMW); float qq = 0.f;
#pragma unroll
              for (int j = 0; j < 16; ++j) { const float d = f[j] - mean; qq += d * d; }
              const float var = wave_sum(qq) * (1.f / GMW);
              if (lane == 0) { mu[t0 + i] = mean; rs[t0 + i] = rsqrtf(var + EPS); } }
      } }
    lds_barrier();
    gmlp_stage<T>(a, layer, P0, 0, vout, lds, 0, tid);
    lds_barrier();
#pragma unroll 1
    for (int g = 0; g < 8; ++g) {
        int ln = lane; asm volatile("" : "+v"(ln)); const int lr = ln & 15, q = ln >> 4;
        if (g + 1 < 8) gmlp_stage<T>(a, layer, P0, g + 1, vout, lds, (g + 1) & 1, wave * 64 + ln);
        const LAS unsigned char* vt = lds + GL_VT + (g & 1) * GL_VT_BYTES + (16 * wave + lr) * (GV_LD * 2);
        bf16x8 af[T / 32];
#pragma unroll
        for (int kk = 0; kk < T / 32; ++kk) af[kk] = *(const LAS bf16x8*)(vt + (32 * kk + 8 * q) * 2);
        const bf16* wg = Wsb + (size_t)g * 128 * 128;
        bf16x8 wf[NTB][T / 32]; float bsv[NTB]; u32x2 uu[NTB];
#pragma unroll
        for (int tb = 0; tb < NTB; ++tb) {
#pragma unroll
            for (int kk = 0; kk <= tb / 2; ++kk) wf[tb][kk] = *(const bf16x8*)(wg + (size_t)(16 * tb + lr) * 128 + 32 * kk + 8 * q);
            bsv[tb] = a.in(I_GBS)[(size_t)(layer * 8 + g) * 128 + 16 * tb + lr];
            uu[tb] = *(const u32x2*)(P0 + (size_t)(16 * tb + lr) * LDP + PC_U + g * 128 + 16 * wave + 4 * q); }
#pragma unroll
        for (int tb = 0; tb < NTB; ++tb) {
            f32x4 acc = {0.f, 0.f, 0.f, 0.f};
#pragma unroll
            for (int kk = 0; kk <= tb / 2; ++kk) acc = MFMA16(af[kk], wf[tb][kk], acc);
            bf16* up = dry ? dry + ((r0 + 16 * tb + lr) & 8191) * 2048 + g * 128 + 16 * wave + 4 * q : P0 + (size_t)(16 * tb + lr) * LDP + PC_U + g * 128 + 16 * wave + 4 * q;
            u32x2 o; o.x = pk2(bflo(uu[tb].x) * (acc[0] + bsv[tb]), bfhi(uu[tb].x) * (acc[1] + bsv[tb])); o.y = pk2(bflo(uu[tb].y) * (acc[2] + bsv[tb]), bfhi(uu[tb].y) * (acc[3] + bsv[tb])); *(u32x2*)up = o;
        }
        lds_barrier();
    }
}

static_assert(GL_VT + 4 * GL_VT_BYTES <= LDSCTL_OFF, "gMLP decode LDS map");
__device__ __forceinline__ void gmlp_stage_dec(const KP a, int layer, const bf16* P0, int g, float* vout, LAS unsigned char* lds, int buf, int tid) {
    const LAS float* mu = (const LAS float*)(lds + GL_MU); const LAS float* rs = (const LAS float*)(lds + GL_RS);
    if (tid < 256) {
        const int tq = tid >> 6, pi = tid & 63, s0 = 16 * tq, c2 = 2 * pi, cg = g * 128 + c2;
        const f32x2 gg = *(const f32x2*)(a.in(I_GLNG) + (size_t)layer * GMW + cg), gb = *(const f32x2*)(a.in(I_GLNB) + (size_t)layer * GMW + cg);
        unsigned rr[16];
#pragma unroll
        for (int j = 0; j < 16; ++j) rr[j] = *(const unsigned*)(P0 + (size_t)(s0 + j) * LDP + PC_V + cg);
        unsigned h0[8], h1[8], l0[8], l1[8];
#pragma unroll
        for (int e = 0; e < 8; ++e) { float oa[2], ob[2];
#pragma unroll
            for (int u = 0; u < 2; ++u) { const int j = 2 * e + u; const float m = mu[s0 + j], r = rs[s0 + j];
                oa[u] = (bflo(rr[j]) - m) * r * gg[0] + gb[0]; ob[u] = (bfhi(rr[j]) - m) * r * gg[1] + gb[1];
                *(f32x2*)(vout + (size_t)(s0 + j) * GMW + cg) = (f32x2){oa[u], ob[u]}; }
            h0[e] = pk2(oa[0], oa[1]); h1[e] = pk2(ob[0], ob[1]);
            l0[e] = pk2(oa[0] - bflo(h0[e]), oa[1] - bfhi(h0[e])); l1[e] = pk2(ob[0] - bflo(h1[e]), ob[1] - bfhi(h1[e])); }
        LAS unsigned char* d = lds + GL_VT + buf * GL_VT_BYTES + c2 * (GV_LD * 2) + s0 * 2;
        *(LAS u32x4*)d = (u32x4){h0[0], h0[1], h0[2], h0[3]}; *(LAS u32x4*)(d + 16) = (u32x4){h0[4], h0[5], h0[6], h0[7]};
        *(LAS u32x4*)(d + GV_LD * 2) = (u32x4){h1[0], h1[1], h1[2], h1[3]}; *(LAS u32x4*)(d + GV_LD * 2 + 16) = (u32x4){h1[4], h1[5], h1[6], h1[7]};
        d += 2 * GL_VT_BYTES;
        *(LAS u32x4*)d = (u32x4){l0[0], l0[1], l0[2], l0[3]}; *(LAS u32x4*)(d + 16) = (u32x4){l0[4], l0[5], l0[6], l0[7]};
        *(LAS u32x4*)(d + GV_LD * 2) = (u32x4){l1[0], l1[1], l1[2], l1[3]}; *(LAS u32x4*)(d + GV_LD * 2 + 16) = (u32x4){l1[4], l1[5], l1[6], l1[7]};
    }
}
__device__ __forceinline__ void gmlp_item_dec(const KP a, int layer, size_t r0, float* vout, bf16* PB, LAS unsigned char* lds, int tid, int wave, int lane) {
    constexpr int T = 64, NTB = 4;
    bf16* P0 = PB + r0 * LDP;
    { LAS float* mu = (LAS float*)(lds + GL_MU); LAS float* rs = (LAS float*)(lds + GL_RS);
      const int t0 = wave * 8;
      u32x4 qa[8], qb[8];
#pragma unroll
      for (int i = 0; i < 8; ++i) { const bf16* vr = P0 + (size_t)(t0 + i) * LDP + PC_V + lane * 16; qa[i] = *(const u32x4*)vr; qb[i] = *(const u32x4*)(vr + 8); }
#pragma unroll
      for (int i = 0; i < 8; ++i) {
          const float f[16] = { bflo(qa[i].x), bfhi(qa[i].x), bflo(qa[i].y), bfhi(qa[i].y), bflo(qa[i].z), bfhi(qa[i].z), bflo(qa[i].w), bfhi(qa[i].w), bflo(qb[i].x), bfhi(qb[i].x), bflo(qb[i].y), bfhi(qb[i].y), bflo(qb[i].z), bfhi(qb[i].z), bflo(qb[i].w), bfhi(qb[i].w) };
          float s = 0.f;
#pragma unroll
          for (int j = 0; j < 16; ++j) s += f[j];
          const float mean = wave_sum(s) * (1.f / GMW); float qq = 0.f;
#pragma unroll
          for (int j = 0; j < 16; ++j) { const float d = f[j] - mean; qq += d * d; }
          const float var = wave_sum(qq) * (1.f / GMW);
          if (lane == 0) { mu[t0 + i] = mean; rs[t0 + i] = rsqrtf(var + EPS); } } }
    lds_barrier();
    gmlp_stage_dec(a, layer, P0, 0, vout, lds, 0, tid);
    lds_barrier();
#pragma unroll 1
    for (int g = 0; g < 8; ++g) {
        int ln = lane; asm volatile("" : "+v"(ln)); const int lr = ln & 15, q = ln >> 4;
        if (g + 1 < 8) gmlp_stage_dec(a, layer, P0, g + 1, vout, lds, (g + 1) & 1, wave * 64 + ln);
        const LAS unsigned char* vt = lds + GL_VT + (g & 1) * GL_VT_BYTES + (16 * wave + lr) * (GV_LD * 2);
        bf16x8 ah[T / 32], al[T / 32];
#pragma unroll
        for (int kk = 0; kk < T / 32; ++kk) { ah[kk] = *(const LAS bf16x8*)(vt + (32 * kk + 8 * q) * 2); al[kk] = *(const LAS bf16x8*)(vt + 2 * GL_VT_BYTES + (32 * kk + 8 * q) * 2); }
        const float* w32 = a.in(I_GWS) + (size_t)(layer * 8 + g) * 128 * 128;
        bf16x8 wh[NTB][T / 32], wl[NTB][T / 32]; float bsv[NTB]; u32x2 uu[NTB];
#pragma unroll
        for (int tb = 0; tb < NTB; ++tb) { const int t = 16 * tb + lr;
#pragma unroll
            for (int kk = 0; kk <= tb / 2; ++kk) { const float* wp = w32 + (size_t)t * 128 + 32 * kk + 8 * q; const f32x4 w0 = *(const f32x4*)wp, w1 = *(const f32x4*)(wp + 4);
                float f[8] = {w0[0], w0[1], w0[2], w0[3], w1[0], w1[1], w1[2], w1[3]};
#pragma unroll
                for (int e = 0; e < 8; ++e) if (32 * kk + 8 * q + e > t) f[e] = 0.f;
                const u32x4 hi = {pk2(f[0], f[1]), pk2(f[2], f[3]), pk2(f[4], f[5]), pk2(f[6], f[7])};
                const u32x4 lo = {pk2(f[0] - bflo(hi.x), f[1] - bfhi(hi.x)), pk2(f[2] - bflo(hi.y), f[3] - bfhi(hi.y)), pk2(f[4] - bflo(hi.z), f[5] - bfhi(hi.z)), pk2(f[6] - bflo(hi.w), f[7] - bfhi(hi.w))};
                wh[tb][kk] = __builtin_bit_cast(bf16x8, hi); wl[tb][kk] = __builtin_bit_cast(bf16x8, lo); }
            bsv[tb] = a.in(I_GBS)[(size_t)(layer * 8 + g) * 128 + t];
            uu[tb] = *(const u32x2*)(P0 + (size_t)t * LDP + PC_U + g * 128 + 16 * wave + 4 * q); }
#pragma unroll
        for (int tb = 0; tb < NTB; ++tb) {
            f32x4 acc = {0.f, 0.f, 0.f, 0.f};
#pragma unroll
            for (int kk = 0; kk <= tb / 2; ++kk) { acc = MFMA16(al[kk], wh[tb][kk], acc); acc = MFMA16(ah[kk], wl[tb][kk], acc); acc = MFMA16(ah[kk], wh[tb][kk], acc); }
            bf16* up = P0 + (size_t)(16 * tb + lr) * LDP + PC_U + g * 128 + 16 * wave + 4 * q;
            u32x2 o; o.x = pk2(bflo(uu[tb].x) * (acc[0] + bsv[tb]), bfhi(uu[tb].x) * (acc[1] + bsv[tb])); o.y = pk2(bflo(uu[tb].y) * (acc[2] + bsv[tb]), bfhi(uu[tb].y) * (acc[3] + bsv[tb])); *(u32x2*)up = o;
        }
        lds_barrier();
    }
}

#ifndef MK_PER_PHASE
#define MK_PER_PHASE 0
#endif
constexpr int WGM_WIDE = 8;
constexpr int WGM_N2K = 4;
constexpr int FFN_R1 = 64 * 256;
constexpr int PH_PER_LAYER = 15, N_PHASES = DEPTH * PH_PER_LAYER + 1;

__global__ void __launch_bounds__(NTHREADS, 2) mk_fwd(Args a_unused) {
    (void)a_unused;
    extern __shared__ __attribute__((aligned(16))) unsigned char lds_raw[];
    LAS unsigned char* lds = (LAS unsigned char*)lds_raw;
    const int G = gridDim.x, bid = blockIdx.x;
    const int wave0 = __builtin_amdgcn_readfirstlane(threadIdx.x >> 6);
    { volatile LAS unsigned* M0 = (volatile LAS unsigned*)(lds + LDSCTL_OFF); if (threadIdx.x < 64) M0[threadIdx.x] = 0u; }
    __syncthreads();
    int lo, hi; XcdBarrier bar;
    { const KP k0 = kp_get(); lo = k0.ph_lo(); hi = k0.ph_hi();
      bar.bar = (unsigned*)(k0.ws() + WS_CTL) + CW_BAR; bar.x = 0; bar.st = (volatile LAS unsigned*)(lds + LDSCTL_OFF) + 8; bar.w0 = (unsigned)wave0;
      if (hi - lo > 1) bar = xcd_barrier_post((unsigned*)(k0.ws() + WS_CTL) + CW_BAR, (volatile LAS unsigned*)(lds + LDSCTL_OFF) + 8, (unsigned)wave0); }
#define PH_LOCALS \
    const KP a = kp_get(); int lane = lane_id(); asm volatile("" : "+v"(lane)); unsigned char* wsb = a.ws(); float* X = a.out(); \
    const int wave = wave0, tid = wave * 64 + lane, gw = bid * NWAVES + wave, NGW = G * NWAVES, gtid = bid * NTHREADS + tid, NGT = G * NTHREADS; \
    bf16* Wb = (bf16*)(wsb + WS_W); bf16* XS = (bf16*)(wsb + WS_HB); bf16* XT = (bf16*)((unsigned char*)X + WSO_XT); float* RS = (float*)(wsb + WS_RS); float* SSQ = (float*)(wsb + WS_SQ); bf16* PB = (bf16*)(wsb + WS_PB); bf16* AB = PB; bf16* PE = (bf16*)(wsb + WS_PE); float* DT = (float*)(wsb + WS_DT); float* PART = (float*)(wsb + WS_PART); \
    (void)tid; (void)gw; (void)NGW; (void)gtid; (void)NGT; (void)Wb; (void)XS; (void)XT; (void)RS; (void)SSQ; (void)PB; (void)AB; (void)PE; (void)DT; (void)PART; (void)X;

    int ph = 0;
#define PH_ON (lo <= ph && ph < hi)
#define PH_END do { if (PH_ON && ph + 1 < hi) xcd_barrier(bar); ++ph; } while (0)

    if (PH_ON) { PH_LOCALS convert_group<0>(a, 0, Wb, lds, gw, NGW, wave, lane); convert_group<1>(a, 0, Wb, lds, gw, NGW, wave, lane);
        convert_group<3>(a, 0, Wb, lds, gw, NGW, wave, lane); convert_misc(a, 0, Wb, PE, gtid, NGT);
        phase_first(a.in(I_XP), a.in(I_XS), XS, RS, gw, NGW, lane);
#ifdef DBG_FILL
        if (0 == 0) for (size_t i = OUT_SSM_P + gtid; i < OUT_END; i += NGT) a.out()[i] = 0.f;
#endif
    }
    PH_END;
    if (PH_ON) { PH_LOCALS pg8::Gemm g{XS, Wb + WO_GU1, XBP, KP_D, M_TOK, FF2, D}; pg8::StaticOrder S; S.init(M_TOK, FF2, D, G, bid, WGM_WIDE);
        EpiGU E{AB, LDF, RS}; pg8::gemm_phase<EpiGU, pg8::StaticOrder, true, true>(lds, g, S, E, wave); }
    PH_END;
    if (PH_ON) { PH_LOCALS
        pg8::Gemm g{AB, Wb + WO_D1, LDF, KP_F, M_TOK, D, FF}; pg8::TailSplitOrder S; S.init(M_P, M_TOK - M_P, M_P / 256, D, FF, G, bid, WGM_N2K, 0);
        EpiRes<false> E{nullptr, nullptr, XS, M_P, 0.5f, PART, SSQ}; pg8::gemm_phase<EpiRes<false>, pg8::TailSplitOrder, true, true>(lds, g, S, E, wave); }
    PH_END;
    if (PH_ON) { PH_LOCALS phase_rstd<true>(SSQ, RS, PART, XS, gw, NGW, lane, gtid, NGT); }
    PH_END;
    if (PH_ON) { PH_LOCALS pg8::Gemm g{XS, Wb + WO_IN, XBP, KP_D, M_TOK, NIN, D}; pg8::StaticOrder S; S.init(M_TOK, NIN, D, G, bid, WGM_WIDE);
        EpiInProj E{PB, DT, a.in(I_DTB) + 0 * NH, RS}; pg8::gemm_phase<EpiInProj, pg8::StaticOrder, true, true>(lds, g, S, E, wave);
        TAIL_CONVERT((M_TOK / 256) * (NIN / 256), convert_group<2>(a, 0, Wb, lds, tw_, tn_, wave, lane);); }
    PH_END;
    if (PH_ON) { PH_LOCALS
        constexpr int N_S1 = NB_P * NSC1 * NG, N_GM = NB_P * (SEQ / 128) + NB_S;
        for (int it = bid; it < N_S1; it += G) ssd1_item(a, 0, it / (NSC1 * NG), (it / NG) % NSC1, it % NG, PB, DT, (unsigned char*)X, lds, tid, wave, lane);
        for (int j = bid; j < NB_P * (SEQ / 128); j += G) gmlp_item<128>(a, 0, (size_t)(j / (SEQ / 128)) * SEQ + (size_t)(j % (SEQ / 128)) * 128, nullptr, PB, Wb + WO_WS, lds, tid, wave, lane);
        for (int bs = (G >= NB_S) ? bid - (G - NB_S) : bid; bs < NB_S; bs += G) if (bs >= 0)
            gmlp_item_dec(a, 0, (size_t)M_P + (size_t)bs * L_S, X + OUT_GV + (size_t)(0 * NB_S + bs) * L_S * GMW, PB, lds, tid, wave, lane);
        (void)N_GM;
    }
    PH_END;
    if (PH_ON) { PH_LOCALS
        constexpr int N_S3D = NB_S * NG;
        if (G > N_S3D) {
            if (bid < N_S3D) { const int bs = bid / NG, g = bid % NG;
                ssd3_item(a, 0, (size_t)M_P + (size_t)bs * L_S, 1, g, nullptr, a.in(I_SSSM) + (size_t)(0 * NB_S + bs) * NH * HD * NS, 2, a.in(I_SCONV) + (size_t)(0 * NB_S + bs) * 3 * XBC,
                          X + OUT_SSM_S + (size_t)(0 * NB_S + bs) * NH * HD * NS, X + OUT_CONV_S + (size_t)(0 * NB_S + bs) * 3 * XBC, PB, DT, lds, tid, wave, lane); }
            else ssd2_phase((unsigned char*)X, gw - N_S3D * NWAVES, NGW - N_S3D * NWAVES, lane);
        } else {
            for (int j = bid; j < N_S3D; j += G) { const int bs = j / NG, g = j % NG;
                ssd3_item(a, 0, (size_t)M_P + (size_t)bs * L_S, 1, g, nullptr, a.in(I_SSSM) + (size_t)(0 * NB_S + bs) * NH * HD * NS, 2, a.in(I_SCONV) + (size_t)(0 * NB_S + bs) * 3 * XBC,
                          X + OUT_SSM_S + (size_t)(0 * NB_S + bs) * NH * HD * NS, X + OUT_CONV_S + (size_t)(0 * NB_S + bs) * 3 * XBC, PB, DT, lds, tid, wave, lane); }
            ssd2_phase((unsigned char*)X, gw, NGW, lane);
        }
    }
    PH_END;
    if (PH_ON) { PH_LOCALS
        constexpr int N_S3P = NB_P * NSC * NG;
        for (int it = bid; it < N_S3P; it += G) {
            { const int b = it / (NSC * NG), k = (it / NG) % NSC, g = it % NG; const bool lastk = (k == NSC - 1);
                ssd3_item(a, 0, (size_t)b * SEQ + (size_t)k * SC * 64, SC, g, k ? (const float*)((unsigned char*)X + WSO_ST) + ((size_t)b * NSC1 + (k - 1)) * NH * ST_ELEMS : nullptr, nullptr, k ? 1 : 0, nullptr,
                          lastk ? X + OUT_SSM_P + (size_t)(0 * NB_P + b) * NH * HD * NS : nullptr, lastk ? X + OUT_CONV_P + (size_t)(0 * NB_P + b) * 3 * XBC : nullptr, PB, DT, lds, tid, wave, lane); }
        }
    }
    PH_END;
    if (PH_ON) { PH_LOCALS
        { pg8::Gemm g{PB + PC_Z, Wb + WO_A, LDP, KP_D, M_TOK, D, DIN}; pg8::StaticOrder S; S.init(M_TOK, D, DIN, G, bid, WGM_N2K);
          EpiMerge<0> E{PB + PC_GA, PB + PC_MRG}; pg8::gemm_phase<EpiMerge<0>, pg8::StaticOrder, true, true>(lds, g, S, E, wave); }
        { pg8::Gemm g{PB + PC_U, Wb + WO_B, LDP, KP_G, M_TOK, D, GMW}; pg8::StaticOrder S; S.init(M_TOK, D, GMW, G, bid, WGM_N2K);
          EpiMerge<1> E{PB + PC_GB, PB + PC_MRG}; pg8::gemm_phase<EpiMerge<1>, pg8::StaticOrder, true, true>(lds, g, S, E, wave); }
        TAIL_CONVERT((M_TOK / 256) * (D / 256), convert_group<0>(a, 1, Wb, lds, tw_, tn_, wave, lane); convert_group<1>(a, 1, Wb, lds, tw_, tn_, wave, lane););
    }
    PH_END;
    if (PH_ON) { PH_LOCALS pg8::Gemm g{PB + PC_MRG, Wb + WO_O, LDP, KP_D, M_TOK, D, D}; pg8::TailSplitOrder S; S.init(M_P, M_TOK - M_P, M_P / 256, D, D, G, bid, WGM_N2K, 0);
        EpiRes<false> E{nullptr, nullptr, XS, M_P, 1.0f, PART, SSQ}; pg8::gemm_phase<EpiRes<false>, pg8::TailSplitOrder, true, true>(lds, g, S, E, wave); }
    PH_END;
    if (PH_ON) { PH_LOCALS phase_rstd<true>(SSQ, RS, PART, XS, gw, NGW, lane, gtid, NGT); }
    PH_END;
    if (PH_ON) { PH_LOCALS pg8::Gemm g{XS, Wb + WO_GU2, XBP, KP_D, M_TOK, FF2, D}; pg8::StaticOrder S; S.init(M_TOK, FF2, D, G, bid, WGM_WIDE);
        EpiGU E{AB, LDF, RS}; pg8::gemm_phase<EpiGU, pg8::StaticOrder, true, true>(lds, g, S, E, wave); }
    PH_END;
    if (PH_ON) { PH_LOCALS
        pg8::Gemm g{AB, Wb + WO_D2, LDF, KP_F, M_TOK, D, FF}; pg8::TailSplitOrder S; S.init(M_P, M_TOK - M_P, M_P / 256, D, FF, G, bid, WGM_N2K, 0);
        EpiRes<false> E{nullptr, nullptr, XS, M_P, 0.5f, PART, SSQ}; pg8::gemm_phase<EpiRes<false>, pg8::TailSplitOrder, true, true>(lds, g, S, E, wave); }
    PH_END;
    if (PH_ON) { PH_LOCALS phase_rstd<true>(SSQ, RS, PART, XS, gw, NGW, lane, gtid, NGT); }
    PH_END;
    if (PH_ON) { PH_LOCALS
        { pg8::Gemm g{XS, Wb + WO_PG, XBP, KP_D, M_TOK, D, D}; pg8::StaticOrder S; S.init(M_TOK, D, D, G, bid, WGM_N2K);
          EpiPg E{PB + PC_TMP, RS}; pg8::gemm_phase<EpiPg, pg8::StaticOrder, true, true>(lds, g, S, E, wave); }
        { pg8::Gemm g{PE, Wb + WO_PP, LDE, KP_E, M_TOK, D, PLE}; pg8::StaticOrder S; S.init(M_TOK, D, PLE, G, bid, WGM_N2K);
          EpiPle E{PB + PC_TMP, XS, XT, SSQ}; pg8::gemm_phase<EpiPle, pg8::StaticOrder, true, true>(lds, g, S, E, wave); }
        TAIL_CONVERT((M_TOK / 256) * (D / 256), convert_group<2>(a, 1, Wb, lds, tw_, tn_, wave, lane););
    }
    PH_END;
    if (PH_ON) { PH_LOCALS
        convert_group<3>(a, 1, Wb, lds, gw, NGW, wave, lane); convert_misc(a, 1, Wb, PE, gtid, NGT);
        phase_rstd<false>(SSQ, RS, PART, XT, gw, NGW, lane, gtid, NGT);
#ifdef DBG_FILL
        if (1 == 0) for (size_t i = OUT_SSM_P + gtid; i < OUT_END; i += NGT) a.out()[i] = 0.f;
#endif
    }
    PH_END;
    if (PH_ON) { PH_LOCALS pg8::Gemm g{XT, Wb + WO_GU1, XBP, KP_D, M_TOK, FF2, D}; pg8::StaticOrder S; S.init(M_TOK, FF2, D, G, bid, WGM_WIDE);
        EpiGU E{AB, LDF, RS}; pg8::gemm_phase<EpiGU, pg8::StaticOrder, true, true>(lds, g, S, E, wave); }
    PH_END;
    if (PH_ON) { PH_LOCALS
        pg8::Gemm g{AB, Wb + WO_D1, LDF, KP_F, M_TOK, D, FF}; pg8::TailSplitOrder S; S.init(M_P, M_TOK - M_P, M_P / 256, D, FF, G, bid, WGM_N2K, 0);
        EpiRes<false> E{nullptr, nullptr, XT, M_P, 0.5f, PART, SSQ}; pg8::gemm_phase<EpiRes<false>, pg8::TailSplitOrder, true, true>(lds, g, S, E, wave); }
    PH_END;
    if (PH_ON) { PH_LOCALS phase_rstd<true>(SSQ, RS, PART, XT, gw, NGW, lane, gtid, NGT); }
    PH_END;
    if (PH_ON) { PH_LOCALS pg8::Gemm g{XT, Wb + WO_IN, XBP, KP_D, M_TOK, NIN, D}; pg8::StaticOrder S; S.init(M_TOK, NIN, D, G, bid, WGM_WIDE);
        EpiInProj E{PB, DT, a.in(I_DTB) + 1 * NH, RS}; pg8::gemm_phase<EpiInProj, pg8::StaticOrder, true, true>(lds, g, S, E, wave); }
    PH_END;
    if (PH_ON) { PH_LOCALS
        constexpr int N_S1 = NB_P * NSC1 * NG, N_GM = NB_P * (SEQ / 128) + NB_S;
        for (int it = bid; it < N_S1; it += G) ssd1_item(a, 1, it / (NSC1 * NG), (it / NG) % NSC1, it % NG, PB, DT, (unsigned char*)X, lds, tid, wave, lane);
        for (int j = bid; j < NB_P * (SEQ / 128); j += G) gmlp_item<128>(a, 1, (size_t)(j / (SEQ / 128)) * SEQ + (size_t)(j % (SEQ / 128)) * 128, nullptr, PB, Wb + WO_WS, lds, tid, wave, lane);
        for (int bs = (G >= NB_S) ? bid - (G - NB_S) : bid; bs < NB_S; bs += G) if (bs >= 0)
            gmlp_item_dec(a, 1, (size_t)M_P + (size_t)bs * L_S, X + OUT_GV + (size_t)(1 * NB_S + bs) * L_S * GMW, PB, lds, tid, wave, lane);
        (void)N_GM;
    }
    PH_END;
    if (PH_ON) { PH_LOCALS
        constexpr int N_S3D = NB_S * NG;
        if (G > N_S3D) {
            if (bid < N_S3D) { const int bs = bid / NG, g = bid % NG;
                ssd3_item(a, 1, (size_t)M_P + (size_t)bs * L_S, 1, g, nullptr, a.in(I_SSSM) + (size_t)(1 * NB_S + bs) * NH * HD * NS, 2, a.in(I_SCONV) + (size_t)(1 * NB_S + bs) * 3 * XBC,
                          X + OUT_SSM_S + (size_t)(1 * NB_S + bs) * NH * HD * NS, X + OUT_CONV_S + (size_t)(1 * NB_S + bs) * 3 * XBC, PB, DT, lds, tid, wave, lane); }
            else ssd2_phase((unsigned char*)X, gw - N_S3D * NWAVES, NGW - N_S3D * NWAVES, lane);
        } else {
            for (int j = bid; j < N_S3D; j += G) { const int bs = j / NG, g = j % NG;
                ssd3_item(a, 1, (size_t)M_P + (size_t)bs * L_S, 1, g, nullptr, a.in(I_SSSM) + (size_t)(1 * NB_S + bs) * NH * HD * NS, 2, a.in(I_SCONV) + (size_t)(1 * NB_S + bs) * 3 * XBC,
                          X + OUT_SSM_S + (size_t)(1 * NB_S + bs) * NH * HD * NS, X + OUT_CONV_S + (size_t)(1 * NB_S + bs) * 3 * XBC, PB, DT, lds, tid, wave, lane); }
            ssd2_phase((unsigned char*)X, gw, NGW, lane);
        }
    }
    PH_END;
    if (PH_ON) { PH_LOCALS
        constexpr int N_S3P = NB_P * NSC * NG;
        for (int it = bid; it < N_S3P; it += G) {
            { const int b = it / (NSC * NG), k = (it / NG) % NSC, g = it % NG; const bool lastk = (k == NSC - 1);
                ssd3_item(a, 1, (size_t)b * SEQ + (size_t)k * SC * 64, SC, g, k ? (const float*)((unsigned char*)X + WSO_ST) + ((size_t)b * NSC1 + (k - 1)) * NH * ST_ELEMS : nullptr, nullptr, k ? 1 : 0, nullptr,
                          lastk ? X + OUT_SSM_P + (size_t)(1 * NB_P + b) * NH * HD * NS : nullptr, lastk ? X + OUT_CONV_P + (size_t)(1 * NB_P + b) * 3 * XBC : nullptr, PB, DT, lds, tid, wave, lane); }
        }
    }
    PH_END;
    if (PH_ON) { PH_LOCALS
        { pg8::Gemm g{PB + PC_Z, Wb + WO_A, LDP, KP_D, M_TOK, D, DIN}; pg8::StaticOrder S; S.init(M_TOK, D, DIN, G, bid, WGM_N2K);
          EpiMerge<0> E{PB + PC_GA, PB + PC_MRG}; pg8::gemm_phase<EpiMerge<0>, pg8::StaticOrder, true, true>(lds, g, S, E, wave); }
        { pg8::Gemm g{PB + PC_U, Wb + WO_B, LDP, KP_G, M_TOK, D, GMW}; pg8::StaticOrder S; S.init(M_TOK, D, GMW, G, bid, WGM_N2K);
          EpiMerge<1> E{PB + PC_GB, PB + PC_MRG}; pg8::gemm_phase<EpiMerge<1>, pg8::StaticOrder, true, true>(lds, g, S, E, wave); }
    }
    PH_END;
    if (PH_ON) { PH_LOCALS pg8::Gemm g{PB + PC_MRG, Wb + WO_O, LDP, KP_D, M_TOK, D, D}; pg8::TailSplitOrder S; S.init(M_P, M_TOK - M_P, M_P / 256, D, D, G, bid, WGM_N2K, 0);
        EpiRes<false> E{nullptr, nullptr, XT, M_P, 1.0f, PART, SSQ}; pg8::gemm_phase<EpiRes<false>, pg8::TailSplitOrder, true, true>(lds, g, S, E, wave); }
    PH_END;
    if (PH_ON) { PH_LOCALS phase_rstd<true>(SSQ, RS, PART, XT, gw, NGW, lane, gtid, NGT); }
    PH_END;
    if (PH_ON) { PH_LOCALS pg8::Gemm g{XT, Wb + WO_GU2, XBP, KP_D, M_TOK, FF2, D}; pg8::StaticOrder S; S.init(M_TOK, FF2, D, G, bid, WGM_WIDE);
        EpiGU E{AB, LDF, RS}; pg8::gemm_phase<EpiGU, pg8::StaticOrder, true, true>(lds, g, S, E, wave); }
    PH_END;
    if (PH_ON) { PH_LOCALS
        pg8::Gemm g{AB, Wb + WO_D2, LDF, KP_F, M_TOK, D, FF}; pg8::TailSplitOrder S; S.init(M_P, M_TOK - M_P, M_P / 256, D, FF, G, bid, WGM_N2K, 0);
        EpiRes<false> E{nullptr, nullptr, XT, M_P, 0.5f, PART, SSQ}; pg8::gemm_phase<EpiRes<false>, pg8::TailSplitOrder, true, true>(lds, g, S, E, wave); }
    PH_END;
    if (PH_ON) { PH_LOCALS phase_rstd<true>(SSQ, RS, PART, XT, gw, NGW, lane, gtid, NGT); }
    PH_END;
    if (PH_ON) { PH_LOCALS
        { pg8::Gemm g{XT, Wb + WO_PG, XBP, KP_D, M_TOK, D, D}; pg8::StaticOrder S; S.init(M_TOK, D, D, G, bid, WGM_N2K);
          EpiPg E{PB + PC_TMP, RS}; pg8::gemm_phase<EpiPg, pg8::StaticOrder, true, true>(lds, g, S, E, wave); }
        { pg8::Gemm g{PE, Wb + WO_PP, LDE, KP_E, M_TOK, D, PLE}; pg8::StaticOrder S; S.init(M_TOK, D, PLE, G, bid, WGM_N2K);
          EpiPle E{PB + PC_TMP, XT, XS, SSQ}; pg8::gemm_phase<EpiPle, pg8::StaticOrder, true, true>(lds, g, S, E, wave); }
    }
    PH_END;
    if (PH_ON) { PH_LOCALS phase_final_norm(XS, X, a.in(I_FINN), gw, NGW, lane); }
    PH_END;
#undef PH_ON
#undef PH_END
}

extern "C" void kernel_launch(void* const* d_in, const int* in_sizes, int n_in, void* d_out, int out_size, void* d_ws, size_t ws_size, hipStream_t stream) {
    static int grid = 0;
    if (grid == 0) {
        if (n_in != N_IN || (size_t)out_size != OUT_END || ws_size < WS_END) { fprintf(stderr, "kernel_launch: unexpected problem: n_in %d out %d ws %zu (need %zu)\n", n_in, out_size, ws_size, (size_t)WS_END); grid = -1; return; }
        int dev = 0, cus = 0, per_cu = 0;
        if (hipGetDevice(&dev) != hipSuccess || hipDeviceGetAttribute(&cus, hipDeviceAttributeMultiprocessorCount, dev) != hipSuccess) { grid = -1; return; }
        if (hipFuncSetAttribute((const void*)mk_fwd, hipFuncAttributeMaxDynamicSharedMemorySize, LDS_BYTES) != hipSuccess) { fprintf(stderr, "kernel_launch: hipFuncSetAttribute failed\n"); grid = -1; return; }
        if (hipOccupancyMaxActiveBlocksPerMultiprocessor(&per_cu, (const void*)mk_fwd, NTHREADS, LDS_BYTES) != hipSuccess || per_cu < 1) { fprintf(stderr, "kernel_launch: occupancy query says %d blocks per CU\n", per_cu); (void)hipGetLastError(); grid = -1; return; }
        grid = cus;
    }
    if (grid < 0) return;
    (void)in_sizes;
    if (hipMemsetAsync((char*)d_ws + WS_CTL, 0, CTL_ZERO_BYTES, stream) != hipSuccess) return;
    Args a{};
    for (int i = 0; i < N_IN; ++i) a.in[i] = (const float*)d_in[i];
    a.out = (float*)d_out; a.ws = (unsigned char*)d_ws;
#if MK_PER_PHASE
    #ifndef DBG_LIMIT
#define DBG_LIMIT N_PHASES
#endif
    for (int p = 0; p < DBG_LIMIT; ++p) { a.ph_lo = p; a.ph_hi = p + 1; hipLaunchKernelGGL(mk_fwd, dim3(grid), dim3(NTHREADS), LDS_BYTES, stream, a); }
#else
    a.ph_lo = 0; a.ph_hi = N_PHASES; hipLaunchKernelGGL(mk_fwd, dim3(grid), dim3(NTHREADS), LDS_BYTES, stream, a);
#endif
    const hipError_t le = hipPeekAtLastError();
    if (le != hipSuccess) fprintf(stderr, "kernel_launch: launch failed: %s\n", hipGetErrorName(le));
}
```

```cpp
#include <hip/hip_runtime.h>
#include <cstdio>
#include <cstdint>

namespace pg8 {
#define PG8_LAS __attribute__((address_space(3)))
typedef unsigned short bf16_t;
typedef short bf16x8 __attribute__((ext_vector_type(8)));
typedef float f32x4 __attribute__((ext_vector_type(4)));
typedef float f32x2 __attribute__((ext_vector_type(2)));
typedef unsigned u32x4 __attribute__((ext_vector_type(4)));
typedef unsigned u32x2 __attribute__((ext_vector_type(2)));
constexpr int BM = 256, BK = 64, HALF = 128, HTB = HALF * BK * 2  , STAGE_BYTES = 8 * HTB, NXCD = 8, WGM = 8;

__host__ __device__ __forceinline__ int lds_byte(int r, int c) { const int st = (r >> 4) * 2 + (c >> 5), rr = r & 15, cc = c & 31, ob = rr * 64 + cc * 2; return st * 1024 + (ob ^ (((ob >> 9) & 1) << 5)); }
__host__ __device__ __forceinline__ void stage_rc(int b, int& R, int& C) { const int st = b / 1024, sb = b % 1024, swz = sb ^ (((sb >> 9) & 1) << 5); R = (st >> 1) * 16 + swz / 64; C = (st & 1) * 32 + (swz % 64) / 2; }
__host__ __device__ __forceinline__ int perm32(int rho) { const int n = rho >> 4, i = rho & 15; return 8 * (i >> 2) + 4 * n + (i & 3); }

struct Unit { int pm, pn, kt0, ktn, slice; };
struct Gemm { const bf16_t* A; const bf16_t* Bt; int lda, ldb, M, N, K; };

struct StaticOrder {
    int nM, nN, nwg, G, c, ntk, wgm, pmb;
    __host__ __device__ __forceinline__ void init(int M, int N, int K, int G_, int c_, int wgm_ = WGM, int pmb_ = 0) { nM = M / BM; nN = N / BM; nwg = nM * nN; G = G_; c = c_; ntk = K / BK; wgm = wgm_; pmb = pmb_; }
    __host__ __device__ __forceinline__ void tile_of(int L, int& pm, int& pn) const {
        int wgid = L; { const int q = nwg / NXCD, r = nwg % NXCD, xcd = wgid % NXCD, off = wgid / NXCD; wgid = (xcd < r ? xcd * (q + 1) : r * (q + 1) + (xcd - r) * q) + off; }
        const int nig = wgm * nN, gid = wgid / nig, fm = gid * wgm, gsz = (nM - fm) < wgm ? (nM - fm) : wgm;
        pm = pmb + fm + ((wgid % nig) % gsz); pn = (wgid % nig) / gsz;
    }
    __host__ __device__ __forceinline__ bool next(int i, Unit& u) const {
        const long L = (long)i * G + c; const bool ok = L < nwg;
        int pm, pn; tile_of(ok ? (int)L : 0, pm, pn);
        u.pm = pm; u.pn = pn; u.kt0 = 0; u.ktn = ntk; u.slice = -1; return ok;
    }
    __device__ __forceinline__ void a_ready(const Unit&) const {}
    __device__ __forceinline__ void done(const Unit&) const {}
};
struct TailSplitOrder : StaticOrder {
    int nmain, ntail, pm0;
    __host__ __device__ __forceinline__ void init(int M_main, int M_tail, int pmt, int N, int K, int G_, int c_, int wgm_ = WGM, int pmb_ = 0) { StaticOrder::init(M_main, N, K, G_, c_, wgm_, pmb_); nmain = nwg; pm0 = pmt; ntail = M_tail / BM * nN * 8; }
    __host__ __device__ __forceinline__ bool next(int i, Unit& u) const {
        const long L = (long)i * G + c; const bool is_main = L < nmain; const long ti = L - nmain; const bool ok = is_main || ti < ntail;
        int pm, pn; tile_of(is_main ? (int)L : 0, pm, pn);
        const int idx = (!is_main && ok) ? (int)ti : 0, tl = idx >> 3, sl = idx & 7, half = ntk >> 1, q = half >> 3, r = half & 7;
        u.pm = is_main ? pm : pm0 + tl / nN; u.pn = is_main ? pn : tl % nN;
        u.kt0 = is_main ? 0 : 2 * (sl * q + (sl < r ? sl : r)); u.ktn = is_main ? ntk : 2 * (q + (sl < r ? 1 : 0)); u.slice = is_main ? -1 : sl; return ok;
    }
};

typedef __bf16 bf16x2_hw __attribute__((ext_vector_type(2)));
__device__ __forceinline__ unsigned cvt_pk_bf16(float lo, float hi) { const f32x2 v = {lo, hi}; const bf16x2_hw b = __builtin_convertvector(v, bf16x2_hw); return __builtin_bit_cast(unsigned, b); }

template <class Epi, class Sched, bool ALIGN_EPI = false, bool SP2 = false>
__device__ __forceinline__ void gemm_phase(PG8_LAS unsigned char* lds, const Gemm g, const Sched& S, const Epi& E, const int wid  ) {
    int lane = (int)__builtin_amdgcn_mbcnt_hi(~0u, __builtin_amdgcn_mbcnt_lo(~0u, 0u)); asm volatile("" : "+v"(lane));
    const int tid = wid * 64 + lane, wr = wid >> 2, wc = wid & 3, fr = lane & 15, fq = lane >> 4;
    unsigned voffA[2], voffB[2];
#pragma unroll
    for (int i = 0; i < 2; ++i) { int R, C; stage_rc(tid * 16 + i * 8192, R, C); const int Rb = Epi::PERM ? ((R & ~31) + perm32(R & 31)) : R;
        voffA[i] = (unsigned)(R * g.lda + C) * 2u; voffB[i] = (unsigned)(Rb * g.ldb + C) * 2u; }
    const size_t kstep = (size_t)(BK * 2);
    const size_t hsA = (size_t)HALF * g.lda * 2, hsB = (size_t)HALF * g.ldb * 2;
    const size_t tsA = 2 * hsA, tsB = 2 * hsB;
    const unsigned ldsw = (unsigned)wid * 1024u;
    const int aoff = lds_byte(wr * 64 + fr, fq * 8), boff = lds_byte(wc * 32 + fr, fq * 8);
#define PG8_SA(b, h) (((b) * 2 + (h)) * HTB)
#define PG8_SB(b, h) ((4 + (b) * 2 + (h)) * HTB)
#define PG8_STAGE(bufoff, gbase, voff) do { _Pragma("unroll") for (int _i = 0; _i < 2; ++_i) \
        __builtin_amdgcn_global_load_lds((const unsigned*)((const char*)(gbase) + (voff)[_i]), (PG8_LAS unsigned*)(lds + (bufoff) + ldsw + _i * 8192), 16, 0, 0); } while (0)
#define PG8_LDA(dst, b, h) do { _Pragma("unroll") for (int m = 0; m < 4; ++m) _Pragma("unroll") for (int k = 0; k < 2; ++k) dst[m][k] = *(const PG8_LAS bf16x8*)(lds + PG8_SA(b, h) + aoff + m * 2048 + k * 1024); } while (0)
#define PG8_LDB(dst, b, h) do { _Pragma("unroll") for (int n = 0; n < 2; ++n) _Pragma("unroll") for (int k = 0; k < 2; ++k) dst[n][k] = *(const PG8_LAS bf16x8*)(lds + PG8_SB(b, h) + boff + n * 2048 + k * 1024); } while (0)
#define PG8_MMA(ai, bj, At, Bt) do { __builtin_amdgcn_s_setprio(1); _Pragma("unroll") for (int m = 0; m < 4; ++m) _Pragma("unroll") for (int n = 0; n < 2; ++n) _Pragma("unroll") for (int k = 0; k < 2; ++k) \
        acc[ai][bj][m][n] = __builtin_amdgcn_mfma_f32_16x16x32_bf16(Bt[n][k], At[m][k], acc[ai][bj][m][n], 0, 0, 0); __builtin_amdgcn_s_setprio(0); } while (0)
#define PG8_WAIT_V(n) asm volatile("s_waitcnt vmcnt(" #n ")" ::: "memory")
#define PG8_WAIT_L(n) asm volatile("s_waitcnt lgkmcnt(" #n ")" ::: "memory")
#define PG8_BAR __builtin_amdgcn_s_barrier()
#define PG8_SCHED __builtin_amdgcn_sched_barrier(0)
    Unit cur, nxt; int ui = 0;
    if (!S.next(0, cur)) return;
    f32x4 acc[2][2][4][2];
#pragma unroll
    for (int a = 0; a < 2; ++a)
#pragma unroll
        for (int b = 0; b < 2; ++b)
#pragma unroll
            for (int m = 0; m < 4; ++m)
#pragma unroll
                for (int n = 0; n < 2; ++n) acc[a][b][m][n] = (f32x4){0.f, 0.f, 0.f, 0.f};
    bf16x8 At[4][2], B0[2][2], B1[2][2];
    const char* cA = (const char*)g.A + (size_t)cur.pm * tsA + (size_t)cur.kt0 * kstep; const char* cB = (const char*)g.Bt + (size_t)cur.pn * tsB + (size_t)cur.kt0 * kstep;
    S.a_ready(cur);
    if constexpr (SP2) {
        PG8_STAGE(PG8_SB(0, 0), cB, voffB); PG8_STAGE(PG8_SB(0, 1), cB + hsB, voffB); PG8_STAGE(PG8_SA(0, 0), cA, voffA); PG8_STAGE(PG8_SA(0, 1), cA + hsA, voffA);
        if (wr == 1) PG8_BAR;
        PG8_WAIT_V(2); PG8_BAR;
        PG8_STAGE(PG8_SB(1, 0), cB + kstep, voffB); PG8_STAGE(PG8_SA(1, 0), cA + kstep, voffA); PG8_STAGE(PG8_SB(1, 1), cB + hsB + kstep, voffB);
        PG8_WAIT_V(6); PG8_BAR;
    } else {
        PG8_STAGE(PG8_SB(0, 0), cB, voffB); PG8_STAGE(PG8_SA(0, 0), cA, voffA); PG8_STAGE(PG8_SB(0, 1), cB + hsB, voffB); PG8_STAGE(PG8_SA(0, 1), cA + hsA, voffA);
        if (wr == 1) PG8_BAR;
        PG8_WAIT_V(4); PG8_BAR;
        PG8_STAGE(PG8_SB(1, 0), cB + kstep, voffB); PG8_STAGE(PG8_SA(1, 0), cA + kstep, voffA); PG8_STAGE(PG8_SB(1, 1), cB + hsB + kstep, voffB);
        PG8_WAIT_V(6); PG8_BAR;
    }
    for (;;) {
        const bool has_next = S.next(ui + 1, nxt); const int nt = cur.ktn;
        const char* nA = has_next ? (const char*)g.A + (size_t)nxt.pm * tsA + (size_t)nxt.kt0 * kstep : cA; const char* nB = has_next ? (const char*)g.Bt + (size_t)nxt.pn * tsB + (size_t)nxt.kt0 * kstep : cB;
        for (int t = 0; t < nt; t += 2) {
            const bool last = (t == nt - 2);
            const char* a1 = cA + (size_t)(t + 1) * kstep;
            const char* a2 = last ? nA : cA + (size_t)(t + 2) * kstep; const char* b2 = last ? nB : cB + (size_t)(t + 2) * kstep;
            const char* a3 = a2 + kstep; const char* b3 = b2 + kstep;
            if (last && has_next) S.a_ready(nxt);
            if constexpr (SP2) {
            PG8_LDB(B0, 0, 0); PG8_LDB(B1, 0, 1); PG8_SCHED; PG8_LDA(At, 0, 0); PG8_STAGE(PG8_SA(1, 1), a1 + hsA, voffA);
            PG8_WAIT_V(8); PG8_WAIT_L(0); PG8_BAR; PG8_MMA(0, 0, At, B0); PG8_MMA(0, 1, At, B1); PG8_BAR; PG8_SCHED;
            PG8_LDA(At, 0, 1); PG8_STAGE(PG8_SB(0, 0), b2, voffB); PG8_STAGE(PG8_SB(0, 1), b2 + hsB, voffB); PG8_STAGE(PG8_SA(0, 0), a2, voffA);
            PG8_WAIT_V(8); PG8_WAIT_L(0); PG8_BAR; PG8_MMA(1, 0, At, B0); PG8_MMA(1, 1, At, B1); PG8_BAR; PG8_SCHED;
            PG8_LDB(B0, 1, 0); PG8_LDB(B1, 1, 1); PG8_SCHED; PG8_LDA(At, 1, 0); PG8_STAGE(PG8_SA(0, 1), a2 + hsA, voffA);
            PG8_WAIT_V(8); PG8_WAIT_L(0); PG8_BAR; PG8_MMA(0, 0, At, B0); PG8_MMA(0, 1, At, B1); PG8_BAR; PG8_SCHED;
            PG8_LDA(At, 1, 1); PG8_STAGE(PG8_SB(1, 0), b3, voffB); PG8_STAGE(PG8_SB(1, 1), b3 + hsB, voffB); PG8_STAGE(PG8_SA(1, 0), a3, voffA);
            PG8_WAIT_V(8); PG8_WAIT_L(0); PG8_BAR; PG8_MMA(1, 0, At, B0); PG8_MMA(1, 1, At, B1); PG8_BAR; PG8_SCHED;
            } else {
            PG8_LDB(B0, 0, 0); PG8_SCHED; PG8_LDA(At, 0, 0); PG8_STAGE(PG8_SA(1, 1), a1 + hsA, voffA);
            PG8_WAIT_L(8); PG8_BAR; PG8_WAIT_L(0); PG8_MMA(0, 0, At, B0); PG8_BAR; PG8_SCHED;
            PG8_LDB(B1, 0, 1); PG8_STAGE(PG8_SB(0, 0), b2, voffB);
            PG8_BAR; PG8_WAIT_L(0); PG8_MMA(0, 1, At, B1); PG8_BAR;
            PG8_LDA(At, 0, 1); PG8_STAGE(PG8_SA(0, 0), a2, voffA);
            PG8_BAR; PG8_WAIT_L(0); PG8_MMA(1, 0, At, B0); PG8_BAR; PG8_SCHED;
            PG8_STAGE(PG8_SB(0, 1), b2 + hsB, voffB);
            PG8_WAIT_V(6); PG8_BAR; PG8_MMA(1, 1, At, B1); PG8_BAR;
            PG8_LDB(B0, 1, 0); PG8_SCHED; PG8_LDA(At, 1, 0); PG8_STAGE(PG8_SA(0, 1), a2 + hsA, voffA);
            PG8_WAIT_L(8); PG8_BAR; PG8_WAIT_L(0); PG8_MMA(0, 0, At, B0); PG8_BAR; PG8_SCHED;
            PG8_LDB(B1, 1, 1); PG8_STAGE(PG8_SB(1, 0), b3, voffB);
            PG8_BAR; PG8_WAIT_L(0); PG8_MMA(0, 1, At, B1); PG8_BAR;
            PG8_LDA(At, 1, 1); PG8_STAGE(PG8_SA(1, 0), a3, voffA);
            PG8_BAR; PG8_WAIT_L(0); PG8_MMA(1, 0, At, B0); PG8_BAR; PG8_SCHED;
            PG8_STAGE(PG8_SB(1, 1), b3 + hsB, voffB);
            PG8_WAIT_V(6); PG8_BAR; PG8_MMA(1, 1, At, B1); PG8_BAR;
            }
        }
        if constexpr (ALIGN_EPI) { if (wr == 0) PG8_BAR; }
        E(acc, cur, wr, wc, fr, fq); S.done(cur);
        if (!has_next) break;
#pragma unroll
        for (int a = 0; a < 2; ++a)
#pragma unroll
            for (int b = 0; b < 2; ++b)
#pragma unroll
                for (int m = 0; m < 4; ++m)
#pragma unroll
                    for (int n = 0; n < 2; ++n) acc[a][b][m][n] = (f32x4){0.f, 0.f, 0.f, 0.f};
        cur = nxt; cA = nA; cB = nB; ++ui;
        if constexpr (ALIGN_EPI) { if (wr == 1) PG8_BAR; }
    }
    PG8_WAIT_V(0);
    if constexpr (!ALIGN_EPI) { if (wr == 0) PG8_BAR; }
    PG8_BAR;
#undef PG8_SA
#undef PG8_SB
#undef PG8_STAGE
#undef PG8_LDA
#undef PG8_LDB
#undef PG8_MMA
#undef PG8_WAIT_V
#undef PG8_WAIT_L
#undef PG8_BAR
#undef PG8_SCHED
}
}

constexpr int D = 2048, SEQ = 8192, NB_P = 4, NB_S = 16, L_S = 64, DEPTH = 2;
constexpr int M_P = NB_P * SEQ;
constexpr int M_TOK = M_P + NB_S * L_S;
constexpr int FF = 5632, FF2 = 2 * FF;
constexpr int NH = 32, HD = 64, NG = 4, NS = 128, XBC = 3072, DIN = 2048;
constexpr int GMW = 1024, PLE = 256, INC = 11296;
constexpr int NIN = 11520;
constexpr int LDP = 11520;
constexpr int LDH = 2048, LDF = 5632, LDE = 256;
constexpr int KP_D = 2048, KP_F = 5632, KP_G = 1024, KP_E = 256;
constexpr int PC_Z = 0, PC_XBC = 2048, PC_U = 5120, PC_V = 6144, PC_GA = 7168, PC_GB = 9216, PC_DT = 11264;
constexpr int PC_MRG = 2048;
constexpr int PC_TMP = 0;
constexpr float EPS = 1e-6f;

typedef unsigned short bf16;
typedef pg8::f32x4 f32x4;
typedef pg8::f32x2 f32x2;
typedef pg8::u32x4 u32x4;
typedef pg8::u32x2 u32x2;
#define LAS __attribute__((address_space(3)))

__device__ __forceinline__ float bf2f(bf16 b) { return __uint_as_float(((unsigned)b) << 16); }
__device__ __forceinline__ float bflo(unsigned w) { return __uint_as_float(w << 16); }
__device__ __forceinline__ float bfhi(unsigned w) { return __uint_as_float(w & 0xffff0000u); }
__device__ __forceinline__ bf16 f2bf(float f) { return (bf16)(pg8::cvt_pk_bf16(f, 0.f) & 0xffffu); }
__device__ __forceinline__ unsigned pk2(float lo, float hi) { return pg8::cvt_pk_bf16(lo, hi); }
__device__ __forceinline__ float fast_sigmoid(float x) { return __builtin_amdgcn_rcpf(1.f + __builtin_amdgcn_exp2f(-1.4426950409f * x)); }
__device__ __forceinline__ float fast_silu(float x) { return x * fast_sigmoid(x); }
__device__ __forceinline__ float fast_gelu_tanh(float x) { const float y = 0.7978845608f * (x + 0.044715f * x * x * x); return x * fast_sigmoid(2.f * y); }
__device__ __forceinline__ float softplus_f(float x) { return x > 20.f ? x : log1pf(expf(x)); }

using pg8::Unit;
struct EpiGU {
    static constexpr bool PERM = false;
    bf16* O; int ldc; const float* RS;
    mutable int pmc; mutable float rs[2][4];
    __device__ __forceinline__ void operator()(const f32x4 (&acc)[2][2][4][2], const Unit& u, int wr, int wc, int fr, int fq) const {
        const int row0 = u.pm * 256 + wr * 64 + fr, col0 = u.pn * 128 + wc * 32 + 8 * fq;
        if (pmc != u.pm + 1) { pmc = u.pm + 1;
#pragma unroll
            for (int ai = 0; ai < 2; ++ai)
#pragma unroll
                for (int m = 0; m < 4; ++m) rs[ai][m] = RS[row0 + ai * 128 + m * 16]; }
#pragma unroll
        for (int ai = 0; ai < 2; ++ai)
#pragma unroll
            for (int m = 0; m < 4; ++m) { bf16* rowp = O + (size_t)(row0 + ai * 128 + m * 16) * ldc + col0;
                const float rl = -1.4426950409f * rs[ai][m], r2 = rs[ai][m] * rs[ai][m];
                const f32x4 g0 = acc[ai][0][m][0], u0 = acc[ai][0][m][1], g1 = acc[ai][1][m][0], u1 = acc[ai][1][m][1];
                const f32x4 p0 = g0 * u0 * r2, p1 = g1 * u1 * r2, e0 = g0 * rl, e1 = g1 * rl;
                float o[8];
#pragma unroll
                for (int j = 0; j < 4; ++j) { o[j] = p0[j] * __builtin_amdgcn_rcpf(1.f + __builtin_amdgcn_exp2f(e0[j])); o[4 + j] = p1[j] * __builtin_amdgcn_rcpf(1.f + __builtin_amdgcn_exp2f(e1[j])); }
                u32x4 w; w.x = pk2(o[0], o[1]); w.y = pk2(o[2], o[3]); w.z = pk2(o[4], o[5]); w.w = pk2(o[6], o[7]);
                *(u32x4*)rowp = w; }
    }
};
__device__ __forceinline__ float ssq8(const f32x4 a, const f32x4 b) { return ((a[0] * a[0] + a[1] * a[1]) + (a[2] * a[2] + a[3] * a[3])) + ((b[0] * b[0] + b[1] * b[1]) + (b[2] * b[2] + b[3] * b[3])); }
__device__ __forceinline__ void ssq_emit(float* SSQ, float s, int plane, int row, int fq) { s += __shfl_xor(s, 16); s += __shfl_xor(s, 32); if (fq == 0) SSQ[(size_t)plane * M_TOK + row] = s; }
constexpr int XBP = D;
__device__ __forceinline__ void unpack8(const u32x4 w, f32x4& lo, f32x4& hi) { lo = (f32x4){bflo(w.x), bfhi(w.x), bflo(w.y), bfhi(w.y)}; hi = (f32x4){bflo(w.z), bfhi(w.z), bflo(w.w), bfhi(w.w)}; }
__device__ __forceinline__ u32x4 pack8u(const f32x4 lo, const f32x4 hi) { return (u32x4){pk2(lo[0], lo[1]), pk2(lo[2], lo[3]), pk2(hi[0], hi[1]), pk2(hi[2], hi[3])}; }
template <bool SRC_F32> struct EpiRes {
    static constexpr bool PERM = true;
    const float* rlo; const float* rhi; bf16* XB; int split; float alpha; float* part; float* SSQ;
    __device__ __forceinline__ void operator()(const f32x4 (&acc)[2][2][4][2], const Unit& u, int wr, int wc, int fr, int fq) const {
        const int row0 = u.pm * 256 + wr * 64 + fr, col0 = u.pn * 256 + wc * 32 + 8 * fq;
        if (u.slice >= 0) {
#pragma unroll
            for (int ai = 0; ai < 2; ++ai)
#pragma unroll
                for (int m = 0; m < 4; ++m) { float* pp = part + ((size_t)u.slice * (M_TOK - M_P) + (size_t)(row0 + ai * 128 + m * 16 - split)) * D + col0;
#pragma unroll
                    for (int bj = 0; bj < 2; ++bj) { *(f32x4*)(pp + bj * 128) = alpha * acc[ai][bj][m][0]; *(f32x4*)(pp + bj * 128 + 4) = alpha * acc[ai][bj][m][1]; } }
            return;
        }
#pragma unroll
        for (int ai = 0; ai < 2; ++ai) {
            f32x4 r0[4][2], r1[4][2];
#pragma unroll
            for (int m = 0; m < 4; ++m) { const int r = row0 + ai * 128 + m * 16;
#pragma unroll
                for (int bj = 0; bj < 2; ++bj) {
                    if (SRC_F32) { const float* rp = (r < split ? rlo + (size_t)r * D : rhi + (size_t)(r - split) * D) + col0 + bj * 128; r0[m][bj] = *(const f32x4*)rp; r1[m][bj] = *(const f32x4*)(rp + 4); }
                    else unpack8(*(const u32x4*)(XB + (size_t)r * XBP + col0 + bj * 128), r0[m][bj], r1[m][bj]); } }
#pragma unroll
            for (int m = 0; m < 4; ++m) { bf16* xp = XB + (size_t)(row0 + ai * 128 + m * 16) * XBP + col0; float sq = 0.f;
#pragma unroll
                for (int bj = 0; bj < 2; ++bj) { const f32x4 x0 = r0[m][bj] + alpha * acc[ai][bj][m][0], x1 = r1[m][bj] + alpha * acc[ai][bj][m][1]; sq += ssq8(x0, x1); *(u32x4*)(xp + bj * 128) = pack8u(x0, x1); }
                ssq_emit(SSQ, sq, u.pn * 4 + wc, row0 + ai * 128 + m * 16, fq); }
            asm volatile("" ::: "memory"); }
    }
};
struct EpiInProj {
    static constexpr bool PERM = true;
    bf16* P; float* DT; const float* dt_bias; const float* RS;
    mutable int pmc; mutable float rsc[2][4];
    __device__ __forceinline__ void operator()(const f32x4 (&acc)[2][2][4][2], const Unit& u, int wr, int wc, int fr, int fq) const {
        const int row0 = u.pm * 256 + wr * 64 + fr, col0 = u.pn * 256 + wc * 32 + 8 * fq;
        const int mode = u.pn < 8 ? 0 : u.pn < 20 ? 1 : u.pn < 28 ? 2 : u.pn < 44 ? 3 : 4;
        if (pmc != u.pm + 1) { pmc = u.pm + 1;
#pragma unroll
            for (int ai = 0; ai < 2; ++ai)
#pragma unroll
                for (int m = 0; m < 4; ++m) rsc[ai][m] = RS[row0 + ai * 128 + m * 16]; }
        if (mode == 4) {
            if (wc == 0) {
                const f32x4 b0 = *(const f32x4*)(dt_bias + 8 * fq), b1 = *(const f32x4*)(dt_bias + 8 * fq + 4);
#pragma unroll
                for (int ai = 0; ai < 2; ++ai)
#pragma unroll
                    for (int m = 0; m < 4; ++m) { float* dp = DT + (size_t)(row0 + ai * 128 + m * 16) * 32 + 8 * fq; const float rs = rsc[ai][m];
                        f32x4 v0 = acc[ai][0][m][0] * rs + b0, v1 = acc[ai][0][m][1] * rs + b1;
#pragma unroll
                        for (int j = 0; j < 4; ++j) { v0[j] = softplus_f(v0[j]); v1[j] = softplus_f(v1[j]); }
                        *(f32x4*)dp = v0; *(f32x4*)(dp + 4) = v1; }
            }
            return;
        }
#pragma unroll
        for (int ai = 0; ai < 2; ++ai)
#pragma unroll
            for (int m = 0; m < 4; ++m) { bf16* rowp = P + (size_t)(row0 + ai * 128 + m * 16) * LDP + col0; const float rs = rsc[ai][m];
#pragma unroll
                for (int bj = 0; bj < 2; ++bj) { f32x4 v0 = acc[ai][bj][m][0] * rs, v1 = acc[ai][bj][m][1] * rs;
                    if (mode == 0) {
#pragma unroll
                        for (int j = 0; j < 4; ++j) { v0[j] = fast_silu(v0[j]); v1[j] = fast_silu(v1[j]); } }
                    else if (mode == 2) {
#pragma unroll
                        for (int j = 0; j < 4; ++j) { v0[j] = fast_gelu_tanh(v0[j]); v1[j] = fast_gelu_tanh(v1[j]); } }
                    else if (mode == 3) {
#pragma unroll
                        for (int j = 0; j < 4; ++j) { v0[j] = fast_sigmoid(v0[j]); v1[j] = fast_sigmoid(v1[j]); } }
                    u32x4 w; w.x = pk2(v0[0], v0[1]); w.y = pk2(v0[2], v0[3]); w.z = pk2(v1[0], v1[1]); w.w = pk2(v1[2], v1[3]);
                    *(u32x4*)(rowp + bj * 128) = w; } }
    }
};
template <int MODE> struct EpiMerge {
    static constexpr bool PERM = true;
    const bf16* Gt; bf16* T;
    __device__ __forceinline__ void operator()(const f32x4 (&acc)[2][2][4][2], const Unit& u, int wr, int wc, int fr, int fq) const {
        const int row0 = u.pm * 256 + wr * 64 + fr, col0 = u.pn * 256 + wc * 32 + 8 * fq;
#pragma unroll
        for (int ai = 0; ai < 2; ++ai) {
            u32x4 gg[4][2], tt[4][2];
#pragma unroll
            for (int m = 0; m < 4; ++m) { const size_t ro = (size_t)(row0 + ai * 128 + m * 16) * LDP + col0;
#pragma unroll
                for (int bj = 0; bj < 2; ++bj) { gg[m][bj] = *(const u32x4*)(Gt + ro + bj * 128); if (MODE == 1) tt[m][bj] = *(const u32x4*)(T + ro + bj * 128); } }
#pragma unroll
            for (int m = 0; m < 4; ++m) { const size_t ro = (size_t)(row0 + ai * 128 + m * 16) * LDP + col0;
#pragma unroll
                for (int bj = 0; bj < 2; ++bj) { const u32x4 g4 = gg[m][bj];
                    f32x4 v0 = acc[ai][bj][m][0], v1 = acc[ai][bj][m][1];
                    v0[0] *= bflo(g4.x); v0[1] *= bfhi(g4.x); v0[2] *= bflo(g4.y); v0[3] *= bfhi(g4.y); v1[0] *= bflo(g4.z); v1[1] *= bfhi(g4.z); v1[2] *= bflo(g4.w); v1[3] *= bfhi(g4.w);
                    if (MODE == 1) { const u32x4 t4 = tt[m][bj];
                        v0[0] += bflo(t4.x); v0[1] += bfhi(t4.x); v0[2] += bflo(t4.y); v0[3] += bfhi(t4.y); v1[0] += bflo(t4.z); v1[1] += bfhi(t4.z); v1[2] += bflo(t4.w); v1[3] += bfhi(t4.w); }
                    u32x4 w; w.x = pk2(v0[0], v0[1]); w.y = pk2(v0[2], v0[3]); w.z = pk2(v1[0], v1[1]); w.w = pk2(v1[2], v1[3]);
                    *(u32x4*)(T + ro + bj * 128) = w; } }
            asm volatile("" ::: "memory"); }
    }
};
struct EpiPg {
    static constexpr bool PERM = true;
    bf16* T; const float* RS;
    __device__ __forceinline__ void operator()(const f32x4 (&acc)[2][2][4][2], const Unit& u, int wr, int wc, int fr, int fq) const {
        const int row0 = u.pm * 256 + wr * 64 + fr, col0 = u.pn * 256 + wc * 32 + 8 * fq;
#pragma unroll
        for (int ai = 0; ai < 2; ++ai)
#pragma unroll
            for (int m = 0; m < 4; ++m) { bf16* rowp = T + (size_t)(row0 + ai * 128 + m * 16) * LDP + col0; const float rs = RS[row0 + ai * 128 + m * 16];
#pragma unroll
                for (int bj = 0; bj < 2; ++bj) { f32x4 v0 = acc[ai][bj][m][0] * rs, v1 = acc[ai][bj][m][1] * rs;
#pragma unroll
                    for (int j = 0; j < 4; ++j) { v0[j] = fast_sigmoid(v0[j]); v1[j] = fast_sigmoid(v1[j]); }
                    *(u32x4*)(rowp + bj * 128) = pack8u(v0, v1); } }
    }
};
struct EpiPle {
    static constexpr bool PERM = true;
    const bf16* T; const bf16* XI; bf16* XB; float* SSQ;
    __device__ __forceinline__ void operator()(const f32x4 (&acc)[2][2][4][2], const Unit& u, int wr, int wc, int fr, int fq) const {
        const int row0 = u.pm * 256 + wr * 64 + fr, col0 = u.pn * 256 + wc * 32 + 8 * fq;
#pragma unroll
        for (int ai = 0; ai < 2; ++ai) {
            u32x4 tt[4][2], xx[4][2];
#pragma unroll
            for (int m = 0; m < 4; ++m) { const int r = row0 + ai * 128 + m * 16;
#pragma unroll
                for (int bj = 0; bj < 2; ++bj) { tt[m][bj] = *(const u32x4*)(T + (size_t)r * LDP + col0 + bj * 128); xx[m][bj] = *(const u32x4*)(XI + (size_t)r * XBP + col0 + bj * 128); } }
#pragma unroll
            for (int m = 0; m < 4; ++m) { bf16* xp = XB + (size_t)(row0 + ai * 128 + m * 16) * XBP + col0; float sq = 0.f;
#pragma unroll
                for (int bj = 0; bj < 2; ++bj) { f32x4 t0, t1, x0, x1; unpack8(tt[m][bj], t0, t1); unpack8(xx[m][bj], x0, x1);
                    x0 = x0 + acc[ai][bj][m][0] * t0; x1 = x1 + acc[ai][bj][m][1] * t1; sq += ssq8(x0, x1); *(u32x4*)(xp + bj * 128) = pack8u(x0, x1); }
                ssq_emit(SSQ, sq, u.pn * 4 + wc, row0 + ai * 128 + m * 16, fq); }
            asm volatile("" ::: "memory"); }
    }
};

#define XB_TMO      128
#define XB_XCNT(j)  (256  + 64 * (j))
#define XB_XSUB(j)  (1280 + 64 * (j))
#define XB_XGEN(j)  (2304 + 64 * (j))
#define XB_TOP      3328
#define XB_TOPGEN   3392
#define XCD_BAR_WORDS 3456
#define XB_SPIN_CAP (1u << 18)

__device__ __forceinline__ unsigned xb_ld(unsigned* p)              { return __hip_atomic_load(p, __ATOMIC_RELAXED, __HIP_MEMORY_SCOPE_AGENT); }
__device__ __forceinline__ unsigned xb_add(unsigned* p, unsigned v) { return __hip_atomic_fetch_add(p, v, __ATOMIC_RELAXED, __HIP_MEMORY_SCOPE_AGENT); }
__device__ __forceinline__ unsigned xb_xcc_id() { return (unsigned)__builtin_amdgcn_s_getreg((3 << 11) | 20) & 0xFu; }
#define XB_SPIN(cond, bar) do { unsigned _sp = 0; while (cond) { __builtin_amdgcn_s_sleep(1); \
    if ((++_sp & 255u) == 0u) { if (xb_ld(&(bar)[XB_TMO])) break; if (_sp > XB_SPIN_CAP) { atomicAdd(&(bar)[XB_TMO], 1u); break; } } } } while (0)

__device__ __forceinline__ unsigned xb_lane() { return __builtin_amdgcn_mbcnt_hi(~0u, __builtin_amdgcn_mbcnt_lo(~0u, 0u)); }
struct XcdBarrier {
    unsigned* bar; unsigned x; unsigned w0;
    volatile LAS unsigned* st;
};

__device__ __forceinline__ XcdBarrier xcd_barrier_post(unsigned* bar, volatile LAS unsigned* st, unsigned w0) {
    XcdBarrier b; b.bar = bar; b.x = xb_xcc_id(); b.st = st; b.w0 = w0;
    if (w0 == 0u && xb_lane() == 0u) (void)xb_add(&bar[XB_XCNT(b.x)], 1u);
    return b;
}
__device__ __forceinline__ void xcd_barrier_complete(unsigned* bar, unsigned x, unsigned& nloc, unsigned& nx) {
    const unsigned G = gridDim.x * gridDim.y * gridDim.z;
    unsigned sum, cnt, mine, sp = 0u;
    for (;;) {
        sum = 0u; cnt = 0u; mine = 0u;
#pragma unroll
        for (unsigned j = 0; j < 16; ++j) { const unsigned c = xb_ld(&bar[XB_XCNT(j)]); sum += c; cnt += (c > 0u) ? 1u : 0u; mine = (j == x) ? c : mine; }
        if (sum == G) break;
        __builtin_amdgcn_s_sleep(1);
        if ((++sp & 255u) == 0u) { if (xb_ld(&bar[XB_TMO])) break; if (sp > XB_SPIN_CAP) { atomicAdd(&bar[XB_TMO], 1u); break; } }
    }
    nloc = mine > 0u ? mine : 1u; nx = cnt > 0u ? cnt : 1u;
}

__device__ __forceinline__ void xcd_barrier(const XcdBarrier& b) {
    asm volatile("s_waitcnt vmcnt(0)" ::: "memory");
    __syncthreads();
    if (b.w0 == 0u && xb_lane() == 0u) {
        unsigned* bar = b.bar;
        __builtin_amdgcn_s_waitcnt(0);
        unsigned nloc = b.st[0], nx = b.st[1];
        if (nloc == 0u) { xcd_barrier_complete(bar, b.x, nloc, nx); b.st[0] = nloc; b.st[1] = nx; }
        const unsigned old = xb_add(&bar[XB_XSUB(b.x)], 1u);
        const unsigned gen = old / nloc;
        if (old + 1u == (gen + 1u) * nloc) {
            __builtin_amdgcn_fence(__ATOMIC_RELEASE, "agent");
            asm volatile("s_waitcnt vmcnt(0)" ::: "memory");
            const unsigned og = xb_add(&bar[XB_TOP], 1u);
            const unsigned tg = og / nx;
            if (og + 1u == (tg + 1u) * nx) xb_add(&bar[XB_TOPGEN], 1u);
            else XB_SPIN(xb_ld(&bar[XB_TOPGEN]) == tg, bar);
            __builtin_amdgcn_fence(__ATOMIC_ACQUIRE, "agent");
            xb_add(&bar[XB_XGEN(b.x)], 1u);
            asm volatile("s_waitcnt vmcnt(0)" ::: "memory");
        } else {
            XB_SPIN(xb_ld(&bar[XB_XGEN(b.x)]) == gen, bar);
            __builtin_amdgcn_fence(__ATOMIC_ACQUIRE, "agent");
            asm volatile("s_waitcnt vmcnt(0)" ::: "memory");
        }
    }
    __syncthreads();
}

constexpr size_t MiB = 1u << 20;
constexpr size_t WS_CTL = 0, CTL_ZERO_BYTES = 1 * MiB;
constexpr int CW_BAR = 4096;
constexpr size_t WO_GU1 = 0;
constexpr size_t WO_D1  = WO_GU1 + (size_t)FF2 * KP_D;
constexpr size_t WO_IN  = WO_D1 + (size_t)D * KP_F;
constexpr size_t WO_A   = WO_IN + (size_t)NIN * KP_D;
constexpr size_t WO_B   = WO_A + (size_t)D * KP_D;
constexpr size_t WO_O   = WO_B + (size_t)D * KP_G;
constexpr size_t WO_GU2 = WO_O + (size_t)D * KP_D;
constexpr size_t WO_D2  = WO_GU2 + (size_t)FF2 * KP_D;
constexpr size_t WO_PG  = WO_D2 + (size_t)D * KP_F;
constexpr size_t WO_PP  = WO_PG + (size_t)D * KP_D;
constexpr size_t WO_WS  = WO_PP + (size_t)D * KP_E;
constexpr size_t WO_END = WO_WS + (size_t)8 * 128 * 128;
constexpr size_t WS_W   = 1 * MiB;
constexpr size_t WS_HB  = WS_W + ((WO_END * 2 + 255) / 256) * 256;
constexpr size_t WS_PB  = WS_HB + (size_t)M_TOK * LDH * 2;
constexpr size_t WS_PE  = WS_PB + (size_t)M_TOK * LDP * 2;
constexpr size_t WS_DT  = WS_PE + (size_t)M_TOK * LDE * 2;
constexpr size_t WS_SSQ = WS_DT;
constexpr size_t WS_PART = WS_DT + (size_t)M_TOK * NH * 4;
constexpr size_t WS_RS  = WS_PART + (size_t)8 * (M_TOK - M_P) * D * 4;
constexpr size_t WS_SQ  = WS_RS + (((size_t)M_TOK * 4 + 255) / 256) * 256;
constexpr size_t WS_END = WS_SQ + (size_t)32 * M_TOK * 4;

constexpr int RING_BYTES = 131072;
constexpr int LDS_BYTES = 147456;
constexpr int LDSCTL_OFF = LDS_BYTES - 256;
constexpr int NWAVES = 8, NTHREADS = 512;

constexpr size_t OUT_Y = 0;
constexpr size_t OUT_SSM_P = (size_t)M_TOK * D;
constexpr size_t OUT_CONV_P = OUT_SSM_P + (size_t)DEPTH * NB_P * NH * HD * NS;
constexpr size_t OUT_SSM_S = OUT_CONV_P + (size_t)DEPTH * NB_P * 3 * XBC;
constexpr size_t OUT_CONV_S = OUT_SSM_S + (size_t)DEPTH * NB_S * NH * HD * NS;
constexpr size_t OUT_GV = OUT_CONV_S + (size_t)DEPTH * NB_S * 3 * XBC;
constexpr size_t OUT_END = OUT_GV + (size_t)DEPTH * NB_S * L_S * GMW;

enum { I_XP = 0, I_XS, I_PP, I_PS, I_SCONV, I_SSSM, I_F1N, I_F1G, I_F1U, I_F1D, I_MIXN, I_WIN, I_CONVW, I_CONVB, I_DTB, I_ALOG, I_DSKIP, I_SSDN,
       I_GLNG, I_GLNB, I_GWS, I_GBS, I_WBA, I_WBB, I_WOUT, I_F2N, I_F2G, I_F2U, I_F2D, I_PLEN, I_PLEG, I_PLEP, I_FINN, N_IN };

struct Args { const float* in[N_IN]; float* out; unsigned char* ws; int ph_lo, ph_hi; };
#define CAS __attribute__((address_space(4)))
struct KP { const CAS char* p;
    __device__ __forceinline__ const float* in(int i) const { return *(const float* const CAS*)(p + 8 * i); }
    __device__ __forceinline__ float* out() const { return *(float* const CAS*)(p + 8 * N_IN); }
    __device__ __forceinline__ unsigned char* ws() const { return *(unsigned char* const CAS*)(p + 8 * N_IN + 8); }
    __device__ __forceinline__ int ph_lo() const { return *(const int CAS*)(p + 8 * N_IN + 16); }
    __device__ __forceinline__ int ph_hi() const { return *(const int CAS*)(p + 8 * N_IN + 20); } };
__device__ __forceinline__ KP kp_get() { KP k; k.p = (const CAS char*)__builtin_amdgcn_kernarg_segment_ptr(); asm volatile("" : "+s"(k.p)); return k; }
__device__ __forceinline__ int lane_id() { return (int)__builtin_amdgcn_mbcnt_hi(~0u, __builtin_amdgcn_mbcnt_lo(~0u, 0u)); }

__device__ __forceinline__ float wave_sum(float v) {
#pragma unroll
    for (int o = 1; o < 64; o <<= 1) v += __shfl_xor(v, o);
    return v;
}

struct RowId { __device__ __forceinline__ int operator()(int n) const { return n; } };
struct RowGU { int up; __device__ __forceinline__ int operator()(int n) const { const int pn = n >> 7, o = n & 127; return 256 * pn + 128 * ((o >> 2) & 1) + 32 * (o >> 5) + (up ? 16 : 0) + 4 * ((o >> 3) & 3) + (o & 3); } };
struct RowIn { __device__ __forceinline__ int operator()(int n) const { return n < 5120 ? n : (n < 5152 ? n - 5120 + PC_DT : n - 32); } };
template <class RM>
__device__ __forceinline__ void transpose_item(const float* W, int K, int N, bf16* WT, int ldt, RM rm, LAS float* scr, int item, int lane, const float* kg = nullptr) {
    const int nblk = N / 32, kb = item / nblk, nb = item % nblk, k0 = 64 * kb, n0 = 32 * nb;
#pragma unroll
    for (int i = 0; i < 32; ++i) { const int kk = 2 * i + (lane >> 5); scr[kk * 33 + (lane & 31)] = W[(size_t)(k0 + kk) * N + n0 + (lane & 31)]; }
    asm volatile("s_waitcnt lgkmcnt(0)" ::: "memory");
    const int c = lane & 7;
    f32x4 ga = {1.f, 1.f, 1.f, 1.f}, gb = ga;
    if (kg) { ga = *(const f32x4*)(kg + k0 + 8 * c); gb = *(const f32x4*)(kg + k0 + 8 * c + 4); }
#pragma unroll
    for (int j = 0; j < 4; ++j) { const int n = (lane >> 3) + 8 * j; const LAS float* s = scr + (8 * c) * 33 + n;
        u32x4 o; o.x = pk2(s[0 * 33] * ga[0], s[1 * 33] * ga[1]); o.y = pk2(s[2 * 33] * ga[2], s[3 * 33] * ga[3]); o.z = pk2(s[4 * 33] * gb[0], s[5 * 33] * gb[1]); o.w = pk2(s[6 * 33] * gb[2], s[7 * 33] * gb[3]);
        *(u32x4*)(WT + (size_t)rm(n0 + n) * ldt + k0 + 8 * c) = o; }
    asm volatile("s_waitcnt lgkmcnt(0)" ::: "memory");
}

template <int GRP>
__device__ __forceinline__ void convert_group(const KP a, int layer, bf16* Wb, LAS unsigned char* lds, int w, int nw, int wave, int lane) {
    LAS float* scr = (LAS float*)(lds + wave * 16384);
    constexpr int T_GU = (D / 64) * (FF / 32), T_DN = (FF / 64) * (D / 32), T_IN = (D / 64) * (INC / 32), T_SQ = (D / 64) * (D / 32), T_BB = (GMW / 64) * (D / 32), T_PP = (PLE / 64) * (D / 32);
    constexpr int NITEMS = GRP == 0 ? 2 * T_GU : GRP == 1 ? T_DN : GRP == 2 ? 2 * T_SQ + T_BB : GRP == 3 ? T_SQ + T_PP : GRP == 4 ? 2 * T_GU : GRP == 5 ? T_DN : T_IN;
    const size_t lff = (size_t)layer * D * FF, lsq = (size_t)layer * D * D;
    for (int it = w; it < NITEMS; it += nw) {
        int r = it;
        if constexpr (GRP == 0) {
            if (r < T_GU) { transpose_item(a.in(I_F1G) + lff, D, FF, Wb + WO_GU1, KP_D, RowGU{0}, scr, r, lane, a.in(I_F1N) + layer * D); continue; } r -= T_GU;
            transpose_item(a.in(I_F1U) + lff, D, FF, Wb + WO_GU1, KP_D, RowGU{1}, scr, r, lane, a.in(I_F1N) + layer * D);
        } else if constexpr (GRP == 1) {
            transpose_item(a.in(I_F1D) + lff, FF, D, Wb + WO_D1, KP_F, RowId{}, scr, r, lane);
        } else if constexpr (GRP == 2) {
            if (r < T_SQ) { transpose_item(a.in(I_WBA) + lsq, DIN, D, Wb + WO_A, KP_D, RowId{}, scr, r, lane); continue; } r -= T_SQ;
            if (r < T_SQ) { transpose_item(a.in(I_WOUT) + lsq, D, D, Wb + WO_O, KP_D, RowId{}, scr, r, lane); continue; } r -= T_SQ;
            transpose_item(a.in(I_WBB) + (size_t)layer * GMW * D, GMW, D, Wb + WO_B, KP_G, RowId{}, scr, r, lane);
        } else if constexpr (GRP == 3) {
            if (r < T_SQ) { transpose_item(a.in(I_PLEG) + lsq, D, D, Wb + WO_PG, KP_D, RowId{}, scr, r, lane, a.in(I_PLEN) + layer * D); continue; } r -= T_SQ;
            transpose_item(a.in(I_PLEP) + (size_t)layer * PLE * D, PLE, D, Wb + WO_PP, KP_E, RowId{}, scr, r, lane);
        } else if constexpr (GRP == 4) {
            if (r < T_GU) { transpose_item(a.in(I_F2G) + lff, D, FF, Wb + WO_GU2, KP_D, RowGU{0}, scr, r, lane, a.in(I_F2N) + layer * D); continue; } r -= T_GU;
            transpose_item(a.in(I_F2U) + lff, D, FF, Wb + WO_GU2, KP_D, RowGU{1}, scr, r, lane, a.in(I_F2N) + layer * D);
        } else if constexpr (GRP == 5) {
            transpose_item(a.in(I_F2D) + lff, FF, D, Wb + WO_D2, KP_F, RowId{}, scr, r, lane);
        } else {
            transpose_item(a.in(I_WIN) + (size_t)layer * D * INC, D, INC, Wb + WO_IN, KP_D, RowIn{}, scr, r, lane, a.in(I_MIXN) + layer * D);
        }
    }
}
__device__ __forceinline__ void convert_misc(const KP a, int layer, bf16* Wb, bf16* PE, int gtid, int NGT) {
    { u32x4* z = (u32x4*)(Wb + WO_IN + (size_t)INC * KP_D); const int nz = (NIN - INC) * KP_D / 8; for (int i = gtid; i < nz; i += NGT) z[i] = (u32x4){0u, 0u, 0u, 0u}; }
    { const float* wsrc = a.in(I_GWS) + (size_t)layer * 8 * 128 * 128; bf16* wd = Wb + WO_WS;
      for (int i = gtid; i < 8 * 128 * 128 / 8; i += NGT) { const int e0 = i * 8, t = (e0 >> 7) & 127, s0 = e0 & 127; const f32x4 v0 = *(const f32x4*)(wsrc + e0), v1 = *(const f32x4*)(wsrc + e0 + 4);
          float f[8] = {v0[0], v0[1], v0[2], v0[3], v1[0], v1[1], v1[2], v1[3]};
#pragma unroll
          for (int j = 0; j < 8; ++j) if (s0 + j > t) f[j] = 0.f;
          u32x4 o; o.x = pk2(f[0], f[1]); o.y = pk2(f[2], f[3]); o.z = pk2(f[4], f[5]); o.w = pk2(f[6], f[7]); *(u32x4*)(wd + e0) = o; } }
    { const float* pp = a.in(I_PP) + (size_t)layer * M_P * PLE; const float* ps = a.in(I_PS) + (size_t)layer * (M_TOK - M_P) * PLE; const int n8 = M_TOK * PLE / 8, np8 = M_P * PLE / 8;
      for (int i = gtid; i < n8; i += NGT) { const float* s = i < np8 ? pp + (size_t)i * 8 : ps + (size_t)(i - np8) * 8; const f32x4 v0 = *(const f32x4*)s, v1 = *(const f32x4*)(s + 4);
          u32x4 o; o.x = pk2(v0[0], v0[1]); o.y = pk2(v0[2], v0[3]); o.z = pk2(v1[0], v1[1]); o.w = pk2(v1[2], v1[3]); *(u32x4*)(PE + (size_t)(i >> 5) * LDE + (i & 31) * 8) = o; } }
}
#define TAIL_CONVERT(NUNITS, ...) do { const int thr_ = (NUNITS) % G; if (bid >= thr_) { asm volatile("s_waitcnt vmcnt(0) lgkmcnt(0)" ::: "memory"); __syncthreads(); const int tw_ = (bid - thr_) * NWAVES + wave, tn_ = (G - thr_) * NWAVES; __VA_ARGS__ } } while (0)

__device__ __forceinline__ void phase_first(const float* rlo, const float* rhi, bf16* XB, float* RS, int gw, int NGW, int lane) {
    for (int r = gw; r < M_TOK; r += NGW) {
        f32x4 v0[4], v1[4];
        const float* xr = (r < M_P ? rlo + (size_t)r * D : rhi + (size_t)(r - M_P) * D) + 8 * lane;
#pragma unroll
        for (int j = 0; j < 4; ++j) { v0[j] = *(const f32x4*)(xr + 512 * j); v1[j] = *(const f32x4*)(xr + 512 * j + 4); }
        float ss = 0.f;
#pragma unroll
        for (int j = 0; j < 4; ++j) ss += ssq8(v0[j], v1[j]);
        bf16* xo = XB + (size_t)r * XBP + 8 * lane;
#pragma unroll
        for (int j = 0; j < 4; ++j) *(u32x4*)(xo + 512 * j) = pack8u(v0[j], v1[j]);
        ss = wave_sum(ss);
        if (lane == 0) RS[r] = rsqrtf(ss * (1.f / D) + EPS);
    }
}
template <bool FOLD>
__device__ __forceinline__ void phase_rstd(const float* SSQ, float* RS, const float* part, bf16* XB, int gw, int NGW, int lane, int gtid, int NGT) {
    constexpr int NRED = FOLD ? M_P : M_TOK;
    for (int t = gtid; t < NRED * 4; t += NGT) { const int r = t >> 2, q = t & 3; float s = 0.f;
#pragma unroll
        for (int j = 0; j < 8; ++j) s += SSQ[(size_t)(q * 8 + j) * M_TOK + r];
        s += __shfl_xor(s, 1); s += __shfl_xor(s, 2);
        if (q == 0) RS[r] = rsqrtf(s * (1.f / D) + EPS); }
    if (FOLD) for (int r = M_P + (NGW - 1 - gw); r < M_TOK; r += NGW) {
        f32x4 v0[4], v1[4];
        bf16* xo = XB + (size_t)r * XBP + 8 * lane;
#pragma unroll
        for (int j = 0; j < 4; ++j) unpack8(*(const u32x4*)(xo + 512 * j), v0[j], v1[j]);
#pragma unroll 1
        for (int s = 0; s < 8; ++s) { const float* pr = part + ((size_t)s * (M_TOK - M_P) + (size_t)(r - M_P)) * D + 8 * lane;
#pragma unroll
            for (int j = 0; j < 4; ++j) { v0[j] = v0[j] + *(const f32x4*)(pr + 512 * j); v1[j] = v1[j] + *(const f32x4*)(pr + 512 * j + 4); } }
        float ss = 0.f;
#pragma unroll
        for (int j = 0; j < 4; ++j) { ss += ssq8(v0[j], v1[j]); *(u32x4*)(xo + 512 * j) = pack8u(v0[j], v1[j]); }
        ss = wave_sum(ss);
        if (lane == 0) RS[r] = rsqrtf(ss * (1.f / D) + EPS);
    }
}
__device__ __forceinline__ void phase_final_norm(const bf16* XB, float* Y, const float* gain, int gw, int NGW, int lane) {
    for (int r = gw; r < M_TOK; r += NGW) {
        const bf16* xr = XB + (size_t)r * XBP + 8 * lane;
        f32x4 v0[4], v1[4]; float ss = 0.f;
#pragma unroll
        for (int j = 0; j < 4; ++j) unpack8(*(const u32x4*)(xr + 512 * j), v0[j], v1[j]);
#pragma unroll
        for (int j = 0; j < 4; ++j) ss += ssq8(v0[j], v1[j]);
        const float rstd = rsqrtf(wave_sum(ss) * (1.f / D) + EPS);
        float* yo = Y + (size_t)r * D + 8 * lane;
#pragma unroll
        for (int j = 0; j < 4; ++j) { const f32x4 g0 = *(const f32x4*)(gain + 8 * lane + 512 * j), g1 = *(const f32x4*)(gain + 8 * lane + 512 * j + 4); __builtin_nontemporal_store(v0[j] * rstd * g0, (f32x4*)(yo + 512 * j)); __builtin_nontemporal_store(v1[j] * rstd * g1, (f32x4*)(yo + 512 * j + 4)); }
    }
}

__device__ __forceinline__ size_t seq_row0(int sq) { return sq < NB_P ? (size_t)sq * SEQ : (size_t)M_P + (size_t)(sq - NB_P) * L_S; }


typedef pg8::bf16x8 bf16x8;
constexpr int SC = 8, NSC = SEQ / (64 * SC), NSC1 = NSC - 1;
constexpr int XS_LD = 72, TM_LD = 136;
constexpr int SL_XST = 0;
constexpr int SL_BMT = SL_XST + 512 * XS_LD * 2;
constexpr int SL_BM  = SL_BMT + 128 * XS_LD * 2;
constexpr int SL_CM  = SL_BM + 64 * TM_LD * 2;
constexpr int SL_CUM = SL_CM + 64 * TM_LD * 2;
constexpr int SL_DTV = SL_CUM + 2048;
constexpr int SL_WV  = SL_DTV + 2048;
constexpr int SL_SSQ = SL_WV + 2048;
constexpr int SL_GN  = SL_SSQ + 2048;
constexpr int SL_END = SL_GN + 2048;
static_assert(SL_END <= LDSCTL_OFF, "SSD LDS map");
constexpr size_t ST_ELEMS = 128 * 64;
constexpr size_t WSO_ST = 0, WSO_DTOT = (size_t)NB_P * NSC1 * NH * ST_ELEMS * 4;
static_assert(WSO_DTOT + (size_t)NB_P * NSC1 * NH * 4 <= (size_t)128 * MiB, "SSD states fit the first 128 MiB of the y region of d_out");
constexpr size_t WSO_XT = (size_t)128 * MiB;
static_assert(WSO_XT + (size_t)M_TOK * XBP * 2 <= (size_t)M_TOK * D * 4, "second stream buffer fits the y region");

__device__ __forceinline__ bf16x8 ld_pair8(const LAS unsigned char* p0, const LAS unsigned char* p1) {
    const u32x2 a = *(const LAS u32x2*)p0, b = *(const LAS u32x2*)p1; const u32x4 w = {a.x, a.y, b.x, b.y}; return __builtin_bit_cast(bf16x8, w); }
__device__ __forceinline__ bf16x8 pack8(const f32x4 lo, const f32x4 hi) { const u32x4 w = {pk2(lo[0], lo[1]), pk2(lo[2], lo[3]), pk2(hi[0], hi[1]), pk2(hi[2], hi[3])}; return __builtin_bit_cast(bf16x8, w); }
#define MFMA16(a, b, c) __builtin_amdgcn_mfma_f32_16x16x32_bf16((a), (b), (c), 0, 0, 0)
__device__ __forceinline__ void lds_barrier() { asm volatile("s_waitcnt lgkmcnt(0)" ::: "memory"); __builtin_amdgcn_s_barrier(); asm volatile("" ::: "memory"); }

__device__ __forceinline__ int xperm(int n2) { const int c = n2 & 63; return (n2 & ~63) | ((c >> 5) << 5) | (((c >> 2) & 1) << 4) | (((c >> 3) & 3) << 2) | (c & 3); }
__device__ __forceinline__ int xphys(int pb, int i) { return 32 * (pb >> 1) + 8 * (i >> 2) + 4 * (pb & 1) + (i & 3); }
template <bool FULL>
__device__ __forceinline__ void ssd_stage(const KP a, int layer, const bf16* rowp, int hist, const float* cst, float* tail_out, int g, LAS unsigned char* lds, int tid) {
    constexpr int NPAIR = FULL ? 384 : 320, NT = (NPAIR * 4 + NTHREADS - 1) / NTHREADS;
    static_assert(NPAIR % 64 == 0, "a wave's 64 tasks share the token block and the channel kind");
    const int wv = __builtin_amdgcn_readfirstlane(tid >> 6), ln = tid & 63;
    const float* cw = a.in(I_CONVW) + (size_t)layer * 4 * XBC; const float* cb = a.in(I_CONVB) + (size_t)layer * XBC;
    unsigned rr[NT][19];
#pragma unroll
    for (int i = 0; i < NT; ++i) {
        const int tw = wv * 64 + i * NTHREADS;
        const int tq = tw / NPAIR, pw = tw - tq * NPAIR, s0 = 16 * tq;
        const int chw = pw < 256 ? g * 512 + 2 * pw : (pw < 320 ? DIN + g * 128 + 2 * (pw - 256) : DIN + 512 + g * 128 + 2 * (pw - 320));
        if (tw < NPAIR * 4) {
            const bf16* pb = rowp + PC_XBC + chw + 2 * ln;
#pragma unroll
            for (int j = 0; j < 19; ++j) {
                const int s = s0 + j - 3;
                if (j >= 3 || s >= 0 || hist == 1) rr[i][j] = *(const unsigned*)(pb + (long)s * LDP);
                else if (hist == 2) { const f32x2 v = *(const f32x2*)(cst + (size_t)(s + 3) * XBC + chw + 2 * ln); rr[i][j] = pk2(v[0], v[1]); }
                else rr[i][j] = 0u;
            }
        } else {
#pragma unroll
            for (int j = 0; j < 19; ++j) rr[i][j] = 0u;
        }
    }
#pragma unroll
    for (int i = 0; i < NT; ++i) {
        const int tw = wv * 64 + i * NTHREADS; if (tw >= NPAIR * 4) break;
        const int tq = tw / NPAIR, pw = tw - tq * NPAIR, s0 = 16 * tq;
        const int kind = pw < 256 ? 0 : (pw < 320 ? 1 : 2);
        const int n2 = 2 * (pw - (kind == 0 ? 0 : (kind == 1 ? 256 : 320))) + 2 * ln;
        const int ch = (kind == 0 ? g * 512 : (kind == 1 ? DIN + g * 128 : DIN + 512 + g * 128)) + n2;
        float w0[4], w1[4];
#pragma unroll
        for (int k = 0; k < 4; ++k) { const f32x2 wv2 = *(const f32x2*)(cw + (size_t)k * XBC + ch); w0[k] = wv2[0]; w1[k] = wv2[1]; }
        const f32x2 bv = *(const f32x2*)(cb + ch);
        if (tail_out && tq == 3) {
#pragma unroll
            for (int k = 0; k < 3; ++k) *(f32x2*)(tail_out + (size_t)k * XBC + ch) = (f32x2){bflo(rr[i][16 + k]), bfhi(rr[i][16 + k])}; }
        unsigned q0[8], q1[8];
        LAS unsigned char* dtm = lds + (kind == 1 ? SL_BM : SL_CM) + s0 * (TM_LD * 2) + n2 * 2;
#pragma unroll
        for (int e = 0; e < 8; ++e) { float oa[2], ob[2];
#pragma unroll
            for (int u = 0; u < 2; ++u) { const int j = 2 * e + u;
                const float c0 = bv[0] + w0[0] * bflo(rr[i][j]) + w0[1] * bflo(rr[i][j + 1]) + w0[2] * bflo(rr[i][j + 2]) + w0[3] * bflo(rr[i][j + 3]), c1 = bv[1] + w1[0] * bfhi(rr[i][j]) + w1[1] * bfhi(rr[i][j + 1]) + w1[2] * bfhi(rr[i][j + 2]) + w1[3] * bfhi(rr[i][j + 3]);
                oa[u] = fast_silu(c0); ob[u] = fast_silu(c1);
                if (FULL && kind >= 1) *(LAS unsigned*)(dtm + j * (TM_LD * 2)) = pk2(oa[u], ob[u]); }
            q0[e] = pk2(oa[0], oa[1]); q1[e] = pk2(ob[0], ob[1]); }
        if (kind <= 1) {
            LAS unsigned char* d = lds + (kind == 0 ? SL_XST : SL_BMT) + n2 * (XS_LD * 2) + s0 * 2;
            *(LAS u32x4*)d = (u32x4){q0[0], q0[1], q0[2], q0[3]}; *(LAS u32x4*)(d + 16) = (u32x4){q0[4], q0[5], q0[6], q0[7]};
            *(LAS u32x4*)(d + XS_LD * 2) = (u32x4){q1[0], q1[1], q1[2], q1[3]}; *(LAS u32x4*)(d + XS_LD * 2 + 16) = (u32x4){q1[4], q1[5], q1[6], q1[7]};
        }
    }
}
__device__ __forceinline__ float ssd_cum(float dtv, float av, LAS unsigned char* lds, int wave, int lane) {
    float c = dtv * av;
#pragma unroll
    for (int o = 1; o < 64; o <<= 1) { const float t = __shfl_up(c, o); if (lane >= o) c += t; }
    const float c63 = __shfl(c, 63);
    ((LAS float*)(lds + SL_CUM))[wave * 64 + lane] = c; ((LAS float*)(lds + SL_DTV))[wave * 64 + lane] = dtv; ((LAS float*)(lds + SL_WV))[wave * 64 + lane] = __expf(c63 - c) * dtv;
    return c63;
}
__device__ __forceinline__ void ssd_state_update(f32x4 (&H)[8][4], float c63, const LAS unsigned char* lds, int wave, int lr, int q) {
    const float dec = __expf(c63);
#pragma unroll
    for (int nb = 0; nb < 8; ++nb)
#pragma unroll
        for (int pb = 0; pb < 4; ++pb) H[nb][pb] = H[nb][pb] * dec;
    const LAS float* wv = (const LAS float*)(lds + SL_WV) + wave * 64;
#pragma unroll
    for (int i = 0; i < 2; ++i) {
        const f32x4 wa = *(const LAS f32x4*)(wv + 32 * i + 4 * q), wb = *(const LAS f32x4*)(wv + 32 * i + 16 + 4 * q);
        bf16x8 xw[4];
#pragma unroll
        for (int pb = 0; pb < 4; ++pb) { const LAS unsigned char* xr = lds + SL_XST + (wave * 64 + xphys(pb, lr)) * (XS_LD * 2) + (32 * i + 4 * q) * 2;
            const u32x2 ua = *(const LAS u32x2*)xr, ub = *(const LAS u32x2*)(xr + 32);
            const f32x4 lo = {bflo(ua.x) * wa[0], bfhi(ua.x) * wa[1], bflo(ua.y) * wa[2], bfhi(ua.y) * wa[3]}, hi = {bflo(ub.x) * wb[0], bfhi(ub.x) * wb[1], bflo(ub.y) * wb[2], bfhi(ub.y) * wb[3]};
            xw[pb] = pack8(lo, hi); }
#pragma unroll
        for (int nb = 0; nb < 8; ++nb) { const LAS unsigned char* br = lds + SL_BMT + (16 * nb + lr) * (XS_LD * 2) + (32 * i + 4 * q) * 2; const bf16x8 bfA = ld_pair8(br, br + 32);
#pragma unroll
            for (int pb = 0; pb < 4; ++pb) H[nb][pb] = MFMA16(bfA, xw[pb], H[nb][pb]); }
        __builtin_amdgcn_sched_barrier(0);
    }
}
__device__ __forceinline__ void ssd_state_load(f32x4 (&H)[8][4], const float* st, int lane) {
#pragma unroll
    for (int nb = 0; nb < 8; ++nb)
#pragma unroll
        for (int pb = 0; pb < 4; ++pb)
#pragma unroll
            for (int r = 0; r < 4; ++r) H[nb][pb][r] = st[(size_t)(((nb * 4 + pb) * 4 + r) * 64 + lane)];
}
__device__ __forceinline__ void ssd_state_store(const f32x4 (&H)[8][4], float* st, int lane) {
#pragma unroll
    for (int nb = 0; nb < 8; ++nb)
#pragma unroll
        for (int pb = 0; pb < 4; ++pb)
#pragma unroll
            for (int r = 0; r < 4; ++r) st[(size_t)(((nb * 4 + pb) * 4 + r) * 64 + lane)] = H[nb][pb][r];
}

__device__ __forceinline__ void ssd1_item(const KP a, int layer, int b, int k, int g, const bf16* PB, const float* DT, unsigned char* hbreg, LAS unsigned char* lds, int tid, int wave, int lane) {
    const int h = g * 8 + wave; (void)tid;
    const float av = -__expf(a.in(I_ALOG)[layer * NH + h]);
    f32x4 H[8][4];
#pragma unroll
    for (int nb = 0; nb < 8; ++nb)
#pragma unroll
        for (int pb = 0; pb < 4; ++pb) H[nb][pb] = (f32x4){0.f, 0.f, 0.f, 0.f};
    float dsum = 0.f;
    float dtn = DT[((size_t)b * SEQ + (size_t)(k * SC) * 64 + lane) * NH + h];
#pragma unroll 1
    for (int c = 0; c < SC; ++c) {
        int ln = lane; asm volatile("" : "+v"(ln));
        const int lr = ln & 15, q = ln >> 4;
        const size_t rowc = (size_t)b * SEQ + (size_t)(k * SC + c) * 64;
        const float dtc = dtn; if (c + 1 < SC) dtn = DT[(rowc + 64 + ln) * NH + h];
        ssd_stage<false>(a, layer, PB + rowc * LDP, (k == 0 && c == 0) ? 0 : 1, nullptr, nullptr, g, lds, wave * 64 + ln);
        const float c63 = ssd_cum(dtc, av, lds, wave, ln);
        dsum += c63;
        lds_barrier();
        ssd_state_update(H, c63, lds, wave, lr, q);
        lds_barrier();
    }
    const size_t si = ((size_t)b * NSC1 + k) * NH + h;
    { int ln = lane; asm volatile("" : "+v"(ln));
      ssd_state_store(H, (float*)(hbreg + WSO_ST) + si * ST_ELEMS, ln);
      if (ln == 0) ((float*)(hbreg + WSO_DTOT))[si] = __expf(dsum); }
}
__device__ __forceinline__ void ssd2_phase(unsigned char* hbreg, int gw, int NGW, int lane) {
    for (int it = gw; it < NB_P * NH * 32; it += NGW) {
        const int bh = it >> 5, part = it & 31, b = bh / NH, h = bh % NH;
        float* s0 = (float*)(hbreg + WSO_ST) + (((size_t)b * NSC1) * NH + h) * ST_ELEMS + (size_t)part * 4 * 64 + lane; const float* d0 = (const float*)(hbreg + WSO_DTOT) + ((size_t)b * NSC1) * NH + h;
        float sv[NSC1][4], dk[NSC1];
#pragma unroll
        for (int k = 0; k < NSC1; ++k) { dk[k] = d0[(size_t)k * NH];
#pragma unroll
            for (int j = 0; j < 4; ++j) sv[k][j] = s0[(size_t)k * NH * ST_ELEMS + j * 64]; }
        float run[4] = {0.f, 0.f, 0.f, 0.f};
#pragma unroll
        for (int k = 0; k < NSC1; ++k)
#pragma unroll
            for (int j = 0; j < 4; ++j) { run[j] = run[j] * dk[k] + sv[k][j]; s0[(size_t)k * NH * ST_ELEMS + j * 64] = run[j]; }
    }
}
__device__ __forceinline__ void ssd3_item(const KP a, int layer, size_t row0, int nchunk, int g, const float* st_init  , const float* sinit  ,
                                          int hist0, const float* cst, float* ssm_out  , float* conv_out  ,
                                          bf16* PB, const float* DT, LAS unsigned char* lds, int tid, int wave, int lane, bf16* dry = nullptr) {
    const int h = g * 8 + wave; (void)tid;
#ifdef S3_DRY_SKIP
    const int skip = dry ? S3_DRY_SKIP : 0; if (dry) { ssm_out = nullptr; conv_out = nullptr; }
#else
    constexpr int skip = 0;
#endif
    const float av = -__expf(a.in(I_ALOG)[layer * NH + h]), Dk = a.in(I_DSKIP)[layer * NH + h];
    f32x4 H[8][4];
    { const int lr = lane & 15, q = lane >> 4;
    if (st_init) ssd_state_load(H, st_init + (size_t)h * ST_ELEMS, lane);
    else if (sinit) {
#pragma unroll
        for (int nb = 0; nb < 8; ++nb)
#pragma unroll
            for (int pb = 0; pb < 4; ++pb) H[nb][pb] = *(const f32x4*)(sinit + ((size_t)h * HD + xphys(pb, lr)) * NS + 16 * nb + 4 * q);
    } else {
#pragma unroll
        for (int nb = 0; nb < 8; ++nb)
#pragma unroll
            for (int pb = 0; pb < 4; ++pb) H[nb][pb] = (f32x4){0.f, 0.f, 0.f, 0.f};
    } }
    ((LAS float*)(lds + SL_GN))[wave * 64 + lane] = a.in(I_SSDN)[(size_t)layer * DIN + h * 64 + lane];
    float dtn = DT[(row0 + lane) * NH + h];
#pragma unroll 1
    for (int c = 0; c < nchunk; ++c) {
        const size_t rowc = row0 + (size_t)c * 64;
        const float dtc = dtn; if (c + 1 < nchunk) dtn = DT[(rowc + 64 + lane) * NH + h];
        if (!(skip & 1)) { int ln = lane; asm volatile("" : "+v"(ln));
          ssd_stage<true>(a, layer, PB + rowc * LDP, c == 0 ? hist0 : 1, cst, (c == nchunk - 1) ? conv_out : nullptr, g, lds, wave * 64 + ln); }
        float c63; { int ln = lane; asm volatile("" : "+v"(ln)); c63 = ssd_cum(dtc, av, lds, wave, ln); }
        lds_barrier();
        const LAS float* cumv = (const LAS float*)(lds + SL_CUM) + wave * 64; const LAS float* dtv = (const LAS float*)(lds + SL_DTV) + wave * 64;
#pragma unroll 1
        for (int th = (skip & 2) ? 2 : 0; th < 2; ++th) {
            int ln = lane; asm volatile("" : "+v"(ln)); const int lr = ln & 15, q = ln >> 4;
            u32x4 zpre[2][2];
#pragma unroll
            for (int tbi = 0; tbi < 2; ++tbi) { const bf16* zr = PB + (rowc + 16 * (2 * th + tbi) + lr) * LDP + PC_Z + h * 64 + 8 * q;
#pragma unroll
                for (int m = 0; m < 2; ++m) zpre[tbi][m] = (skip & 8) ? (u32x4){0x3f803f80u, 0x3f803f80u, 0x3f803f80u, 0x3f803f80u} : *(const u32x4*)(zr + 32 * m); }
            f32x4 cbt[4][2];
#pragma unroll
            for (int sb = 0; sb < 4; ++sb) { cbt[sb][0] = (f32x4){0.f, 0.f, 0.f, 0.f}; cbt[sb][1] = (f32x4){0.f, 0.f, 0.f, 0.f}; }
#pragma unroll
            for (int kk = 0; kk < 4; ++kk) {
                bf16x8 cf[2];
#pragma unroll
                for (int tbi = 0; tbi < 2; ++tbi) cf[tbi] = *(const LAS bf16x8*)(lds + SL_CM + (16 * (2 * th + tbi) + lr) * (TM_LD * 2) + (32 * kk + 8 * q) * 2);
#pragma unroll
                for (int sb = 0; sb < 4; ++sb) { const bf16x8 bfA = *(const LAS bf16x8*)(lds + SL_BM + (16 * sb + lr) * (TM_LD * 2) + (32 * kk + 8 * q) * 2);
                    cbt[sb][0] = MFMA16(bfA, cf[0], cbt[sb][0]); cbt[sb][1] = MFMA16(bfA, cf[1], cbt[sb][1]); }
                __builtin_amdgcn_sched_barrier(0);
            }
            float ct[2]; ct[0] = cumv[16 * (2 * th) + lr]; ct[1] = cumv[16 * (2 * th + 1) + lr];
            bf16x8 mf[2][2];
#pragma unroll
            for (int sb = 0; sb < 4; ++sb) { const f32x4 cs = *(const LAS f32x4*)(cumv + 16 * sb + 4 * q), ds = *(const LAS f32x4*)(dtv + 16 * sb + 4 * q);
#pragma unroll
                for (int tbi = 0; tbi < 2; ++tbi) { const int t = 16 * (2 * th + tbi) + lr;
#pragma unroll
                    for (int r = 0; r < 4; ++r) { const int s = 16 * sb + 4 * q + r; const float f = (s <= t) ? __expf(ct[tbi] - cs[r]) * ds[r] : 0.f; cbt[sb][tbi][r] = cbt[sb][tbi][r] * f + ((s == t) ? Dk : 0.f); } } }
#pragma unroll
            for (int i = 0; i < 2; ++i) { mf[i][0] = pack8(cbt[2 * i][0], cbt[2 * i + 1][0]); mf[i][1] = pack8(cbt[2 * i][1], cbt[2 * i + 1][1]); }
            __builtin_amdgcn_sched_barrier(0);
            f32x4 y[4][2];
#pragma unroll
            for (int pb = 0; pb < 4; ++pb) { y[pb][0] = (f32x4){0.f, 0.f, 0.f, 0.f}; y[pb][1] = (f32x4){0.f, 0.f, 0.f, 0.f}; }
#pragma unroll
            for (int kk = 0; kk < 4; ++kk) {
                bf16x8 cf[2];
#pragma unroll
                for (int tbi = 0; tbi < 2; ++tbi) { const LAS unsigned char* cr = lds + SL_CM + (16 * (2 * th + tbi) + lr) * (TM_LD * 2) + (32 * kk + 4 * q) * 2; cf[tbi] = ld_pair8(cr, cr + 32); }
#pragma unroll
                for (int pb = 0; pb < 4; ++pb) { asm volatile("" : "+v"(H[2 * kk][pb]), "+v"(H[2 * kk + 1][pb]));
                    const bf16x8 hf = pack8(H[2 * kk][pb], H[2 * kk + 1][pb]); y[pb][0] = MFMA16(hf, cf[0], y[pb][0]); y[pb][1] = MFMA16(hf, cf[1], y[pb][1]); }
                __builtin_amdgcn_sched_barrier(0);
            }
            { const float e0 = __expf(ct[0]), e1 = __expf(ct[1]);
#pragma unroll
              for (int pb = 0; pb < 4; ++pb) { y[pb][0] = y[pb][0] * e0; y[pb][1] = y[pb][1] * e1; } }
#pragma unroll
            for (int i = 0; i < 2; ++i)
#pragma unroll
                for (int pb = 0; pb < 4; ++pb) { const LAS unsigned char* xr = lds + SL_XST + (wave * 64 + xphys(pb, lr)) * (XS_LD * 2) + (32 * i + 4 * q) * 2; const bf16x8 xf = ld_pair8(xr, xr + 32);
                    y[pb][0] = MFMA16(xf, mf[i][0], y[pb][0]); y[pb][1] = MFMA16(xf, mf[i][1], y[pb][1]); }
            __builtin_amdgcn_sched_barrier(0);
            float ssq[2] = {0.f, 0.f};
#pragma unroll
            for (int tbi = 0; tbi < 2; ++tbi)
#pragma unroll
                for (int pb = 0; pb < 4; ++pb) { const u32x4 z4 = zpre[tbi][pb >> 1]; const unsigned zx = (pb & 1) ? z4.z : z4.x, zy = (pb & 1) ? z4.w : z4.y; const float zf[4] = {bflo(zx), bfhi(zx), bflo(zy), bfhi(zy)};
#pragma unroll
                    for (int r = 0; r < 4; ++r) { const float v = y[pb][tbi][r] * zf[r]; y[pb][tbi][r] = v; ssq[tbi] += v * v; } }
#pragma unroll
            for (int tbi = 0; tbi < 2; ++tbi) { float s = ssq[tbi]; s += __shfl_xor(s, 16); s += __shfl_xor(s, 32); if (q == 0) ((LAS float*)(lds + SL_SSQ))[(th * 32 + 16 * tbi + lr) * 8 + wave] = s; }
            lds_barrier();
#pragma unroll
            for (int tbi = 0; tbi < 2; ++tbi) { const int t = 16 * (2 * th + tbi) + lr; const LAS f32x4* sp = (const LAS f32x4*)((LAS float*)(lds + SL_SSQ) + (th * 32 + 16 * tbi + lr) * 8);
                const f32x4 s0 = sp[0], s1 = sp[1]; const float rstd = rsqrtf(((s0[0] + s0[1]) + (s0[2] + s0[3]) + (s1[0] + s1[1]) + (s1[2] + s1[3])) * (1.f / 512.f) + EPS);
                bf16* zr = dry ? dry + ((rowc + t) & 8191) * 2048 + h * 64 + 8 * q : PB + (rowc + t) * LDP + PC_Z + h * 64 + 8 * q;
#pragma unroll
                for (int m = 0; m < 2; ++m) { const LAS f32x4* gp = (const LAS f32x4*)((const LAS float*)(lds + SL_GN) + wave * 64 + 32 * m + 8 * q); const f32x4 ga = gp[0], gb = gp[1];
                    const f32x4 va = y[2 * m][tbi], vb = y[2 * m + 1][tbi];
                    u32x4 o; o.x = pk2(va[0] * rstd * ga[0], va[1] * rstd * ga[1]); o.y = pk2(va[2] * rstd * ga[2], va[3] * rstd * ga[3]); o.z = pk2(vb[0] * rstd * gb[0], vb[1] * rstd * gb[1]); o.w = pk2(vb[2] * rstd * gb[2], vb[3] * rstd * gb[3]);
                    if (!(skip & 16)) *(u32x4*)(zr + 32 * m) = o; else asm volatile("" :: "v"(o.x), "v"(o.y), "v"(o.z), "v"(o.w)); } }
        }
        if (!(skip & 4)) { int ln = lane; asm volatile("" : "+v"(ln)); ssd_state_update(H, c63, lds, wave, ln & 15, ln >> 4); }
        lds_barrier();
    }
    if (ssm_out) { int ln = lane; asm volatile("" : "+v"(ln)); const int lr = ln & 15, q = ln >> 4;
#pragma unroll
        for (int nb = 0; nb < 8; ++nb)
#pragma unroll
            for (int pb = 0; pb < 4; ++pb) *(f32x4*)(ssm_out + ((size_t)h * HD + xphys(pb, lr)) * NS + 16 * nb + 4 * q) = H[nb][pb];
    }
}

constexpr int GV_LD = 136;
constexpr int GL_MU = 0, GL_RS = 512, GL_VT = 1024, GL_VT_BYTES = 128 * GV_LD * 2;
static_assert(GL_VT + 2 * GL_VT_BYTES <= LDSCTL_OFF, "gMLP LDS map");

template <int T>
__device__ __forceinline__ void gmlp_stage(const KP a, int layer, const bf16* P0  , int g, float* vout  , LAS unsigned char* lds, int buf, int tid) {
    const LAS float* mu = (const LAS float*)(lds + GL_MU); const LAS float* rs = (const LAS float*)(lds + GL_RS);
#pragma unroll 1
    for (int task = tid; task < 64 * (T / 16); task += NTHREADS) {
        const int tq = task >> 6, pi = task & 63, s0 = 16 * tq, c2 = 2 * pi, cg = g * 128 + c2;
        const f32x2 gg = *(const f32x2*)(a.in(I_GLNG) + (size_t)layer * GMW + cg), gb = *(const f32x2*)(a.in(I_GLNB) + (size_t)layer * GMW + cg);
        unsigned rr[16];
#pragma unroll
        for (int j = 0; j < 16; ++j) rr[j] = *(const unsigned*)(P0 + (size_t)(s0 + j) * LDP + PC_V + cg);
        unsigned q0[8], q1[8];
#pragma unroll
        for (int e = 0; e < 8; ++e) { float oa[2], ob[2];
#pragma unroll
            for (int u = 0; u < 2; ++u) { const int j = 2 * e + u; const float m = mu[s0 + j], r = rs[s0 + j];
                oa[u] = (bflo(rr[j]) - m) * r * gg[0] + gb[0]; ob[u] = (bfhi(rr[j]) - m) * r * gg[1] + gb[1];
                if (vout) *(f32x2*)(vout + (size_t)(s0 + j) * GMW + cg) = (f32x2){oa[u], ob[u]}; }
            q0[e] = pk2(oa[0], oa[1]); q1[e] = pk2(ob[0], ob[1]); }
        LAS unsigned char* d = lds + GL_VT + buf * GL_VT_BYTES + c2 * (GV_LD * 2) + s0 * 2;
        *(LAS u32x4*)d = (u32x4){q0[0], q0[1], q0[2], q0[3]}; *(LAS u32x4*)(d + 16) = (u32x4){q0[4], q0[5], q0[6], q0[7]};
        *(LAS u32x4*)(d + GV_LD * 2) = (u32x4){q1[0], q1[1], q1[2], q1[3]}; *(LAS u32x4*)(d + GV_LD * 2 + 16) = (u32x4){q1[4], q1[5], q1[6], q1[7]};
    }
}
template <int T>
__device__ __forceinline__ void gmlp_item(const KP a, int layer, size_t r0  , float* vout, bf16* PB, const bf16* Wsb  , LAS unsigned char* lds, int tid, int wave, int lane, bf16* dry = nullptr) {
    constexpr int NTB = T / 16;
    bf16* P0 = PB + r0 * LDP;
    { LAS float* mu = (LAS float*)(lds + GL_MU); LAS float* rs = (LAS float*)(lds + GL_RS);
#pragma unroll 1
      for (int t0 = wave * (T / 8); t0 < (wave + 1) * (T / 8); t0 += 8) {
          u32x4 qa[8], qb[8];
#pragma unroll
          for (int i = 0; i < 8; ++i) { const bf16* vr = P0 + (size_t)(t0 + i) * LDP + PC_V + lane * 16; qa[i] = *(const u32x4*)vr; qb[i] = *(const u32x4*)(vr + 8); }
#pragma unroll
          for (int i = 0; i < 8; ++i) {
              const float f[16] = { bflo(qa[i].x), bfhi(qa[i].x), bflo(qa[i].y), bfhi(qa[i].y), bflo(qa[i].z), bfhi(qa[i].z), bflo(qa[i].w), bfhi(qa[i].w), bflo(qb[i].x), bfhi(qb[i].x), bflo(qb[i].y), bfhi(qb[i].y), bflo(qb[i].z), bfhi(qb[i].z), bflo(qb[i].w), bfhi(qb[i].w) };
              float s = 0.f;
#pragma unroll
              for (int j = 0; j < 16; ++j) s += f[j];
              const float mean = wave_sum(s) * (1.f / GMW); float qq = 0.f;
#pragma unroll
              for (int j = 0; j < 16; ++j) { const float d = f[j] - mean; qq += d * d; }
              const float var = wave_sum(qq) * (1.f / GMW);
              if (lane == 0) { mu[t0 + i] = mean; rs[t0 + i] = rsqrtf(var + EPS); } }
      } }
    lds_barrier();
    gmlp_stage<T>(a, layer, P0, 0, vout, lds, 0, tid);
    lds_barrier();
#pragma unroll 1
    for (int g = 0; g < 8; ++g) {
        int ln = lane; asm volatile("" : "+v"(ln)); const int lr = ln & 15, q = ln >> 4;
        if (g + 1 < 8) gmlp_stage<T>(a, layer, P0, g + 1, vout, lds, (g + 1) & 1, wave * 64 + ln);
        const LAS unsigned char* vt = lds + GL_VT + (g & 1) * GL_VT_BYTES + (16 * wave + lr) * (GV_LD * 2);
        bf16x8 af[T / 32];
#pragma unroll
        for (int kk = 0; kk < T / 32; ++kk) af[kk] = *(const LAS bf16x8*)(vt + (32 * kk + 8 * q) * 2);
        const bf16* wg = Wsb + (size_t)g * 128 * 128;
        bf16x8 wf[NTB][T / 32]; float bsv[NTB]; u32x2 uu[NTB];
#pragma unroll
        for (int tb = 0; tb < NTB; ++tb) {
#pragma unroll
            for (int kk = 0; kk <= tb / 2; ++kk) wf[tb][kk] = *(const bf16x8*)(wg + (size_t)(16 * tb + lr) * 128 + 32 * kk + 8 * q);
            bsv[tb] = a.in(I_GBS)[(size_t)(layer * 8 + g) * 128 + 16 * tb + lr];
            uu[tb] = *(const u32x2*)(P0 + (size_t)(16 * tb + lr) * LDP + PC_U + g * 128 + 16 * wave + 4 * q); }
#pragma unroll
        for (int tb = 0; tb < NTB; ++tb) {
            f32x4 acc = {0.f, 0.f, 0.f, 0.f};
#pragma unroll
            for (int kk = 0; kk <= tb / 2; ++kk) acc = MFMA16(af[kk], wf[tb][kk], acc);
            bf16* up = dry ? dry + ((r0 + 16 * tb + lr) & 8191) * 2048 + g * 128 + 16 * wave + 4 * q : P0 + (size_t)(16 * tb + lr) * LDP + PC_U + g * 128 + 16 * wave + 4 * q;
            u32x2 o; o.x = pk2(bflo(uu[tb].x) * (acc[0] + bsv[tb]), bfhi(uu[tb].x) * (acc[1] + bsv[tb])); o.y = pk2(bflo(uu[tb].y) * (acc[2] + bsv[tb]), bfhi(uu[tb].y) * (acc[3] + bsv[tb])); *(u32x2*)up = o;
        }
        lds_barrier();
    }
}

static_assert(GL_VT + 4 * GL_VT_BYTES <= LDSCTL_OFF, "gMLP decode LDS map");
__device__ __forceinline__ void gmlp_stage_dec(const KP a, int layer, const bf16* P0, int g, float* vout, LAS unsigned char* lds, int buf, int tid) {
    const LAS float* mu = (const LAS float*)(lds + GL_MU); const LAS float* rs = (const LAS float*)(lds + GL_RS);
    if (tid < 256) {
        const int tq = tid >> 6, pi = tid & 63, s0 = 16 * tq, c2 = 2 * pi, cg = g * 128 + c2;
        const f32x2 gg = *(const f32x2*)(a.in(I_GLNG) + (size_t)layer * GMW + cg), gb = *(const f32x2*)(a.in(I_GLNB) + (size_t)layer * GMW + cg);
        unsigned rr[16];
#pragma unroll
        for (int j = 0; j < 16; ++j) rr[j] = *(const unsigned*)(P0 + (size_t)(s0 + j) * LDP + PC_V + cg);
        unsigned h0[8], h1[8], l0[8], l1[8];
#pragma unroll
        for (int e = 0; e < 8; ++e) { float oa[2], ob[2];
#pragma unroll
            for (int u = 0; u < 2; ++u) { const int j = 2 * e + u; const float m = mu[s0 + j], r = rs[s0 + j];
                oa[u] = (bflo(rr[j]) - m) * r * gg[0] + gb[0]; ob[u] = (bfhi(rr[j]) - m) * r * gg[1] + gb[1];
                *(f32x2*)(vout + (size_t)(s0 + j) * GMW + cg) = (f32x2){oa[u], ob[u]}; }
            h0[e] = pk2(oa[0], oa[1]); h1[e] = pk2(ob[0], ob[1]);
            l0[e] = pk2(oa[0] - bflo(h0[e]), oa[1] - bfhi(h0[e])); l1[e] = pk2(ob[0] - bflo(h1[e]), ob[1] - bfhi(h1[e])); }
        LAS unsigned char* d = lds + GL_VT + buf * GL_VT_BYTES + c2 * (GV_LD * 2) + s0 * 2;
        *(LAS u32x4*)d = (u32x4){h0[0], h0[1], h0[2], h0[3]}; *(LAS u32x4*)(d + 16) = (u32x4){h0[4], h0[5], h0[6], h0[7]};
        *(LAS u32x4*)(d + GV_LD * 2) = (u32x4){h1[0], h1[1], h1[2], h1[3]}; *(LAS u32x4*)(d + GV_LD * 2 + 16) = (u32x4){h1[4], h1[5], h1[6], h1[7]};
        d += 2 * GL_VT_BYTES;
        *(LAS u32x4*)d = (u32x4){l0[0], l0[1], l0[2], l0[3]}; *(LAS u32x4*)(d + 16) = (u32x4){l0[4], l0[5], l0[6], l0[7]};
        *(LAS u32x4*)(d + GV_LD * 2) = (u32x4){l1[0], l1[1], l1[2], l1[3]}; *(LAS u32x4*)(d + GV_LD * 2 + 16) = (u32x4){l1[4], l1[5], l1[6], l1[7]};
    }
}
__device__ __forceinline__ void gmlp_item_dec(const KP a, int layer, size_t r0, float* vout, bf16* PB, LAS unsigned char* lds, int tid, int wave, int lane) {
    constexpr int T = 64, NTB = 4;
    bf16* P0 = PB + r0 * LDP;
    { LAS float* mu = (LAS float*)(lds + GL_MU); LAS float* rs = (LAS float*)(lds + GL_RS);
      const int t0 = wave * 8;
      u32x4 qa[8], qb[8];
#pragma unroll
      for (int i = 0; i < 8; ++i) { const bf16* vr = P0 + (size_t)(t0 + i) * LDP + PC_V + lane * 16; qa[i] = *(const u32x4*)vr; qb[i] = *(const u32x4*)(vr + 8); }
#pragma unroll
      for (int i = 0; i < 8; ++i) {
          const float f[16] = { bflo(qa[i].x), bfhi(qa[i].x), bflo(qa[i].y), bfhi(qa[i].y), bflo(qa[i].z), bfhi(qa[i].z), bflo(qa[i].w), bfhi(qa[i].w), bflo(qb[i].x), bfhi(qb[i].x), bflo(qb[i].y), bfhi(qb[i].y), bflo(qb[i].z), bfhi(qb[i].z), bflo(qb[i].w), bfhi(qb[i].w) };
          float s = 0.f;
#pragma unroll
          for (int j = 0; j < 16; ++j) s += f[j];
          const float mean = wave_sum(s) * (1.f / GMW); float qq = 0.f;
#pragma unroll
          for (int j = 0; j < 16; ++j) { const float d = f[j] - mean; qq += d * d; }
          const float var = wave_sum(qq) * (1.f / GMW);
          if (lane == 0) { mu[t0 + i] = mean; rs[t0 + i] = rsqrtf(var + EPS); } } }
    lds_barrier();
    gmlp_stage_dec(a, layer, P0, 0, vout, lds, 0, tid);
    lds_barrier();
#pragma unroll 1
    for (int g = 0; g < 8; ++g) {
        int ln = lane; asm volatile("" : "+v"(ln)); const int lr = ln & 15, q = ln >> 4;
        if (g + 1 < 8) gmlp_stage_dec(a, layer, P0, g + 1, vout, lds, (g + 1) & 1, wave * 64 + ln);
        const LAS unsigned char* vt = lds + GL_VT + (g & 1) * GL_VT_BYTES + (16 * wave + lr) * (GV_LD * 2);
        bf16x8 ah[T / 32], al[T / 32];
#pragma unroll
        for (int kk = 0; kk < T / 32; ++kk) { ah[kk] = *(const LAS bf16x8*)(vt + (32 * kk + 8 * q) * 2); al[kk] = *(const LAS bf16x8*)(vt + 2 * GL_VT_BYTES + (32 * kk + 8 * q) * 2); }
        const float* w32 = a.in(I_GWS) + (size_t)(layer * 8 + g) * 128 * 128;
        bf16x8 wh[NTB][T / 32], wl[NTB][T / 32]; float bsv[NTB]; u32x2 uu[NTB];
#pragma unroll
        for (int tb = 0; tb < NTB; ++tb) { const int t = 16 * tb + lr;
#pragma unroll
            for (int kk = 0; kk <= tb / 2; ++kk) { const float* wp = w32 + (size_t)t * 128 + 32 * kk + 8 * q; const f32x4 w0 = *(const f32x4*)wp, w1 = *(const f32x4*)(wp + 4);
                float f[8] = {w0[0], w0[1], w0[2], w0[3], w1[0], w1[1], w1[2], w1[3]};
#pragma unroll
                for (int e = 0; e < 8; ++e) if (32 * kk + 8 * q + e > t) f[e] = 0.f;
                const u32x4 hi = {pk2(f[0], f[1]), pk2(f[2], f[3]), pk2(f[4], f[5]), pk2(f[6], f[7])};
                const u32x4 lo = {pk2(f[0] - bflo(hi.x), f[1] - bfhi(hi.x)), pk2(f[2] - bflo(hi.y), f[3] - bfhi(hi.y)), pk2(f[4] - bflo(hi.z), f[5] - bfhi(hi.z)), pk2(f[6] - bflo(hi.w), f[7] - bfhi(hi.w))};
                wh[tb][kk] = __builtin_bit_cast(bf16x8, hi); wl[tb][kk] = __builtin_bit_cast(bf16x8, lo); }
            bsv[tb] = a.in(I_GBS)[(size_t)(layer * 8 + g) * 128 + t];
            uu[tb] = *(const u32x2*)(P0 + (size_t)t * LDP + PC_U + g * 128 + 16 * wave + 4 * q); }
#pragma unroll
        for (int tb = 0; tb < NTB; ++tb) {
            f32x4 acc = {0.f, 0.f, 0.f, 0.f};
#pragma unroll
            for (int kk = 0; kk <= tb / 2; ++kk) { acc = MFMA16(al[kk], wh[tb][kk], acc); acc = MFMA16(ah[kk], wl[tb][kk], acc); acc = MFMA16(ah[kk], wh[tb][kk], acc); }
            bf16* up = P0 + (size_t)(16 * tb + lr) * LDP + PC_U + g * 128 + 16 * wave + 4 * q;
            u32x2 o; o.x = pk2(bflo(uu[tb].x) * (acc[0] + bsv[tb]), bfhi(uu[tb].x) * (acc[1] + bsv[tb])); o.y = pk2(bflo(uu[tb].y) * (acc[2] + bsv[tb]), bfhi(uu[tb].y) * (acc[3] + bsv[tb])); *(u32x2*)up = o;
        }
        lds_barrier();
    }
}

#ifndef MK_PER_PHASE
#define MK_PER_PHASE 0
#endif
constexpr int WGM_WIDE = 8;
constexpr int WGM_N2K = 4;
constexpr int FFN_R1 = 64 * 256;
constexpr int PH_PER_LAYER = 15, N_PHASES = DEPTH * PH_PER_LAYER + 1;

__global__ void __launch_bounds__(NTHREADS, 2) mk_fwd(Args a_unused) {
    (void)a_unused;
    extern __shared__ __attribute__((aligned(16))) unsigned char lds_raw[];
    LAS unsigned char* lds = (LAS unsigned char*)lds_raw;
    const int G = gridDim.x, bid = blockIdx.x;
    const int wave0 = __builtin_amdgcn_readfirstlane(threadIdx.x >> 6);
    { volatile LAS unsigned* M0 = (volatile LAS unsigned*)(lds + LDSCTL_OFF); if (threadIdx.x < 64) M0[threadIdx.x] = 0u; }
    __syncthreads();
    int lo, hi; XcdBarrier bar;
    { const KP k0 = kp_get(); lo = k0.ph_lo(); hi = k0.ph_hi();
      bar.bar = (unsigned*)(k0.ws() + WS_CTL) + CW_BAR; bar.x = 0; bar.st = (volatile LAS unsigned*)(lds + LDSCTL_OFF) + 8; bar.w0 = (unsigned)wave0;
      if (hi - lo > 1) bar = xcd_barrier_post((unsigned*)(k0.ws() + WS_CTL) + CW_BAR, (volatile LAS unsigned*)(lds + LDSCTL_OFF) + 8, (unsigned)wave0); }
#define PH_LOCALS \
    const KP a = kp_get(); int lane = lane_id(); asm volatile("" : "+v"(lane)); unsigned char* wsb = a.ws(); float* X = a.out(); \
    const int wave = wave0, tid = wave * 64 + lane, gw = bid * NWAVES + wave, NGW = G * NWAVES, gtid = bid * NTHREADS + tid, NGT = G * NTHREADS; \
    bf16* Wb = (bf16*)(wsb + WS_W); bf16* XS = (bf16*)(wsb + WS_HB); bf16* XT = (bf16*)((unsigned char*)X + WSO_XT); float* RS = (float*)(wsb + WS_RS); float* SSQ = (float*)(wsb + WS_SQ); bf16* PB = (bf16*)(wsb + WS_PB); bf16* AB = PB; bf16* PE = (bf16*)(wsb + WS_PE); float* DT = (float*)(wsb + WS_DT); float* PART = (float*)(wsb + WS_PART); \
    (void)tid; (void)gw; (void)NGW; (void)gtid; (void)NGT; (void)Wb; (void)XS; (void)XT; (void)RS; (void)SSQ; (void)PB; (void)AB; (void)PE; (void)DT; (void)PART; (void)X;

    int ph = 0;
#define PH_ON (lo <= ph && ph < hi)
#define PH_END do { if (PH_ON && ph + 1 < hi) xcd_barrier(bar); ++ph; } while (0)

    if (PH_ON) { PH_LOCALS convert_group<0>(a, 0, Wb, lds, gw, NGW, wave, lane); convert_group<1>(a, 0, Wb, lds, gw, NGW, wave, lane); convert_group<6>(a, 0, Wb, lds, gw, NGW, wave, lane); convert_group<2>(a, 0, Wb, lds, gw, NGW, wave, lane); convert_group<5>(a, 0, Wb, lds, gw, NGW, wave, lane);
        convert_group<3>(a, 0, Wb, lds, gw, NGW, wave, lane); convert_misc(a, 0, Wb, PE, gtid, NGT);
        phase_first(a.in(I_XP), a.in(I_XS), XS, RS, gw, NGW, lane);
#ifdef DBG_FILL
        if (0 == 0) for (size_t i = OUT_SSM_P + gtid; i < OUT_END; i += NGT) a.out()[i] = 0.f;
#endif
    }
    PH_END;
    if (PH_ON) { PH_LOCALS pg8::Gemm g{XS, Wb + WO_GU1, XBP, KP_D, M_TOK, FF2, D}; pg8::StaticOrder S; S.init(M_TOK, FF2, D, G, bid, WGM_WIDE);
        EpiGU E{AB, LDF, RS}; pg8::gemm_phase<EpiGU, pg8::StaticOrder, true, true>(lds, g, S, E, wave); }
    PH_END;
    if (PH_ON) { PH_LOCALS
        pg8::Gemm g{AB, Wb + WO_D1, LDF, KP_F, M_TOK, D, FF}; pg8::TailSplitOrder S; S.init(M_P, M_TOK - M_P, M_P / 256, D, FF, G, bid, WGM_N2K, 0);
        EpiRes<false> E{nullptr, nullptr, XS, M_P, 0.5f, PART, SSQ}; pg8::gemm_phase<EpiRes<false>, pg8::TailSplitOrder, true, true>(lds, g, S, E, wave); }
    PH_END;
    if (PH_ON) { PH_LOCALS phase_rstd<true>(SSQ, RS, PART, XS, gw, NGW, lane, gtid, NGT); }
    PH_END;
    if (PH_ON) { PH_LOCALS pg8::Gemm g{XS, Wb + WO_IN, XBP, KP_D, M_TOK, NIN, D}; pg8::StaticOrder S; S.init(M_TOK, NIN, D, G, bid, WGM_WIDE);
        EpiInProj E{PB, DT, a.in(I_DTB) + 0 * NH, RS}; pg8::gemm_phase<EpiInProj, pg8::StaticOrder, true, true>(lds, g, S, E, wave);
        TAIL_CONVERT((M_TOK / 256) * (NIN / 256), convert_group<4>(a, 0, Wb, lds, tw_, tn_, wave, lane);); }
    PH_END;
    if (PH_ON) { PH_LOCALS
        constexpr int N_S1 = NB_P * NSC1 * NG, N_GM = NB_P * (SEQ / 128) + NB_S;
        for (int it = bid; it < N_S1; it += G) ssd1_item(a, 0, it / (NSC1 * NG), (it / NG) % NSC1, it % NG, PB, DT, (unsigned char*)X, lds, tid, wave, lane);
        for (int j = bid; j < NB_P * (SEQ / 128); j += G) gmlp_item<128>(a, 0, (size_t)(j / (SEQ / 128)) * SEQ + (size_t)(j % (SEQ / 128)) * 128, nullptr, PB, Wb + WO_WS, lds, tid, wave, lane);
        for (int bs = (G >= NB_S) ? bid - (G - NB_S) : bid; bs < NB_S; bs += G) if (bs >= 0)
            gmlp_item_dec(a, 0, (size_t)M_P + (size_t)bs * L_S, X + OUT_GV + (size_t)(0 * NB_S + bs) * L_S * GMW, PB, lds, tid, wave, lane);
        (void)N_GM;
    }
    PH_END;
    if (PH_ON) { PH_LOCALS
        constexpr int N_S3D = NB_S * NG;
        if (G > N_S3D) {
            if (bid < N_S3D) { const int bs = bid / NG, g = bid % NG;
                ssd3_item(a, 0, (size_t)M_P + (size_t)bs * L_S, 1, g, nullptr, a.in(I_SSSM) + (size_t)(0 * NB_S + bs) * NH * HD * NS, 2, a.in(I_SCONV) + (size_t)(0 * NB_S + bs) * 3 * XBC,
                          X + OUT_SSM_S + (size_t)(0 * NB_S + bs) * NH * HD * NS, X + OUT_CONV_S + (size_t)(0 * NB_S + bs) * 3 * XBC, PB, DT, lds, tid, wave, lane); }
            else ssd2_phase((unsigned char*)X, gw - N_S3D * NWAVES, NGW - N_S3D * NWAVES, lane);
        } else {
            for (int j = bid; j < N_S3D; j += G) { const int bs = j / NG, g = j % NG;
                ssd3_item(a, 0, (size_t)M_P + (size_t)bs * L_S, 1, g, nullptr, a.in(I_SSSM) + (size_t)(0 * NB_S + bs) * NH * HD * NS, 2, a.in(I_SCONV) + (size_t)(0 * NB_S + bs) * 3 * XBC,
                          X + OUT_SSM_S + (size_t)(0 * NB_S + bs) * NH * HD * NS, X + OUT_CONV_S + (size_t)(0 * NB_S + bs) * 3 * XBC, PB, DT, lds, tid, wave, lane); }
            ssd2_phase((unsigned char*)X, gw, NGW, lane);
        }
    }
    PH_END;
    if (PH_ON) { PH_LOCALS
        constexpr int N_S3P = NB_P * NSC * NG;
        for (int it = bid; it < N_S3P; it += G) {
            { const int b = it / (NSC * NG), k = (it / NG) % NSC, g = it % NG; const bool lastk = (k == NSC - 1);
                ssd3_item(a, 0, (size_t)b * SEQ + (size_t)k * SC * 64, SC, g, k ? (const float*)((unsigned char*)X + WSO_ST) + ((size_t)b * NSC1 + (k - 1)) * NH * ST_ELEMS : nullptr, nullptr, k ? 1 : 0, nullptr,
                          lastk ? X + OUT_SSM_P + (size_t)(0 * NB_P + b) * NH * HD * NS : nullptr, lastk ? X + OUT_CONV_P + (size_t)(0 * NB_P + b) * 3 * XBC : nullptr, PB, DT, lds, tid, wave, lane); }
        }
    }
    PH_END;
    if (PH_ON) { PH_LOCALS
        { pg8::Gemm g{PB + PC_Z, Wb + WO_A, LDP, KP_D, M_TOK, D, DIN}; pg8::StaticOrder S; S.init(M_TOK, D, DIN, G, bid, WGM_N2K);
          EpiMerge<0> E{PB + PC_GA, PB + PC_MRG}; pg8::gemm_phase<EpiMerge<0>, pg8::StaticOrder, true, true>(lds, g, S, E, wave); }
        { pg8::Gemm g{PB + PC_U, Wb + WO_B, LDP, KP_G, M_TOK, D, GMW}; pg8::StaticOrder S; S.init(M_TOK, D, GMW, G, bid, WGM_N2K);
          EpiMerge<1> E{PB + PC_GB, PB + PC_MRG}; pg8::gemm_phase<EpiMerge<1>, pg8::StaticOrder, true, true>(lds, g, S, E, wave); }
        TAIL_CONVERT((M_TOK / 256) * (D / 256), convert_group<0>(a, 1, Wb, lds, tw_, tn_, wave, lane); convert_group<1>(a, 1, Wb, lds, tw_, tn_, wave, lane); convert_group<6>(a, 1, Wb, lds, tw_, tn_, wave, lane););
    }
    PH_END;
    if (PH_ON) { PH_LOCALS pg8::Gemm g{PB + PC_MRG, Wb + WO_O, LDP, KP_D, M_TOK, D, D}; pg8::TailSplitOrder S; S.init(M_P, M_TOK - M_P, M_P / 256, D, D, G, bid, WGM_N2K, 0);
        EpiRes<false> E{nullptr, nullptr, XS, M_P, 1.0f, PART, SSQ}; pg8::gemm_phase<EpiRes<false>, pg8::TailSplitOrder, true, true>(lds, g, S, E, wave); }
    PH_END;
    if (PH_ON) { PH_LOCALS phase_rstd<true>(SSQ, RS, PART, XS, gw, NGW, lane, gtid, NGT); }
    PH_END;
    if (PH_ON) { PH_LOCALS pg8::Gemm g{XS, Wb + WO_GU2, XBP, KP_D, M_TOK, FF2, D}; pg8::StaticOrder S; S.init(M_TOK, FF2, D, G, bid, WGM_WIDE);
        EpiGU E{AB, LDF, RS}; pg8::gemm_phase<EpiGU, pg8::StaticOrder, true, true>(lds, g, S, E, wave); }
    PH_END;
    if (PH_ON) { PH_LOCALS
        pg8::Gemm g{AB, Wb + WO_D2, LDF, KP_F, M_TOK, D, FF}; pg8::TailSplitOrder S; S.init(M_P, M_TOK - M_P, M_P / 256, D, FF, G, bid, WGM_N2K, 0);
        EpiRes<false> E{nullptr, nullptr, XS, M_P, 0.5f, PART, SSQ}; pg8::gemm_phase<EpiRes<false>, pg8::TailSplitOrder, true, true>(lds, g, S, E, wave); }
    PH_END;
    if (PH_ON) { PH_LOCALS phase_rstd<true>(SSQ, RS, PART, XS, gw, NGW, lane, gtid, NGT); }
    PH_END;
    if (PH_ON) { PH_LOCALS
        { pg8::Gemm g{XS, Wb + WO_PG, XBP, KP_D, M_TOK, D, D}; pg8::StaticOrder S; S.init(M_TOK, D, D, G, bid, WGM_N2K);
          EpiPg E{PB + PC_TMP, RS}; pg8::gemm_phase<EpiPg, pg8::StaticOrder, true, true>(lds, g, S, E, wave); }
        { pg8::Gemm g{PE, Wb + WO_PP, LDE, KP_E, M_TOK, D, PLE}; pg8::StaticOrder S; S.init(M_TOK, D, PLE, G, bid, WGM_N2K);
          EpiPle E{PB + PC_TMP, XS, XT, SSQ}; pg8::gemm_phase<EpiPle, pg8::StaticOrder, true, true>(lds, g, S, E, wave); }
        TAIL_CONVERT((M_TOK / 256) * (D / 256), convert_group<2>(a, 1, Wb, lds, tw_, tn_, wave, lane); convert_group<4>(a, 1, Wb, lds, tw_, tn_, wave, lane); convert_group<5>(a, 1, Wb, lds, tw_, tn_, wave, lane););
    }
    PH_END;
    if (PH_ON) { PH_LOCALS
        convert_group<3>(a, 1, Wb, lds, gw, NGW, wave, lane); convert_misc(a, 1, Wb, PE, gtid, NGT);
        phase_rstd<false>(SSQ, RS, PART, XT, gw, NGW, lane, gtid, NGT);
#ifdef DBG_FILL
        if (1 == 0) for (size_t i = OUT_SSM_P + gtid; i < OUT_END; i += NGT) a.out()[i] = 0.f;
#endif
    }
    PH_END;
    if (PH_ON) { PH_LOCALS pg8::Gemm g{XT, Wb + WO_GU1, XBP, KP_D, M_TOK, FF2, D}; pg8::StaticOrder S; S.init(M_TOK, FF2, D, G, bid, WGM_WIDE);
        EpiGU E{AB, LDF, RS}; pg8::gemm_phase<EpiGU, pg8::StaticOrder, true, true>(lds, g, S, E, wave); }
    PH_END;
    if (PH_ON) { PH_LOCALS
        pg8::Gemm g{AB, Wb + WO_D1, LDF, KP_F, M_TOK, D, FF}; pg8::TailSplitOrder S; S.init(M_P, M_TOK - M_P, M_P / 256, D, FF, G, bid, WGM_N2K, 0);
        EpiRes<false> E{nullptr, nullptr, XT, M_P, 0.5f, PART, SSQ}; pg8::gemm_phase<EpiRes<false>, pg8::TailSplitOrder, true, true>(lds, g, S, E, wave); }
    PH_END;
    if (PH_ON) { PH_LOCALS phase_rstd<true>(SSQ, RS, PART, XT, gw, NGW, lane, gtid, NGT); }
    PH_END;
    if (PH_ON) { PH_LOCALS pg8::Gemm g{XT, Wb + WO_IN, XBP, KP_D, M_TOK, NIN, D}; pg8::StaticOrder S; S.init(M_TOK, NIN, D, G, bid, WGM_WIDE);
        EpiInProj E{PB, DT, a.in(I_DTB) + 1 * NH, RS}; pg8::gemm_phase<EpiInProj, pg8::StaticOrder, true, true>(lds, g, S, E, wave); }
    PH_END;
    if (PH_ON) { PH_LOCALS
        constexpr int N_S1 = NB_P * NSC1 * NG, N_GM = NB_P * (SEQ / 128) + NB_S;
        for (int it = bid; it < N_S1; it += G) ssd1_item(a, 1, it / (NSC1 * NG), (it / NG) % NSC1, it % NG, PB, DT, (unsigned char*)X, lds, tid, wave, lane);
        for (int j = bid; j < NB_P * (SEQ / 128); j += G) gmlp_item<128>(a, 1, (size_t)(j / (SEQ / 128)) * SEQ + (size_t)(j % (SEQ / 128)) * 128, nullptr, PB, Wb + WO_WS, lds, tid, wave, lane);
        for (int bs = (G >= NB_S) ? bid - (G - NB_S) : bid; bs < NB_S; bs += G) if (bs >= 0)
            gmlp_item_dec(a, 1, (size_t)M_P + (size_t)bs * L_S, X + OUT_GV + (size_t)(1 * NB_S + bs) * L_S * GMW, PB, lds, tid, wave, lane);
        (void)N_GM;
    }
    PH_END;
    if (PH_ON) { PH_LOCALS
        constexpr int N_S3D = NB_S * NG;
        if (G > N_S3D) {
            if (bid < N_S3D) { const int bs = bid / NG, g = bid % NG;
                ssd3_item(a, 1, (size_t)M_P + (size_t)bs * L_S, 1, g, nullptr, a.in(I_SSSM) + (size_t)(1 * NB_S + bs) * NH * HD * NS, 2, a.in(I_SCONV) + (size_t)(1 * NB_S + bs) * 3 * XBC,
                          X + OUT_SSM_S + (size_t)(1 * NB_S + bs) * NH * HD * NS, X + OUT_CONV_S + (size_t)(1 * NB_S + bs) * 3 * XBC, PB, DT, lds, tid, wave, lane); }
            else ssd2_phase((unsigned char*)X, gw - N_S3D * NWAVES, NGW - N_S3D * NWAVES, lane);
        } else {
            for (int j = bid; j < N_S3D; j += G) { const int bs = j / NG, g = j % NG;
                ssd3_item(a, 1, (size_t)M_P + (size_t)bs * L_S, 1, g, nullptr, a.in(I_SSSM) + (size_t)(1 * NB_S + bs) * NH * HD * NS, 2, a.in(I_SCONV) + (size_t)(1 * NB_S + bs) * 3 * XBC,
                          X + OUT_SSM_S + (size_t)(1 * NB_S + bs) * NH * HD * NS, X + OUT_CONV_S + (size_t)(1 * NB_S + bs) * 3 * XBC, PB, DT, lds, tid, wave, lane); }
            ssd2_phase((unsigned char*)X, gw, NGW, lane);
        }
    }
    PH_END;
    if (PH_ON) { PH_LOCALS
        constexpr int N_S3P = NB_P * NSC * NG;
        for (int it = bid; it < N_S3P; it += G) {
            { const int b = it / (NSC * NG), k = (it / NG) % NSC, g = it % NG; const bool lastk = (k == NSC - 1);
                ssd3_item(a, 1, (size_t)b * SEQ + (size_t)k * SC * 64, SC, g, k ? (const float*)((unsigned char*)X + WSO_ST) + ((size_t)b * NSC1 + (k - 1)) * NH * ST_ELEMS : nullptr, nullptr, k ? 1 : 0, nullptr,
                          lastk ? X + OUT_SSM_P + (size_t)(1 * NB_P + b) * NH * HD * NS : nullptr, lastk ? X + OUT_CONV_P + (size_t)(1 * NB_P + b) * 3 * XBC : nullptr, PB, DT, lds, tid, wave, lane); }
        }
    }
    PH_END;
    if (PH_ON) { PH_LOCALS
        { pg8::Gemm g{PB + PC_Z, Wb + WO_A, LDP, KP_D, M_TOK, D, DIN}; pg8::StaticOrder S; S.init(M_TOK, D, DIN, G, bid, WGM_N2K);
          EpiMerge<0> E{PB + PC_GA, PB + PC_MRG}; pg8::gemm_phase<EpiMerge<0>, pg8::StaticOrder, true, true>(lds, g, S, E, wave); }
        { pg8::Gemm g{PB + PC_U, Wb + WO_B, LDP, KP_G, M_TOK, D, GMW}; pg8::StaticOrder S; S.init(M_TOK, D, GMW, G, bid, WGM_N2K);
          EpiMerge<1> E{PB + PC_GB, PB + PC_MRG}; pg8::gemm_phase<EpiMerge<1>, pg8::StaticOrder, true, true>(lds, g, S, E, wave); }
    }
    PH_END;
    if (PH_ON) { PH_LOCALS pg8::Gemm g{PB + PC_MRG, Wb + WO_O, LDP, KP_D, M_TOK, D, D}; pg8::TailSplitOrder S; S.init(M_P, M_TOK - M_P, M_P / 256, D, D, G, bid, WGM_N2K, 0);
        EpiRes<false> E{nullptr, nullptr, XT, M_P, 1.0f, PART, SSQ}; pg8::gemm_phase<EpiRes<false>, pg8::TailSplitOrder, true, true>(lds, g, S, E, wave); }
    PH_END;
    if (PH_ON) { PH_LOCALS phase_rstd<true>(SSQ, RS, PART, XT, gw, NGW, lane, gtid, NGT); }
    PH_END;
    if (PH_ON) { PH_LOCALS pg8::Gemm g{XT, Wb + WO_GU2, XBP, KP_D, M_TOK, FF2, D}; pg8::StaticOrder S; S.init(M_TOK, FF2, D, G, bid, WGM_WIDE);
        EpiGU E{AB, LDF, RS}; pg8::gemm_phase<EpiGU, pg8::StaticOrder, true, true>(lds, g, S, E, wave); }
    PH_END;
    if (PH_ON) { PH_LOCALS
        pg8::Gemm g{AB, Wb + WO_D2, LDF, KP_F, M_TOK, D, FF}; pg8::TailSplitOrder S; S.init(M_P, M_TOK - M_P, M_P / 256, D, FF, G, bid, WGM_N2K, 0);
        EpiRes<false> E{nullptr, nullptr, XT, M_P, 0.5f, PART, SSQ}; pg8::gemm_phase<EpiRes<false>, pg8::TailSplitOrder, true, true>(lds, g, S, E, wave); }
    PH_END;
    if (PH_ON) { PH_LOCALS phase_rstd<true>(SSQ, RS, PART, XT, gw, NGW, lane, gtid, NGT); }
    PH_END;
    if (PH_ON) { PH_LOCALS
        { pg8::Gemm g{XT, Wb + WO_PG, XBP, KP_D, M_TOK, D, D}; pg8::StaticOrder S; S.init(M_TOK, D, D, G, bid, WGM_N2K);
          EpiPg E{PB + PC_TMP, RS}; pg8::gemm_phase<EpiPg, pg8::StaticOrder, true, true>(lds, g, S, E, wave); }
        { pg8::Gemm g{PE, Wb + WO_PP, LDE, KP_E, M_TOK, D, PLE}; pg8::StaticOrder S; S.init(M_TOK, D, PLE, G, bid, WGM_N2K);
          EpiPle E{PB + PC_TMP, XT, XS, SSQ}; pg8::gemm_phase<EpiPle, pg8::StaticOrder, true, true>(lds, g, S, E, wave); }
    }
    PH_END;
    if (PH_ON) { PH_LOCALS phase_final_norm(XS, X, a.in(I_FINN), gw, NGW, lane); }
    PH_END;
#undef PH_ON
#undef PH_END
}

extern "C" void kernel_launch(void* const* d_in, const int* in_sizes, int n_in, void* d_out, int out_size, void* d_ws, size_t ws_size, hipStream_t stream) {
    static int grid = 0;
    if (grid == 0) {
        if (n_in != N_IN || (size_t)out_size != OUT_END || ws_size < WS_END) { fprintf(stderr, "kernel_launch: unexpected problem: n_in %d out %d ws %zu (need %zu)\n", n_in, out_size, ws_size, (size_t)WS_END); grid = -1; return; }
        int dev = 0, cus = 0, per_cu = 0;
        if (hipGetDevice(&dev) != hipSuccess || hipDeviceGetAttribute(&cus, hipDeviceAttributeMultiprocessorCount, dev) != hipSuccess) { grid = -1; return; }
        if (hipFuncSetAttribute((const void*)mk_fwd, hipFuncAttributeMaxDynamicSharedMemorySize, LDS_BYTES) != hipSuccess) { fprintf(stderr, "kernel_launch: hipFuncSetAttribute failed\n"); grid = -1; return; }
        if (hipOccupancyMaxActiveBlocksPerMultiprocessor(&per_cu, (const void*)mk_fwd, NTHREADS, LDS_BYTES) != hipSuccess || per_cu < 1) { fprintf(stderr, "kernel_launch: occupancy query says %d blocks per CU\n", per_cu); (void)hipGetLastError(); grid = -1; return; }
        grid = cus;
    }
    if (grid < 0) return;
    (void)in_sizes;
    if (hipMemsetAsync((char*)d_ws + WS_CTL, 0, CTL_ZERO_BYTES, stream) != hipSuccess) return;
    Args a{};
    for (int i = 0; i < N_IN; ++i) a.in[i] = (const float*)d_in[i];
    a.out = (float*)d_out; a.ws = (unsigned char*)d_ws;
#if MK_PER_PHASE
    #ifndef DBG_LIMIT
#define DBG_LIMIT N_PHASES
#endif
    for (int p = 0; p < DBG_LIMIT; ++p) { a.ph_lo = p; a.ph_hi = p + 1; hipLaunchKernelGGL(mk_fwd, dim3(grid), dim3(NTHREADS), LDS_BYTES, stream, a); }
#else
    a.ph_lo = 0; a.ph_hi = N_PHASES; hipLaunchKernelGGL(mk_fwd, dim3(grid), dim3(NTHREADS), LDS_BYTES, stream, a);
#endif
    const hipError_t le = hipPeekAtLastError();
    if (le != hipSuccess) fprintf(stderr, "kernel_launch: launch failed: %s\n", hipGetErrorName(le));
}
```

```cpp
#include <hip/hip_runtime.h>
#include <cstdio>
#include <cstdint>

namespace pg8 {
#define PG8_LAS __attribute__((address_space(3)))
typedef unsigned short bf16_t;
typedef short bf16x8 __attribute__((ext_vector_type(8)));
typedef float f32x4 __attribute__((ext_vector_type(4)));
typedef float f32x2 __attribute__((ext_vector_type(2)));
typedef unsigned u32x4 __attribute__((ext_vector_type(4)));
typedef unsigned u32x2 __attribute__((ext_vector_type(2)));
constexpr int BM = 256, BK = 64, HALF = 128, HTB = HALF * BK * 2  , STAGE_BYTES = 8 * HTB, NXCD = 8, WGM = 8;

__host__ __device__ __forceinline__ int lds_byte(int r, int c) { const int st = (r >> 4) * 2 + (c >> 5), rr = r & 15, cc = c & 31, ob = rr * 64 + cc * 2; return st * 1024 + (ob ^ (((ob >> 9) & 1) << 5)); }
__host__ __device__ __forceinline__ void stage_rc(int b, int& R, int& C) { const int st = b / 1024, sb = b % 1024, swz = sb ^ (((sb >> 9) & 1) << 5); R = (st >> 1) * 16 + swz / 64; C = (st & 1) * 32 + (swz % 64) / 2; }
__host__ __device__ __forceinline__ int perm32(int rho) { const int n = rho >> 4, i = rho & 15; return 8 * (i >> 2) + 4 * n + (i & 3); }

struct Unit { int pm, pn, kt0, ktn, slice; };
struct Gemm { const bf16_t* A; const bf16_t* Bt; int lda, ldb, M, N, K; };

struct StaticOrder {
    int nM, nN, nwg, G, c, ntk, wgm, pmb;
    __host__ __device__ __forceinline__ void init(int M, int N, int K, int G_, int c_, int wgm_ = WGM, int pmb_ = 0) { nM = M / BM; nN = N / BM; nwg = nM * nN; G = G_; c = c_; ntk = K / BK; wgm = wgm_; pmb = pmb_; }
    __host__ __device__ __forceinline__ void tile_of(int L, int& pm, int& pn) const {
        int wgid = L; { const int q = nwg / NXCD, r = nwg % NXCD, xcd = wgid % NXCD, off = wgid / NXCD; wgid = (xcd < r ? xcd * (q + 1) : r * (q + 1) + (xcd - r) * q) + off; }
        const int nig = wgm * nN, gid = wgid / nig, fm = gid * wgm, gsz = (nM - fm) < wgm ? (nM - fm) : wgm;
        pm = pmb + fm + ((wgid % nig) % gsz); pn = (wgid % nig) / gsz;
    }
    __host__ __device__ __forceinline__ bool next(int i, Unit& u) const {
        const long L = (long)i * G + c; const bool ok = L < nwg;
        int pm, pn; tile_of(ok ? (int)L : 0, pm, pn);
        u.pm = pm; u.pn = pn; u.kt0 = 0; u.ktn = ntk; u.slice = -1; return ok;
    }
    __device__ __forceinline__ void a_ready(const Unit&) const {}
    __device__ __forceinline__ void done(const Unit&) const {}
};
struct TailSplitOrder : StaticOrder {
    int nmain, ntail, pm0;
    __host__ __device__ __forceinline__ void init(int M_main, int M_tail, int pmt, int N, int K, int G_, int c_, int wgm_ = WGM, int pmb_ = 0) { StaticOrder::init(M_main, N, K, G_, c_, wgm_, pmb_); nmain = nwg; pm0 = pmt; ntail = M_tail / BM * nN * 8; }
    __host__ __device__ __forceinline__ bool next(int i, Unit& u) const {
        const long L = (long)i * G + c; const bool is_main = L < nmain; const long ti = L - nmain; const bool ok = is_main || ti < ntail;
        int pm, pn; tile_of(is_main ? (int)L : 0, pm, pn);
        const int idx = (!is_main && ok) ? (int)ti : 0, tl = idx >> 3, sl = idx & 7, half = ntk >> 1, q = half >> 3, r = half & 7;
        u.pm = is_main ? pm : pm0 + tl / nN; u.pn = is_main ? pn : tl % nN;
        u.kt0 = is_main ? 0 : 2 * (sl * q + (sl < r ? sl : r)); u.ktn = is_main ? ntk : 2 * (q + (sl < r ? 1 : 0)); u.slice = is_main ? -1 : sl; return ok;
    }
};

typedef __bf16 bf16x2_hw __attribute__((ext_vector_type(2)));
__device__ __forceinline__ unsigned cvt_pk_bf16(float lo, float hi) { const f32x2 v = {lo, hi}; const bf16x2_hw b = __builtin_convertvector(v, bf16x2_hw); return __builtin_bit_cast(unsigned, b); }

template <class Epi, class Sched, bool ALIGN_EPI = false, bool SP2 = false>
__device__ __forceinline__ void gemm_phase(PG8_LAS unsigned char* lds, const Gemm g, const Sched& S, const Epi& E, const int wid  ) {
    int lane = (int)__builtin_amdgcn_mbcnt_hi(~0u, __builtin_amdgcn_mbcnt_lo(~0u, 0u)); asm volatile("" : "+v"(lane));
    const int tid = wid * 64 + lane, wr = wid >> 2, wc = wid & 3, fr = lane & 15, fq = lane >> 4;
    unsigned voffA[2], voffB[2];
#pragma unroll
    for (int i = 0; i < 2; ++i) { int R, C; stage_rc(tid * 16 + i * 8192, R, C); const int Rb = Epi::PERM ? ((R & ~31) + perm32(R & 31)) : R;
        voffA[i] = (unsigned)(R * g.lda + C) * 2u; voffB[i] = (unsigned)(Rb * g.ldb + C) * 2u; }
    const size_t kstep = (size_t)(BK * 2);
    const size_t hsA = (size_t)HALF * g.lda * 2, hsB = (size_t)HALF * g.ldb * 2;
    const size_t tsA = 2 * hsA, tsB = 2 * hsB;
    const unsigned ldsw = (unsigned)wid * 1024u;
    const int aoff = lds_byte(wr * 64 + fr, fq * 8), boff = lds_byte(wc * 32 + fr, fq * 8);
#define PG8_SA(b, h) (((b) * 2 + (h)) * HTB)
#define PG8_SB(b, h) ((4 + (b) * 2 + (h)) * HTB)
#define PG8_STAGE(bufoff, gbase, voff) do { _Pragma("unroll") for (int _i = 0; _i < 2; ++_i) \
        __builtin_amdgcn_global_load_lds((const unsigned*)((const char*)(gbase) + (voff)[_i]), (PG8_LAS unsigned*)(lds + (bufoff) + ldsw + _i * 8192), 16, 0, 0); } while (0)
#define PG8_LDA(dst, b, h) do { _Pragma("unroll") for (int m = 0; m < 4; ++m) _Pragma("unroll") for (int k = 0; k < 2; ++k) dst[m][k] = *(const PG8_LAS bf16x8*)(lds + PG8_SA(b, h) + aoff + m * 2048 + k * 1024); } while (0)
#define PG8_LDB(dst, b, h) do { _Pragma("unroll") for (int n = 0; n < 2; ++n) _Pragma("unroll") for (int k = 0; k < 2; ++k) dst[n][k] = *(const PG8_LAS bf16x8*)(lds + PG8_SB(b, h) + boff + n * 2048 + k * 1024); } while (0)
#define PG8_MMA(ai, bj, At, Bt) do { __builtin_amdgcn_s_setprio(1); _Pragma("unroll") for (int m = 0; m < 4; ++m) _Pragma("unroll") for (int n = 0; n < 2; ++n) _Pragma("unroll") for (int k = 0; k < 2; ++k) \
        acc[ai][bj][m][n] = __builtin_amdgcn_mfma_f32_16x16x32_bf16(Bt[n][k], At[m][k], acc[ai][bj][m][n], 0, 0, 0); __builtin_amdgcn_s_setprio(0); } while (0)
#define PG8_WAIT_V(n) asm volatile("s_waitcnt vmcnt(" #n ")" ::: "memory")
#define PG8_WAIT_L(n) asm volatile("s_waitcnt lgkmcnt(" #n ")" ::: "memory")
#define PG8_BAR __builtin_amdgcn_s_barrier()
#define PG8_SCHED __builtin_amdgcn_sched_barrier(0)
    Unit cur, nxt; int ui = 0;
    if (!S.next(0, cur)) return;
    f32x4 acc[2][2][4][2];
#pragma unroll
    for (int a = 0; a < 2; ++a)
#pragma unroll
        for (int b = 0; b < 2; ++b)
#pragma unroll
            for (int m = 0; m < 4; ++m)
#pragma unroll
                for (int n = 0; n < 2; ++n) acc[a][b][m][n] = (f32x4){0.f, 0.f, 0.f, 0.f};
    bf16x8 At[4][2], B0[2][2], B1[2][2];
    const char* cA = (const char*)g.A + (size_t)cur.pm * tsA + (size_t)cur.kt0 * kstep; const char* cB = (const char*)g.Bt + (size_t)cur.pn * tsB + (size_t)cur.kt0 * kstep;
    S.a_ready(cur);
    if constexpr (SP2) {
        PG8_STAGE(PG8_SB(0, 0), cB, voffB); PG8_STAGE(PG8_SB(0, 1), cB + hsB, voffB); PG8_STAGE(PG8_SA(0, 0), cA, voffA); PG8_STAGE(PG8_SA(0, 1), cA + hsA, voffA);
        if (wr == 1) PG8_BAR;
        PG8_WAIT_V(2); PG8_BAR;
        PG8_STAGE(PG8_SB(1, 0), cB + kstep, voffB); PG8_STAGE(PG8_SA(1, 0), cA + kstep, voffA); PG8_STAGE(PG8_SB(1, 1), cB + hsB + kstep, voffB);
        PG8_WAIT_V(6); PG8_BAR;
    } else {
        PG8_STAGE(PG8_SB(0, 0), cB, voffB); PG8_STAGE(PG8_SA(0, 0), cA, voffA); PG8_STAGE(PG8_SB(0, 1), cB + hsB, voffB); PG8_STAGE(PG8_SA(0, 1), cA + hsA, voffA);
        if (wr == 1) PG8_BAR;
        PG8_WAIT_V(4); PG8_BAR;
        PG8_STAGE(PG8_SB(1, 0), cB + kstep, voffB); PG8_STAGE(PG8_SA(1, 0), cA + kstep, voffA); PG8_STAGE(PG8_SB(1, 1), cB + hsB + kstep, voffB);
        PG8_WAIT_V(6); PG8_BAR;
    }
    for (;;) {
        const bool has_next = S.next(ui + 1, nxt); const int nt = cur.ktn;
        const char* nA = has_next ? (const char*)g.A + (size_t)nxt.pm * tsA + (size_t)nxt.kt0 * kstep : cA; const char* nB = has_next ? (const char*)g.Bt + (size_t)nxt.pn * tsB + (size_t)nxt.kt0 * kstep : cB;
        for (int t = 0; t < nt; t += 2) {
            const bool last = (t == nt - 2);
            const char* a1 = cA + (size_t)(t + 1) * kstep;
            const char* a2 = last ? nA : cA + (size_t)(t + 2) * kstep; const char* b2 = last ? nB : cB + (size_t)(t + 2) * kstep;
            const char* a3 = a2 + kstep; const char* b3 = b2 + kstep;
            if (last && has_next) S.a_ready(nxt);
            if constexpr (SP2) {
            PG8_LDB(B0, 0, 0); PG8_LDB(B1, 0, 1); PG8_SCHED; PG8_LDA(At, 0, 0); PG8_STAGE(PG8_SA(1, 1), a1 + hsA, voffA);
            PG8_WAIT_V(8); PG8_WAIT_L(0); PG8_BAR; PG8_MMA(0, 0, At, B0); PG8_MMA(0, 1, At, B1); PG8_BAR; PG8_SCHED;
            PG8_LDA(At, 0, 1); PG8_STAGE(PG8_SB(0, 0), b2, voffB); PG8_STAGE(PG8_SB(0, 1), b2 + hsB, voffB); PG8_STAGE(PG8_SA(0, 0), a2, voffA);
            PG8_WAIT_V(8); PG8_WAIT_L(0); PG8_BAR; PG8_MMA(1, 0, At, B0); PG8_MMA(1, 1, At, B1); PG8_BAR; PG8_SCHED;
            PG8_LDB(B0, 1, 0); PG8_LDB(B1, 1, 1); PG8_SCHED; PG8_LDA(At, 1, 0); PG8_STAGE(PG8_SA(0, 1), a2 + hsA, voffA);
            PG8_WAIT_V(8); PG8_WAIT_L(0); PG8_BAR; PG8_MMA(0, 0, At, B0); PG8_MMA(0, 1, At, B1); PG8_BAR; PG8_SCHED;
            PG8_LDA(At, 1, 1); PG8_STAGE(PG8_SB(1, 0), b3, voffB); PG8_STAGE(PG8_SB(1, 1), b3 + hsB, voffB); PG8_STAGE(PG8_SA(1, 0), a3, voffA);
            PG8_WAIT_V(8); PG8_WAIT_L(0); PG8_BAR; PG8_MMA(1, 0, At, B0); PG8_MMA(1, 1, At, B1); PG8_BAR; PG8_SCHED;
            } else {
            PG8_LDB(B0, 0, 0); PG8_SCHED; PG8_LDA(At, 0, 0); PG8_STAGE(PG8_SA(1, 1), a1 + hsA, voffA);
            PG8_WAIT_L(8); PG8_BAR; PG8_WAIT_L(0); PG8_MMA(0, 0, At, B0); PG8_BAR; PG8_SCHED;
            PG8_LDB(B1, 0, 1); PG8_STAGE(PG8_SB(0, 0), b2, voffB);
            PG8_BAR; PG8_WAIT_L(0); PG8_MMA(0, 1, At, B1); PG8_BAR;
            PG8_LDA(At, 0, 1); PG8_STAGE(PG8_SA(0, 0), a2, voffA);
            PG8_BAR; PG8_WAIT_L(0); PG8_MMA(1, 0, At, B0); PG8_BAR; PG8_SCHED;
            PG8_STAGE(PG8_SB(0, 1), b2 + hsB, voffB);
            PG8_WAIT_V(6); PG8_BAR; PG8_MMA(1, 1, At, B1); PG8_BAR;
            PG8_LDB(B0, 1, 0); PG8_SCHED; PG8_LDA(At, 1, 0); PG8_STAGE(PG8_SA(0, 1), a2 + hsA, voffA);
            PG8_WAIT_L(8); PG8_BAR; PG8_WAIT_L(0); PG8_MMA(0, 0, At, B0); PG8_BAR; PG8_SCHED;
            PG8_LDB(B1, 1, 1); PG8_STAGE(PG8_SB(1, 0), b3, voffB);
            PG8_BAR; PG8_WAIT_L(0); PG8_MMA(0, 1, At, B1); PG8_BAR;
            PG8_LDA(At, 1, 1); PG8_STAGE(PG8_SA(1, 0), a3, voffA);
            PG8_BAR; PG8_WAIT_L(0); PG8_MMA(1, 0, At, B0); PG8_BAR; PG8_SCHED;
            PG8_STAGE(PG8_SB(1, 1), b3 + hsB, voffB);
            PG8_WAIT_V(6); PG8_BAR; PG8_MMA(1, 1, At, B1); PG8_BAR;
            }
        }
        if constexpr (ALIGN_EPI) { if (wr == 0) PG8_BAR; }
        E(acc, cur, wr, wc, fr, fq); S.done(cur);
        if (!has_next) break;
#pragma unroll
        for (int a = 0; a < 2; ++a)
#pragma unroll
            for (int b = 0; b < 2; ++b)
#pragma unroll
                for (int m = 0; m < 4; ++m)
#pragma unroll
                    for (int n = 0; n < 2; ++n) acc[a][b][m][n] = (f32x4){0.f, 0.f, 0.f, 0.f};
        cur = nxt; cA = nA; cB = nB; ++ui;
        if constexpr (ALIGN_EPI) { if (wr == 1) PG8_BAR; }
    }
    PG8_WAIT_V(0);
    if constexpr (!ALIGN_EPI) { if (wr == 0) PG8_BAR; }
    PG8_BAR;
#undef PG8_SA
#undef PG8_SB
#undef PG8_STAGE
#undef PG8_LDA
#undef PG8_LDB
#undef PG8_MMA
#undef PG8_WAIT_V
#undef PG8_WAIT_L
#undef PG8_BAR
#undef PG8_SCHED
}
}

constexpr int D = 2048, SEQ = 8192, NB_P = 4, NB_S = 16, L_S = 64, DEPTH = 2;
constexpr int M_P = NB_P * SEQ;
constexpr int M_TOK = M_P + NB_S * L_S;
constexpr int FF = 5632, FF2 = 2 * FF;
constexpr int NH = 32, HD = 64, NG = 4, NS = 128, XBC = 3072, DIN = 2048;
constexpr int GMW = 1024, PLE = 256, INC = 11296;
constexpr int NIN = 11520;
constexpr int LDP = 11520;
constexpr int LDH = 2048, LDF = 5632, LDE = 256;
constexpr int KP_D = 2048, KP_F = 5632, KP_G = 1024, KP_E = 256;
constexpr int PC_Z = 0, PC_XBC = 2048, PC_U = 5120, PC_V = 6144, PC_GA = 7168, PC_GB = 9216, PC_DT = 11264;
constexpr int PC_MRG = 2048;
constexpr int PC_TMP = 0;
constexpr float EPS = 1e-6f;

typedef unsigned short bf16;
typedef pg8::f32x4 f32x4;
typedef pg8::f32x2 f32x2;
typedef pg8::u32x4 u32x4;
typedef pg8::u32x2 u32x2;
#define LAS __attribute__((address_space(3)))

__device__ __forceinline__ float bf2f(bf16 b) { return __uint_as_float(((unsigned)b) << 16); }
__device__ __forceinline__ float bflo(unsigned w) { return __uint_as_float(w << 16); }
__device__ __forceinline__ float bfhi(unsigned w) { return __uint_as_float(w & 0xffff0000u); }
__device__ __forceinline__ bf16 f2bf(float f) { return (bf16)(pg8::cvt_pk_bf16(f, 0.f) & 0xffffu); }
__device__ __forceinline__ unsigned pk2(float lo, float hi) { return pg8::cvt_pk_bf16(lo, hi); }
__device__ __forceinline__ float fast_sigmoid(float x) { return __builtin_amdgcn_rcpf(1.f + __builtin_amdgcn_exp2f(-1.4426950409f * x)); }
__device__ __forceinline__ float fast_silu(float x) { return x * fast_sigmoid(x); }
__device__ __forceinline__ float fast_gelu_tanh(float x) { const float y = 0.7978845608f * (x + 0.044715f * x * x * x); return x * fast_sigmoid(2.f * y); }
__device__ __forceinline__ float softplus_f(float x) { return x > 20.f ? x : log1pf(expf(x)); }

using pg8::Unit;
struct EpiGU {
    static constexpr bool PERM = false;
    bf16* O; int ldc; const float* RS;
    mutable int pmc; mutable float rs[2][4];
    __device__ __forceinline__ void operator()(const f32x4 (&acc)[2][2][4][2], const Unit& u, int wr, int wc, int fr, int fq) const {
        const int row0 = u.pm * 256 + wr * 64 + fr, col0 = u.pn * 128 + wc * 32 + 8 * fq;
        if (pmc != u.pm + 1) { pmc = u.pm + 1;
#pragma unroll
            for (int ai = 0; ai < 2; ++ai)
#pragma unroll
                for (int m = 0; m < 4; ++m) rs[ai][m] = RS[row0 + ai * 128 + m * 16]; }
#pragma unroll
        for (int ai = 0; ai < 2; ++ai)
#pragma unroll
            for (int m = 0; m < 4; ++m) { bf16* rowp = O + (size_t)(row0 + ai * 128 + m * 16) * ldc + col0;
                const float rl = -1.4426950409f * rs[ai][m], r2 = rs[ai][m] * rs[ai][m];
                const f32x4 g0 = acc[ai][0][m][0], u0 = acc[ai][0][m][1], g1 = acc[ai][1][m][0], u1 = acc[ai][1][m][1];
                const f32x4 p0 = g0 * u0 * r2, p1 = g1 * u1 * r2, e0 = g0 * rl, e1 = g1 * rl;
                float o[8];
#pragma unroll
                for (int j = 0; j < 4; ++j) { o[j] = p0[j] * __builtin_amdgcn_rcpf(1.f + __builtin_amdgcn_exp2f(e0[j])); o[4 + j] = p1[j] * __builtin_amdgcn_rcpf(1.f + __builtin_amdgcn_exp2f(e1[j])); }
                u32x4 w; w.x = pk2(o[0], o[1]); w.y = pk2(o[2], o[3]); w.z = pk2(o[4], o[5]); w.w = pk2(o[6], o[7]);
                *(u32x4*)rowp = w; }
    }
};
__device__ __forceinline__ float ssq8(const f32x4 a, const f32x4 b) { return ((a[0] * a[0] + a[1] * a[1]) + (a[2] * a[2] + a[3] * a[3])) + ((b[0] * b[0] + b[1] * b[1]) + (b[2] * b[2] + b[3] * b[3])); }
__device__ __forceinline__ void ssq_emit(float* SSQ, float s, int plane, int row, int fq) { s += __shfl_xor(s, 16); s += __shfl_xor(s, 32); if (fq == 0) SSQ[(size_t)plane * M_TOK + row] = s; }
constexpr int XBP = D;
__device__ __forceinline__ void unpack8(const u32x4 w, f32x4& lo, f32x4& hi) { lo = (f32x4){bflo(w.x), bfhi(w.x), bflo(w.y), bfhi(w.y)}; hi = (f32x4){bflo(w.z), bfhi(w.z), bflo(w.w), bfhi(w.w)}; }
__device__ __forceinline__ u32x4 pack8u(const f32x4 lo, const f32x4 hi) { return (u32x4){pk2(lo[0], lo[1]), pk2(lo[2], lo[3]), pk2(hi[0], hi[1]), pk2(hi[2], hi[3])}; }
template <bool SRC_F32> struct EpiRes {
    static constexpr bool PERM = true;
    const float* rlo; const float* rhi; bf16* XB; int split; float alpha; float* part; float* SSQ;
    __device__ __forceinline__ void operator()(const f32x4 (&acc)[2][2][4][2], const Unit& u, int wr, int wc, int fr, int fq) const {
        const int row0 = u.pm * 256 + wr * 64 + fr, col0 = u.pn * 256 + wc * 32 + 8 * fq;
        if (u.slice >= 0) {
#pragma unroll
            for (int ai = 0; ai < 2; ++ai)
#pragma unroll
                for (int m = 0; m < 4; ++m) { float* pp = part + ((size_t)u.slice * (M_TOK - M_P) + (size_t)(row0 + ai * 128 + m * 16 - split)) * D + col0;
#pragma unroll
                    for (int bj = 0; bj < 2; ++bj) { *(f32x4*)(pp + bj * 128) = alpha * acc[ai][bj][m][0]; *(f32x4*)(pp + bj * 128 + 4) = alpha * acc[ai][bj][m][1]; } }
            return;
        }
#pragma unroll
        for (int ai = 0; ai < 2; ++ai) {
            f32x4 r0[4][2], r1[4][2];
#pragma unroll
            for (int m = 0; m < 4; ++m) { const int r = row0 + ai * 128 + m * 16;
#pragma unroll
                for (int bj = 0; bj < 2; ++bj) {
                    if (SRC_F32) { const float* rp = (r < split ? rlo + (size_t)r * D : rhi + (size_t)(r - split) * D) + col0 + bj * 128; r0[m][bj] = *(const f32x4*)rp; r1[m][bj] = *(const f32x4*)(rp + 4); }
                    else unpack8(*(const u32x4*)(XB + (size_t)r * XBP + col0 + bj * 128), r0[m][bj], r1[m][bj]); } }
#pragma unroll
            for (int m = 0; m < 4; ++m) { bf16* xp = XB + (size_t)(row0 + ai * 128 + m * 16) * XBP + col0; float sq = 0.f;
#pragma unroll
                for (int bj = 0; bj < 2; ++bj) { const f32x4 x0 = r0[m][bj] + alpha * acc[ai][bj][m][0], x1 = r1[m][bj] + alpha * acc[ai][bj][m][1]; sq += ssq8(x0, x1); *(u32x4*)(xp + bj * 128) = pack8u(x0, x1); }
                ssq_emit(SSQ, sq, u.pn * 4 + wc, row0 + ai * 128 + m * 16, fq); }
            asm volatile("" ::: "memory"); }
    }
};
struct EpiInProj {
    static constexpr bool PERM = true;
    bf16* P; float* DT; const float* dt_bias; const float* RS;
    mutable int pmc; mutable float rsc[2][4];
    __device__ __forceinline__ void operator()(const f32x4 (&acc)[2][2][4][2], const Unit& u, int wr, int wc, int fr, int fq) const {
        const int row0 = u.pm * 256 + wr * 64 + fr, col0 = u.pn * 256 + wc * 32 + 8 * fq;
        const int mode = u.pn < 8 ? 0 : u.pn < 20 ? 1 : u.pn < 28 ? 2 : u.pn < 44 ? 3 : 4;
        if (pmc != u.pm + 1) { pmc = u.pm + 1;
#pragma unroll
            for (int ai = 0; ai < 2; ++ai)
#pragma unroll
                for (int m = 0; m < 4; ++m) rsc[ai][m] = RS[row0 + ai * 128 + m * 16]; }
        if (mode == 4) {
            if (wc == 0) {
                const f32x4 b0 = *(const f32x4*)(dt_bias + 8 * fq), b1 = *(const f32x4*)(dt_bias + 8 * fq + 4);
#pragma unroll
                for (int ai = 0; ai < 2; ++ai)
#pragma unroll
                    for (int m = 0; m < 4; ++m) { float* dp = DT + (size_t)(row0 + ai * 128 + m * 16) * 32 + 8 * fq; const float rs = rsc[ai][m];
                        f32x4 v0 = acc[ai][0][m][0] * rs + b0, v1 = acc[ai][0][m][1] * rs + b1;
#pragma unroll
                        for (int j = 0; j < 4; ++j) { v0[j] = softplus_f(v0[j]); v1[j] = softplus_f(v1[j]); }
                        *(f32x4*)dp = v0; *(f32x4*)(dp + 4) = v1; }
            }
            return;
        }
#pragma unroll
        for (int ai = 0; ai < 2; ++ai)
#pragma unroll
            for (int m = 0; m < 4; ++m) { bf16* rowp = P + (size_t)(row0 + ai * 128 + m * 16) * LDP + col0; const float rs = rsc[ai][m];
#pragma unroll
                for (int bj = 0; bj < 2; ++bj) { f32x4 v0 = acc[ai][bj][m][0] * rs, v1 = acc[ai][bj][m][1] * rs;
                    if (mode == 0) {
#pragma unroll
                        for (int j = 0; j < 4; ++j) { v0[j] = fast_silu(v0[j]); v1[j] = fast_silu(v1[j]); } }
                    else if (mode == 2) {
#pragma unroll
                        for (int j = 0; j < 4; ++j) { v0[j] = fast_gelu_tanh(v0[j]); v1[j] = fast_gelu_tanh(v1[j]); } }
                    else if (mode == 3) {
#pragma unroll
                        for (int j = 0; j < 4; ++j) { v0[j] = fast_sigmoid(v0[j]); v1[j] = fast_sigmoid(v1[j]); } }
                    u32x4 w; w.x = pk2(v0[0], v0[1]); w.y = pk2(v0[2], v0[3]); w.z = pk2(v1[0], v1[1]); w.w = pk2(v1[2], v1[3]);
                    *(u32x4*)(rowp + bj * 128) = w; } }
    }
};
template <int MODE> struct EpiMerge {
    static constexpr bool PERM = true;
    const bf16* Gt; bf16* T;
    __device__ __forceinline__ void operator()(const f32x4 (&acc)[2][2][4][2], const Unit& u, int wr, int wc, int fr, int fq) const {
        const int row0 = u.pm * 256 + wr * 64 + fr, col0 = u.pn * 256 + wc * 32 + 8 * fq;
#pragma unroll
        for (int ai = 0; ai < 2; ++ai) {
            u32x4 gg[4][2], tt[4][2];
#pragma unroll
            for (int m = 0; m < 4; ++m) { const size_t ro = (size_t)(row0 + ai * 128 + m * 16) * LDP + col0;
#pragma unroll
                for (int bj = 0; bj < 2; ++bj) { gg[m][bj] = *(const u32x4*)(Gt + ro + bj * 128); if (MODE == 1) tt[m][bj] = *(const u32x4*)(T + ro + bj * 128); } }
#pragma unroll
            for (int m = 0; m < 4; ++m) { const size_t ro = (size_t)(row0 + ai * 128 + m * 16) * LDP + col0;
#pragma unroll
                for (int bj = 0; bj < 2; ++bj) { const u32x4 g4 = gg[m][bj];
                    f32x4 v0 = acc[ai][bj][m][0], v1 = acc[ai][bj][m][1];
                    v0[0] *= bflo(g4.x); v0[1] *= bfhi(g4.x); v0[2] *= bflo(g4.y); v0[3] *= bfhi(g4.y); v1[0] *= bflo(g4.z); v1[1] *= bfhi(g4.z); v1[2] *= bflo(g4.w); v1[3] *= bfhi(g4.w);
                    if (MODE == 1) { const u32x4 t4 = tt[m][bj];
                        v0[0] += bflo(t4.x); v0[1] += bfhi(t4.x); v0[2] += bflo(t4.y); v0[3] += bfhi(t4.y); v1[0] += bflo(t4.z); v1[1] += bfhi(t4.z); v1[2] += bflo(t4.w); v1[3] += bfhi(t4.w); }
                    u32x4 w; w.x = pk2(v0[0], v0[1]); w.y = pk2(v0[2], v0[3]); w.z = pk2(v1[0], v1[1]); w.w = pk2(v1[2], v1[3]);
                    *(u32x4*)(T + ro + bj * 128) = w; } }
            asm volatile("" ::: "memory"); }
    }
};
struct EpiPg {
    static constexpr bool PERM = true;
    bf16* T; const float* RS;
    __device__ __forceinline__ void operator()(const f32x4 (&acc)[2][2][4][2], const Unit& u, int wr, int wc, int fr, int fq) const {
        const int row0 = u.pm * 256 + wr * 64 + fr, col0 = u.pn * 256 + wc * 32 + 8 * fq;
#pragma unroll
        for (int ai = 0; ai < 2; ++ai)
#pragma unroll
            for (int m = 0; m < 4; ++m) { bf16* rowp = T + (size_t)(row0 + ai * 128 + m * 16) * LDP + col0; const float rs = RS[row0 + ai * 128 + m * 16];
#pragma unroll
                for (int bj = 0; bj < 2; ++bj) { f32x4 v0 = acc[ai][bj][m][0] * rs, v1 = acc[ai][bj][m][1] * rs;
#pragma unroll
                    for (int j = 0; j < 4; ++j) { v0[j] = fast_sigmoid(v0[j]); v1[j] = fast_sigmoid(v1[j]); }
                    *(u32x4*)(rowp + bj * 128) = pack8u(v0, v1); } }
    }
};
struct EpiPle {
    static constexpr bool PERM = true;
    const bf16* T; const bf16* XI; bf16* XB; float* SSQ;
    __device__ __forceinline__ void operator()(const f32x4 (&acc)[2][2][4][2], const Unit& u, int wr, int wc, int fr, int fq) const {
        const int row0 = u.pm * 256 + wr * 64 + fr, col0 = u.pn * 256 + wc * 32 + 8 * fq;
#pragma unroll
        for (int ai = 0; ai < 2; ++ai) {
            u32x4 tt[4][2], xx[4][2];
#pragma unroll
            for (int m = 0; m < 4; ++m) { const int r = row0 + ai * 128 + m * 16;
#pragma unroll
                for (int bj = 0; bj < 2; ++bj) { tt[m][bj] = *(const u32x4*)(T + (size_t)r * LDP + col0 + bj * 128); xx[m][bj] = *(const u32x4*)(XI + (size_t)r * XBP + col0 + bj * 128); } }
#pragma unroll
            for (int m = 0; m < 4; ++m) { bf16* xp = XB + (size_t)(row0 + ai * 128 + m * 16) * XBP + col0; float sq = 0.f;
#pragma unroll
                for (int bj = 0; bj < 2; ++bj) { f32x4 t0, t1, x0, x1; unpack8(tt[m][bj], t0, t1); unpack8(xx[m][bj], x0, x1);
                    x0 = x0 + acc[ai][bj][m][0] * t0; x1 = x1 + acc[ai][bj][m][1] * t1; sq += ssq8(x0, x1); *(u32x4*)(xp + bj * 128) = pack8u(x0, x1); }
                ssq_emit(SSQ, sq, u.pn * 4 + wc, row0 + ai * 128 + m * 16, fq); }
            asm volatile("" ::: "memory"); }
    }
};

#define XB_TMO      128
#define XB_XCNT(j)  (256  + 64 * (j))
#define XB_XSUB(j)  (1280 + 64 * (j))
#define XB_XGEN(j)  (2304 + 64 * (j))
#define XB_TOP      3328
#define XB_TOPGEN   3392
#define XCD_BAR_WORDS 3456
#define XB_SPIN_CAP (1u << 18)

__device__ __forceinline__ unsigned xb_ld(unsigned* p)              { return __hip_atomic_load(p, __ATOMIC_RELAXED, __HIP_MEMORY_SCOPE_AGENT); }
__device__ __forceinline__ unsigned xb_add(unsigned* p, unsigned v) { return __hip_atomic_fetch_add(p, v, __ATOMIC_RELAXED, __HIP_MEMORY_SCOPE_AGENT); }
__device__ __forceinline__ unsigned xb_xcc_id() { return (unsigned)__builtin_amdgcn_s_getreg((3 << 11) | 20) & 0xFu; }
#define XB_SPIN(cond, bar) do { unsigned _sp = 0; while (cond) { __builtin_amdgcn_s_sleep(1); \
    if ((++_sp & 255u) == 0u) { if (xb_ld(&(bar)[XB_TMO])) break; if (_sp > XB_SPIN_CAP) { atomicAdd(&(bar)[XB_TMO], 1u); break; } } } } while (0)

__device__ __forceinline__ unsigned xb_lane() { return __builtin_amdgcn_mbcnt_hi(~0u, __builtin_amdgcn_mbcnt_lo(~0u, 0u)); }
struct XcdBarrier {
    unsigned* bar; unsigned x; unsigned w0;
    volatile LAS unsigned* st;
};

__device__ __forceinline__ XcdBarrier xcd_barrier_post(unsigned* bar, volatile LAS unsigned* st, unsigned w0) {
    XcdBarrier b; b.bar = bar; b.x = xb_xcc_id(); b.st = st; b.w0 = w0;
    if (w0 == 0u && xb_lane() == 0u) (void)xb_add(&bar[XB_XCNT(b.x)], 1u);
    return b;
}
__device__ __forceinline__ void xcd_barrier_complete(unsigned* bar, unsigned x, unsigned& nloc, unsigned& nx) {
    const unsigned G = gridDim.x * gridDim.y * gridDim.z;
    unsigned sum, cnt, mine, sp = 0u;
    for (;;) {
        sum = 0u; cnt = 0u; mine = 0u;
#pragma unroll
        for (unsigned j = 0; j < 16; ++j) { const unsigned c = xb_ld(&bar[XB_XCNT(j)]); sum += c; cnt += (c > 0u) ? 1u : 0u; mine = (j == x) ? c : mine; }
        if (sum == G) break;
        __builtin_amdgcn_s_sleep(1);
        if ((++sp & 255u) == 0u) { if (xb_ld(&bar[XB_TMO])) break; if (sp > XB_SPIN_CAP) { atomicAdd(&bar[XB_TMO], 1u); break; } }
    }
    nloc = mine > 0u ? mine : 1u; nx = cnt > 0u ? cnt : 1u;
}

__device__ __forceinline__ void xcd_barrier(const XcdBarrier& b) {
    asm volatile("s_waitcnt vmcnt(0)" ::: "memory");
    __syncthreads();
    if (b.w0 == 0u && xb_lane() == 0u) {
        unsigned* bar = b.bar;
        __builtin_amdgcn_s_waitcnt(0);
        unsigned nloc = b.st[0], nx = b.st[1];
        if (nloc == 0u) { xcd_barrier_complete(bar, b.x, nloc, nx); b.st[0] = nloc; b.st[1] = nx; }
        const unsigned old = xb_add(&bar[XB_XSUB(b.x)], 1u);
        const unsigned gen = old / nloc;
        if (old + 1u == (gen + 1u) * nloc) {
            __builtin_amdgcn_fence(__ATOMIC_RELEASE, "agent");
            asm volatile("s_waitcnt vmcnt(0)" ::: "memory");
            const unsigned og = xb_add(&bar[XB_TOP], 1u);
            const unsigned tg = og / nx;
            if (og + 1u == (tg + 1u) * nx) xb_add(&bar[XB_TOPGEN], 1u);
            else XB_SPIN(xb_ld(&bar[XB_TOPGEN]) == tg, bar);
            __builtin_amdgcn_fence(__ATOMIC_ACQUIRE, "agent");
            xb_add(&bar[XB_XGEN(b.x)], 1u);
            asm volatile("s_waitcnt vmcnt(0)" ::: "memory");
        } else {
            XB_SPIN(xb_ld(&bar[XB_XGEN(b.x)]) == gen, bar);
            __builtin_amdgcn_fence(__ATOMIC_ACQUIRE, "agent");
            asm volatile("s_waitcnt vmcnt(0)" ::: "memory");
        }
    }
    __syncthreads();
}

constexpr size_t MiB = 1u << 20;
constexpr size_t WS_CTL = 0, CTL_ZERO_BYTES = 1 * MiB;
constexpr int CW_BAR = 4096;
constexpr size_t WO_GU1 = 0;
constexpr size_t WO_D1  = WO_GU1 + (size_t)FF2 * KP_D;
constexpr size_t WO_IN  = WO_D1 + (size_t)D * KP_F;
constexpr size_t WO_A   = WO_IN + (size_t)NIN * KP_D;
constexpr size_t WO_B   = WO_A + (size_t)D * KP_D;
constexpr size_t WO_O   = WO_B + (size_t)D * KP_G;
constexpr size_t WO_GU2 = WO_O + (size_t)D * KP_D;
constexpr size_t WO_D2  = WO_GU2 + (size_t)FF2 * KP_D;
constexpr size_t WO_PG  = WO_D2 + (size_t)D * KP_F;
constexpr size_t WO_PP  = WO_PG + (size_t)D * KP_D;
constexpr size_t WO_WS  = WO_PP + (size_t)D * KP_E;
constexpr size_t WO_END = WO_WS + (size_t)8 * 128 * 128;
constexpr size_t WS_W   = 1 * MiB;
constexpr size_t WS_HB  = WS_W + ((WO_END * 2 + 255) / 256) * 256;
constexpr size_t WS_PB  = WS_HB + (size_t)M_TOK * LDH * 2;
constexpr size_t WS_PE  = WS_PB + (size_t)M_TOK * LDP * 2;
constexpr size_t WS_DT  = WS_PE + (size_t)M_TOK * LDE * 2;
constexpr size_t WS_SSQ = WS_DT;
constexpr size_t WS_PART = WS_DT + (size_t)M_TOK * NH * 4;
constexpr size_t WS_RS  = WS_PART + (size_t)8 * (M_TOK - M_P) * D * 4;
constexpr size_t WS_SQ  = WS_RS + (((size_t)M_TOK * 4 + 255) / 256) * 256;
constexpr size_t WS_END = WS_SQ + (size_t)32 * M_TOK * 4;

constexpr int RING_BYTES = 131072;
constexpr int LDS_BYTES = 147456;
constexpr int LDSCTL_OFF = LDS_BYTES - 256;
constexpr int NWAVES = 8, NTHREADS = 512;

constexpr size_t OUT_Y = 0;
constexpr size_t OUT_SSM_P = (size_t)M_TOK * D;
constexpr size_t OUT_CONV_P = OUT_SSM_P + (size_t)DEPTH * NB_P * NH * HD * NS;
constexpr size_t OUT_SSM_S = OUT_CONV_P + (size_t)DEPTH * NB_P * 3 * XBC;
constexpr size_t OUT_CONV_S = OUT_SSM_S + (size_t)DEPTH * NB_S * NH * HD * NS;
constexpr size_t OUT_GV = OUT_CONV_S + (size_t)DEPTH * NB_S * 3 * XBC;
constexpr size_t OUT_END = OUT_GV + (size_t)DEPTH * NB_S * L_S * GMW;

enum { I_XP = 0, I_XS, I_PP, I_PS, I_SCONV, I_SSSM, I_F1N, I_F1G, I_F1U, I_F1D, I_MIXN, I_WIN, I_CONVW, I_CONVB, I_DTB, I_ALOG, I_DSKIP, I_SSDN,
       I_GLNG, I_GLNB, I_GWS, I_GBS, I_WBA, I_WBB, I_WOUT, I_F2N, I_F2G, I_F2U, I_F2D, I_PLEN, I_PLEG, I_PLEP, I_FINN, N_IN };

struct Args { const float* in[N_IN]; float* out; unsigned char* ws; int ph_lo, ph_hi; };
#define CAS __attribute__((address_space(4)))
struct KP { const CAS char* p;
    __device__ __forceinline__ const float* in(int i) const { return *(const float* const CAS*)(p + 8 * i); }
    __device__ __forceinline__ float* out() const { return *(float* const CAS*)(p + 8 * N_IN); }
    __device__ __forceinline__ unsigned char* ws() const { return *(unsigned char* const CAS*)(p + 8 * N_IN + 8); }
    __device__ __forceinline__ int ph_lo() const { return *(const int CAS*)(p + 8 * N_IN + 16); }
    __device__ __forceinline__ int ph_hi() const { return *(const int CAS*)(p + 8 * N_IN + 20); } };
__device__ __forceinline__ KP kp_get() { KP k; k.p = (const CAS char*)__builtin_amdgcn_kernarg_segment_ptr(); asm volatile("" : "+s"(k.p)); return k; }
__device__ __forceinline__ int lane_id() { return (int)__builtin_amdgcn_mbcnt_hi(~0u, __builtin_amdgcn_mbcnt_lo(~0u, 0u)); }

__device__ __forceinline__ float wave_sum(float v) {
#pragma unroll
    for (int o = 1; o < 64; o <<= 1) v += __shfl_xor(v, o);
    return v;
}

struct RowId { __device__ __forceinline__ int operator()(int n) const { return n; } };
struct RowGU { int up; __device__ __forceinline__ int operator()(int n) const { const int pn = n >> 7, o = n & 127; return 256 * pn + 128 * ((o >> 2) & 1) + 32 * (o >> 5) + (up ? 16 : 0) + 4 * ((o >> 3) & 3) + (o & 3); } };
struct RowIn { __device__ __forceinline__ int operator()(int n) const { return n < 5120 ? n : (n < 5152 ? n - 5120 + PC_DT : n - 32); } };
template <class RM>
__device__ __forceinline__ void transpose_item(const float* W, int K, int N, bf16* WT, int ldt, RM rm, LAS float* scr, int item, int lane, const float* kg = nullptr) {
    const int nblk = N / 32, kb = item / nblk, nb = item % nblk, k0 = 64 * kb, n0 = 32 * nb;
#pragma unroll
    for (int i = 0; i < 32; ++i) { const int kk = 2 * i + (lane >> 5); scr[kk * 33 + (lane & 31)] = W[(size_t)(k0 + kk) * N + n0 + (lane & 31)]; }
    asm volatile("s_waitcnt lgkmcnt(0)" ::: "memory");
    const int c = lane & 7;
    f32x4 ga = {1.f, 1.f, 1.f, 1.f}, gb = ga;
    if (kg) { ga = *(const f32x4*)(kg + k0 + 8 * c); gb = *(const f32x4*)(kg + k0 + 8 * c + 4); }
#pragma unroll
    for (int j = 0; j < 4; ++j) { const int n = (lane >> 3) + 8 * j; const LAS float* s = scr + (8 * c) * 33 + n;
        u32x4 o; o.x = pk2(s[0 * 33] * ga[0], s[1 * 33] * ga[1]); o.y = pk2(s[2 * 33] * ga[2], s[3 * 33] * ga[3]); o.z = pk2(s[4 * 33] * gb[0], s[5 * 33] * gb[1]); o.w = pk2(s[6 * 33] * gb[2], s[7 * 33] * gb[3]);
        *(u32x4*)(WT + (size_t)rm(n0 + n) * ldt + k0 + 8 * c) = o; }
    asm volatile("s_waitcnt lgkmcnt(0)" ::: "memory");
}

template <int GRP>
__device__ __forceinline__ void convert_group(const KP a, int layer, bf16* Wb, LAS unsigned char* lds, int w, int nw, int wave, int lane) {
    LAS float* scr = (LAS float*)(lds + wave * 16384);
    constexpr int T_GU = (D / 64) * (FF / 32), T_DN = (FF / 64) * (D / 32), T_IN = (D / 64) * (INC / 32), T_SQ = (D / 64) * (D / 32), T_BB = (GMW / 64) * (D / 32), T_PP = (PLE / 64) * (D / 32);
    constexpr int NITEMS = GRP == 0 ? 2 * T_GU : GRP == 1 ? T_DN + T_IN : GRP == 2 ? 2 * T_SQ + T_BB + 2 * T_GU + T_DN : T_SQ + T_PP;
    const size_t lff = (size_t)layer * D * FF, lsq = (size_t)layer * D * D;
    for (int it = w; it < NITEMS; it += nw) {
        int r = it;
        if constexpr (GRP == 0) {
            if (r < T_GU) { transpose_item(a.in(I_F1G) + lff, D, FF, Wb + WO_GU1, KP_D, RowGU{0}, scr, r, lane, a.in(I_F1N) + layer * D); continue; } r -= T_GU;
            transpose_item(a.in(I_F1U) + lff, D, FF, Wb + WO_GU1, KP_D, RowGU{1}, scr, r, lane, a.in(I_F1N) + layer * D);
        } else if constexpr (GRP == 1) {
            if (r < T_DN) { transpose_item(a.in(I_F1D) + lff, FF, D, Wb + WO_D1, KP_F, RowId{}, scr, r, lane); continue; } r -= T_DN;
            transpose_item(a.in(I_WIN) + (size_t)layer * D * INC, D, INC, Wb + WO_IN, KP_D, RowIn{}, scr, r, lane, a.in(I_MIXN) + layer * D);
        } else if constexpr (GRP == 2) {
            if (r < T_SQ) { transpose_item(a.in(I_WBA) + lsq, DIN, D, Wb + WO_A, KP_D, RowId{}, scr, r, lane); continue; } r -= T_SQ;
            if (r < T_SQ) { transpose_item(a.in(I_WOUT) + lsq, D, D, Wb + WO_O, KP_D, RowId{}, scr, r, lane); continue; } r -= T_SQ;
            if (r < T_BB) { transpose_item(a.in(I_WBB) + (size_t)layer * GMW * D, GMW, D, Wb + WO_B, KP_G, RowId{}, scr, r, lane); continue; } r -= T_BB;
            if (r < T_GU) { transpose_item(a.in(I_F2G) + lff, D, FF, Wb + WO_GU2, KP_D, RowGU{0}, scr, r, lane, a.in(I_F2N) + layer * D); continue; } r -= T_GU;
            if (r < T_GU) { transpose_item(a.in(I_F2U) + lff, D, FF, Wb + WO_GU2, KP_D, RowGU{1}, scr, r, lane, a.in(I_F2N) + layer * D); continue; } r -= T_GU;
            transpose_item(a.in(I_F2D) + lff, FF, D, Wb + WO_D2, KP_F, RowId{}, scr, r, lane);
        } else {
            if (r < T_SQ) { transpose_item(a.in(I_PLEG) + lsq, D, D, Wb + WO_PG, KP_D, RowId{}, scr, r, lane, a.in(I_PLEN) + layer * D); continue; } r -= T_SQ;
            transpose_item(a.in(I_PLEP) + (size_t)layer * PLE * D, PLE, D, Wb + WO_PP, KP_E, RowId{}, scr, r, lane);
        }
    }
}
__device__ __forceinline__ void convert_misc(const KP a, int layer, bf16* Wb, bf16* PE, int gtid, int NGT) {
    { u32x4* z = (u32x4*)(Wb + WO_IN + (size_t)INC * KP_D); const int nz = (NIN - INC) * KP_D / 8; for (int i = gtid; i < nz; i += NGT) z[i] = (u32x4){0u, 0u, 0u, 0u}; }
    { const float* wsrc = a.in(I_GWS) + (size_t)layer * 8 * 128 * 128; bf16* wd = Wb + WO_WS;
      for (int i = gtid; i < 8 * 128 * 128 / 8; i += NGT) { const int e0 = i * 8, t = (e0 >> 7) & 127, s0 = e0 & 127; const f32x4 v0 = *(const f32x4*)(wsrc + e0), v1 = *(const f32x4*)(wsrc + e0 + 4);
          float f[8] = {v0[0], v0[1], v0[2], v0[3], v1[0], v1[1], v1[2], v1[3]};
#pragma unroll
          for (int j = 0; j < 8; ++j) if (s0 + j > t) f[j] = 0.f;
          u32x4 o; o.x = pk2(f[0], f[1]); o.y = pk2(f[2], f[3]); o.z = pk2(f[4], f[5]); o.w = pk2(f[6], f[7]); *(u32x4*)(wd + e0) = o; } }
    { const float* pp = a.in(I_PP) + (size_t)layer * M_P * PLE; const float* ps = a.in(I_PS) + (size_t)layer * (M_TOK - M_P) * PLE; const int n8 = M_TOK * PLE / 8, np8 = M_P * PLE / 8;
      for (int i = gtid; i < n8; i += NGT) { const float* s = i < np8 ? pp + (size_t)i * 8 : ps + (size_t)(i - np8) * 8; const f32x4 v0 = *(const f32x4*)s, v1 = *(const f32x4*)(s + 4);
          u32x4 o; o.x = pk2(v0[0], v0[1]); o.y = pk2(v0[2], v0[3]); o.z = pk2(v1[0], v1[1]); o.w = pk2(v1[2], v1[3]); *(u32x4*)(PE + (size_t)(i >> 5) * LDE + (i & 31) * 8) = o; } }
}
#define TAIL_CONVERT(NUNITS, ...) do { const int thr_ = (NUNITS) % G; if (bid >= thr_) { asm volatile("s_waitcnt vmcnt(0) lgkmcnt(0)" ::: "memory"); __syncthreads(); const int tw_ = (bid - thr_) * NWAVES + wave, tn_ = (G - thr_) * NWAVES; __VA_ARGS__ } } while (0)

__device__ __forceinline__ void phase_first(const float* rlo, const float* rhi, bf16* XB, float* RS, int gw, int NGW, int lane) {
    for (int r = gw; r < M_TOK; r += NGW) {
        f32x4 v0[4], v1[4];
        const float* xr = (r < M_P ? rlo + (size_t)r * D : rhi + (size_t)(r - M_P) * D) + 8 * lane;
#pragma unroll
        for (int j = 0; j < 4; ++j) { v0[j] = *(const f32x4*)(xr + 512 * j); v1[j] = *(const f32x4*)(xr + 512 * j + 4); }
        float ss = 0.f;
#pragma unroll
        for (int j = 0; j < 4; ++j) ss += ssq8(v0[j], v1[j]);
        bf16* xo = XB + (size_t)r * XBP + 8 * lane;
#pragma unroll
        for (int j = 0; j < 4; ++j) *(u32x4*)(xo + 512 * j) = pack8u(v0[j], v1[j]);
        ss = wave_sum(ss);
        if (lane == 0) RS[r] = rsqrtf(ss * (1.f / D) + EPS);
    }
}
template <bool FOLD>
__device__ __forceinline__ void phase_rstd(const float* SSQ, float* RS, const float* part, bf16* XB, int gw, int NGW, int lane, int gtid, int NGT) {
    constexpr int NRED = FOLD ? M_P : M_TOK;
    for (int t = gtid; t < NRED * 4; t += NGT) { const int r = t >> 2, q = t & 3; float s = 0.f;
#pragma unroll
        for (int j = 0; j < 8; ++j) s += SSQ[(size_t)(q * 8 + j) * M_TOK + r];
        s += __shfl_xor(s, 1); s += __shfl_xor(s, 2);
        if (q == 0) RS[r] = rsqrtf(s * (1.f / D) + EPS); }
    if (FOLD) for (int r = M_P + (NGW - 1 - gw); r < M_TOK; r += NGW) {
        f32x4 v0[4], v1[4];
        bf16* xo = XB + (size_t)r * XBP + 8 * lane;
#pragma unroll
        for (int j = 0; j < 4; ++j) unpack8(*(const u32x4*)(xo + 512 * j), v0[j], v1[j]);
#pragma unroll 1
        for (int sb = 0; sb < 8; sb += 4) {
            f32x4 t0[4][4], t1[4][4];
#pragma unroll
            for (int s = 0; s < 4; ++s) { const float* pr = part + ((size_t)(sb + s) * (M_TOK - M_P) + (size_t)(r - M_P)) * D + 8 * lane;
#pragma unroll
                for (int j = 0; j < 4; ++j) { t0[s][j] = *(const f32x4*)(pr + 512 * j); t1[s][j] = *(const f32x4*)(pr + 512 * j + 4); } }
#pragma unroll
            for (int s = 0; s < 4; ++s)
#pragma unroll
                for (int j = 0; j < 4; ++j) { v0[j] = v0[j] + t0[s][j]; v1[j] = v1[j] + t1[s][j]; } }
        float ss = 0.f;
#pragma unroll
        for (int j = 0; j < 4; ++j) { ss += ssq8(v0[j], v1[j]); *(u32x4*)(xo + 512 * j) = pack8u(v0[j], v1[j]); }
        ss = wave_sum(ss);
        if (lane == 0) RS[r] = rsqrtf(ss * (1.f / D) + EPS);
    }
}
__device__ __forceinline__ void phase_final_norm(const bf16* XB, float* Y, const float* gain, int gw, int NGW, int lane) {
    for (int r = gw; r < M_TOK; r += NGW) {
        const bf16* xr = XB + (size_t)r * XBP + 8 * lane;
        f32x4 v0[4], v1[4]; float ss = 0.f;
#pragma unroll
        for (int j = 0; j < 4; ++j) unpack8(*(const u32x4*)(xr + 512 * j), v0[j], v1[j]);
#pragma unroll
        for (int j = 0; j < 4; ++j) ss += ssq8(v0[j], v1[j]);
        const float rstd = rsqrtf(wave_sum(ss) * (1.f / D) + EPS);
        float* yo = Y + (size_t)r * D + 8 * lane;
#pragma unroll
        for (int j = 0; j < 4; ++j) { const f32x4 g0 = *(const f32x4*)(gain + 8 * lane + 512 * j), g1 = *(const f32x4*)(gain + 8 * lane + 512 * j + 4); __builtin_nontemporal_store(v0[j] * rstd * g0, (f32x4*)(yo + 512 * j)); __builtin_nontemporal_store(v1[j] * rstd * g1, (f32x4*)(yo + 512 * j + 4)); }
    }
}

__device__ __forceinline__ size_t seq_row0(int sq) { return sq < NB_P ? (size_t)sq * SEQ : (size_t)M_P + (size_t)(sq - NB_P) * L_S; }


typedef pg8::bf16x8 bf16x8;
constexpr int SC = 8, NSC = SEQ / (64 * SC), NSC1 = NSC - 1;
constexpr int XS_LD = 72, TM_LD = 136;
constexpr int SL_XST = 0;
constexpr int SL_BMT = SL_XST + 512 * XS_LD * 2;
constexpr int SL_BM  = SL_BMT + 128 * XS_LD * 2;
constexpr int SL_CM  = SL_BM + 64 * TM_LD * 2;
constexpr int SL_CUM = SL_CM + 64 * TM_LD * 2;
constexpr int SL_DTV = SL_CUM + 2048;
constexpr int SL_WV  = SL_DTV + 2048;
constexpr int SL_SSQ = SL_WV + 2048;
constexpr int SL_GN  = SL_SSQ + 2048;
constexpr int SL_END = SL_GN + 2048;
static_assert(SL_END <= LDSCTL_OFF, "SSD LDS map");
constexpr size_t ST_ELEMS = 128 * 64;
constexpr size_t WSO_ST = 0, WSO_DTOT = (size_t)NB_P * NSC1 * NH * ST_ELEMS * 4;
static_assert(WSO_DTOT + (size_t)NB_P * NSC1 * NH * 4 <= (size_t)128 * MiB, "SSD states fit the first 128 MiB of the y region of d_out");
constexpr size_t WSO_XT = (size_t)128 * MiB;
static_assert(WSO_XT + (size_t)M_TOK * XBP * 2 <= (size_t)M_TOK * D * 4, "second stream buffer fits the y region");

__device__ __forceinline__ bf16x8 ld_pair8(const LAS unsigned char* p0, const LAS unsigned char* p1) {
    const u32x2 a = *(const LAS u32x2*)p0, b = *(const LAS u32x2*)p1; const u32x4 w = {a.x, a.y, b.x, b.y}; return __builtin_bit_cast(bf16x8, w); }
__device__ __forceinline__ bf16x8 pack8(const f32x4 lo, const f32x4 hi) { const u32x4 w = {pk2(lo[0], lo[1]), pk2(lo[2], lo[3]), pk2(hi[0], hi[1]), pk2(hi[2], hi[3])}; return __builtin_bit_cast(bf16x8, w); }
#define MFMA16(a, b, c) __builtin_amdgcn_mfma_f32_16x16x32_bf16((a), (b), (c), 0, 0, 0)
__device__ __forceinline__ void lds_barrier() { asm volatile("s_waitcnt lgkmcnt(0)" ::: "memory"); __builtin_amdgcn_s_barrier(); asm volatile("" ::: "memory"); }

__device__ __forceinline__ int xperm(int n2) { const int c = n2 & 63; return (n2 & ~63) | ((c >> 5) << 5) | (((c >> 2) & 1) << 4) | (((c >> 3) & 3) << 2) | (c & 3); }
__device__ __forceinline__ int xphys(int pb, int i) { return 32 * (pb >> 1) + 8 * (i >> 2) + 4 * (pb & 1) + (i & 3); }
template <bool FULL>
__device__ __forceinline__ void ssd_stage(const KP a, int layer, const bf16* rowp, int hist, const float* cst, float* tail_out, int g, LAS unsigned char* lds, int tid) {
    constexpr int NPAIR = FULL ? 384 : 320, NT = (NPAIR * 4 + NTHREADS - 1) / NTHREADS;
    static_assert(NPAIR % 64 == 0, "a wave's 64 tasks share the token block and the channel kind");
    const int wv = __builtin_amdgcn_readfirstlane(tid >> 6), ln = tid & 63;
    const float* cw = a.in(I_CONVW) + (size_t)layer * 4 * XBC; const float* cb = a.in(I_CONVB) + (size_t)layer * XBC;
    unsigned rr[NT][19];
#pragma unroll
    for (int i = 0; i < NT; ++i) {
        const int tw = wv * 64 + i * NTHREADS;
        const int tq = tw / NPAIR, pw = tw - tq * NPAIR, s0 = 16 * tq;
        const int chw = pw < 256 ? g * 512 + 2 * pw : (pw < 320 ? DIN + g * 128 + 2 * (pw - 256) : DIN + 512 + g * 128 + 2 * (pw - 320));
        if (tw < NPAIR * 4) {
            const bf16* pb = rowp + PC_XBC + chw + 2 * ln;
#pragma unroll
            for (int j = 0; j < 19; ++j) {
                const int s = s0 + j - 3;
                if (j >= 3 || s >= 0 || hist == 1) rr[i][j] = *(const unsigned*)(pb + (long)s * LDP);
                else if (hist == 2) { const f32x2 v = *(const f32x2*)(cst + (size_t)(s + 3) * XBC + chw + 2 * ln); rr[i][j] = pk2(v[0], v[1]); }
                else rr[i][j] = 0u;
            }
        } else {
#pragma unroll
            for (int j = 0; j < 19; ++j) rr[i][j] = 0u;
        }
    }
#pragma unroll
    for (int i = 0; i < NT; ++i) {
        const int tw = wv * 64 + i * NTHREADS; if (tw >= NPAIR * 4) break;
        const int tq = tw / NPAIR, pw = tw - tq * NPAIR, s0 = 16 * tq;
        const int kind = pw < 256 ? 0 : (pw < 320 ? 1 : 2);
        const int n2 = 2 * (pw - (kind == 0 ? 0 : (kind == 1 ? 256 : 320))) + 2 * ln;
        const int ch = (kind == 0 ? g * 512 : (kind == 1 ? DIN + g * 128 : DIN + 512 + g * 128)) + n2;
        float w0[4], w1[4];
#pragma unroll
        for (int k = 0; k < 4; ++k) { const f32x2 wv2 = *(const f32x2*)(cw + (size_t)k * XBC + ch); w0[k] = wv2[0]; w1[k] = wv2[1]; }
        const f32x2 bv = *(const f32x2*)(cb + ch);
        if (tail_out && tq == 3) {
#pragma unroll
            for (int k = 0; k < 3; ++k) *(f32x2*)(tail_out + (size_t)k * XBC + ch) = (f32x2){bflo(rr[i][16 + k]), bfhi(rr[i][16 + k])}; }
        unsigned q0[8], q1[8];
        LAS unsigned char* dtm = lds + (kind == 1 ? SL_BM : SL_CM) + s0 * (TM_LD * 2) + n2 * 2;
#pragma unroll
        for (int e = 0; e < 8; ++e) { float oa[2], ob[2];
#pragma unroll
            for (int u = 0; u < 2; ++u) { const int j = 2 * e + u;
                const float c0 = bv[0] + w0[0] * bflo(rr[i][j]) + w0[1] * bflo(rr[i][j + 1]) + w0[2] * bflo(rr[i][j + 2]) + w0[3] * bflo(rr[i][j + 3]), c1 = bv[1] + w1[0] * bfhi(rr[i][j]) + w1[1] * bfhi(rr[i][j + 1]) + w1[2] * bfhi(rr[i][j + 2]) + w1[3] * bfhi(rr[i][j + 3]);
                oa[u] = fast_silu(c0); ob[u] = fast_silu(c1);
                if (FULL && kind >= 1) *(LAS unsigned*)(dtm + j * (TM_LD * 2)) = pk2(oa[u], ob[u]); }
            q0[e] = pk2(oa[0], oa[1]); q1[e] = pk2(ob[0], ob[1]); }
        if (kind <= 1) {
            LAS unsigned char* d = lds + (kind == 0 ? SL_XST : SL_BMT) + n2 * (XS_LD * 2) + s0 * 2;
            *(LAS u32x4*)d = (u32x4){q0[0], q0[1], q0[2], q0[3]}; *(LAS u32x4*)(d + 16) = (u32x4){q0[4], q0[5], q0[6], q0[7]};
            *(LAS u32x4*)(d + XS_LD * 2) = (u32x4){q1[0], q1[1], q1[2], q1[3]}; *(LAS u32x4*)(d + XS_LD * 2 + 16) = (u32x4){q1[4], q1[5], q1[6], q1[7]};
        }
    }
}
__device__ __forceinline__ float ssd_cum(float dtv, float av, LAS unsigned char* lds, int wave, int lane) {
    float c = dtv * av;
#pragma unroll
    for (int o = 1; o < 64; o <<= 1) { const float t = __shfl_up(c, o); if (lane >= o) c += t; }
    const float c63 = __shfl(c, 63);
    ((LAS float*)(lds + SL_CUM))[wave * 64 + lane] = c; ((LAS float*)(lds + SL_DTV))[wave * 64 + lane] = dtv; ((LAS float*)(lds + SL_WV))[wave * 64 + lane] = __expf(c63 - c) * dtv;
    return c63;
}
__device__ __forceinline__ void ssd_state_update(f32x4 (&H)[8][4], float c63, const LAS unsigned char* lds, int wave, int lr, int q) {
    const float dec = __expf(c63);
#pragma unroll
    for (int nb = 0; nb < 8; ++nb)
#pragma unroll
        for (int pb = 0; pb < 4; ++pb) H[nb][pb] = H[nb][pb] * dec;
    const LAS float* wv = (const LAS float*)(lds + SL_WV) + wave * 64;
#pragma unroll
    for (int i = 0; i < 2; ++i) {
        const f32x4 wa = *(const LAS f32x4*)(wv + 32 * i + 4 * q), wb = *(const LAS f32x4*)(wv + 32 * i + 16 + 4 * q);
        bf16x8 xw[4];
#pragma unroll
        for (int pb = 0; pb < 4; ++pb) { const LAS unsigned char* xr = lds + SL_XST + (wave * 64 + xphys(pb, lr)) * (XS_LD * 2) + (32 * i + 4 * q) * 2;
            const u32x2 ua = *(const LAS u32x2*)xr, ub = *(const LAS u32x2*)(xr + 32);
            const f32x4 lo = {bflo(ua.x) * wa[0], bfhi(ua.x) * wa[1], bflo(ua.y) * wa[2], bfhi(ua.y) * wa[3]}, hi = {bflo(ub.x) * wb[0], bfhi(ub.x) * wb[1], bflo(ub.y) * wb[2], bfhi(ub.y) * wb[3]};
            xw[pb] = pack8(lo, hi); }
#pragma unroll
        for (int nb = 0; nb < 8; ++nb) { const LAS unsigned char* br = lds + SL_BMT + (16 * nb + lr) * (XS_LD * 2) + (32 * i + 4 * q) * 2; const bf16x8 bfA = ld_pair8(br, br + 32);
#pragma unroll
            for (int pb = 0; pb < 4; ++pb) H[nb][pb] = MFMA16(bfA, xw[pb], H[nb][pb]); }
        __builtin_amdgcn_sched_barrier(0);
    }
}
__device__ __forceinline__ void ssd_state_load(f32x4 (&H)[8][4], const float* st, int lane) {
#pragma unroll
    for (int nb = 0; nb < 8; ++nb)
#pragma unroll
        for (int pb = 0; pb < 4; ++pb)
#pragma unroll
            for (int r = 0; r < 4; ++r) H[nb][pb][r] = st[(size_t)(((nb * 4 + pb) * 4 + r) * 64 + lane)];
}
__device__ __forceinline__ void ssd_state_store(const f32x4 (&H)[8][4], float* st, int lane) {
#pragma unroll
    for (int nb = 0; nb < 8; ++nb)
#pragma unroll
        for (int pb = 0; pb < 4; ++pb)
#pragma unroll
            for (int r = 0; r < 4; ++r) st[(size_t)(((nb * 4 + pb) * 4 + r) * 64 + lane)] = H[nb][pb][r];
}

__device__ __forceinline__ void ssd1_item(const KP a, int layer, int b, int k, int g, const bf16* PB, const float* DT, unsigned char* hbreg, LAS unsigned char* lds, int tid, int wave, int lane) {
    const int h = g * 8 + wave; (void)tid;
    const float av = -__expf(a.in(I_ALOG)[layer * NH + h]);
    f32x4 H[8][4];
#pragma unroll
    for (int nb = 0; nb < 8; ++nb)
#pragma unroll
        for (int pb = 0; pb < 4; ++pb) H[nb][pb] = (f32x4){0.f, 0.f, 0.f, 0.f};
    float dsum = 0.f;
    float dtn = DT[((size_t)b * SEQ + (size_t)(k * SC) * 64 + lane) * NH + h];
#pragma unroll 1
    for (int c = 0; c < SC; ++c) {
        int ln = lane; asm volatile("" : "+v"(ln));
        const int lr = ln & 15, q = ln >> 4;
        const size_t rowc = (size_t)b * SEQ + (size_t)(k * SC + c) * 64;
        const float dtc = dtn; if (c + 1 < SC) dtn = DT[(rowc + 64 + ln) * NH + h];
        ssd_stage<false>(a, layer, PB + rowc * LDP, (k == 0 && c == 0) ? 0 : 1, nullptr, nullptr, g, lds, wave * 64 + ln);
        const float c63 = ssd_cum(dtc, av, lds, wave, ln);
        dsum += c63;
        lds_barrier();
        ssd_state_update(H, c63, lds, wave, lr, q);
        lds_barrier();
    }
    const size_t si = ((size_t)b * NSC1 + k) * NH + h;
    { int ln = lane; asm volatile("" : "+v"(ln));
      ssd_state_store(H, (float*)(hbreg + WSO_ST) + si * ST_ELEMS, ln);
      if (ln == 0) ((float*)(hbreg + WSO_DTOT))[si] = __expf(dsum); }
}
__device__ __forceinline__ void ssd2_phase(unsigned char* hbreg, int gw, int NGW, int lane) {
    for (int it = gw; it < NB_P * NH * 32; it += NGW) {
        const int bh = it >> 5, part = it & 31, b = bh / NH, h = bh % NH;
        float* s0 = (float*)(hbreg + WSO_ST) + (((size_t)b * NSC1) * NH + h) * ST_ELEMS + (size_t)part * 4 * 64 + lane; const float* d0 = (const float*)(hbreg + WSO_DTOT) + ((size_t)b * NSC1) * NH + h;
        float sv[NSC1][4], dk[NSC1];
#pragma unroll
        for (int k = 0; k < NSC1; ++k) { dk[k] = d0[(size_t)k * NH];
#pragma unroll
            for (int j = 0; j < 4; ++j) sv[k][j] = s0[(size_t)k * NH * ST_ELEMS + j * 64]; }
        float run[4] = {0.f, 0.f, 0.f, 0.f};
#pragma unroll
        for (int k = 0; k < NSC1; ++k)
#pragma unroll
            for (int j = 0; j < 4; ++j) { run[j] = run[j] * dk[k] + sv[k][j]; s0[(size_t)k * NH * ST_ELEMS + j * 64] = run[j]; }
    }
}
__device__ __forceinline__ void ssd3_item(const KP a, int layer, size_t row0, int nchunk, int g, const float* st_init  , const float* sinit  ,
                                          int hist0, const float* cst, float* ssm_out  , float* conv_out  ,
                                          bf16* PB, const float* DT, LAS unsigned char* lds, int tid, int wave, int lane, bf16* dry = nullptr) {
    const int h = g * 8 + wave; (void)tid;
#ifdef S3_DRY_SKIP
    const int skip = dry ? S3_DRY_SKIP : 0; if (dry) { ssm_out = nullptr; conv_out = nullptr; }
#else
    constexpr int skip = 0;
#endif
    const float av = -__expf(a.in(I_ALOG)[layer * NH + h]), Dk = a.in(I_DSKIP)[layer * NH + h];
    f32x4 H[8][4];
    { const int lr = lane & 15, q = lane >> 4;
    if (st_init) ssd_state_load(H, st_init + (size_t)h * ST_ELEMS, lane);
    else if (sinit) {
#pragma unroll
        for (int nb = 0; nb < 8; ++nb)
#pragma unroll
            for (int pb = 0; pb < 4; ++pb) H[nb][pb] = *(const f32x4*)(sinit + ((size_t)h * HD + xphys(pb, lr)) * NS + 16 * nb + 4 * q);
    } else {
#pragma unroll
        for (int nb = 0; nb < 8; ++nb)
#pragma unroll
            for (int pb = 0; pb < 4; ++pb) H[nb][pb] = (f32x4){0.f, 0.f, 0.f, 0.f};
    } }
    ((LAS float*)(lds + SL_GN))[wave * 64 + lane] = a.in(I_SSDN)[(size_t)layer * DIN + h * 64 + lane];
    float dtn = DT[(row0 + lane) * NH + h];
#pragma unroll 1
    for (int c = 0; c < nchunk; ++c) {
        const size_t rowc = row0 + (size_t)c * 64;
        const float dtc = dtn; if (c + 1 < nchunk) dtn = DT[(rowc + 64 + lane) * NH + h];
        if (!(skip & 1)) { int ln = lane; asm volatile("" : "+v"(ln));
          ssd_stage<true>(a, layer, PB + rowc * LDP, c == 0 ? hist0 : 1, cst, (c == nchunk - 1) ? conv_out : nullptr, g, lds, wave * 64 + ln); }
        float c63; { int ln = lane; asm volatile("" : "+v"(ln)); c63 = ssd_cum(dtc, av, lds, wave, ln); }
        lds_barrier();
        const LAS float* cumv = (const LAS float*)(lds + SL_CUM) + wave * 64; const LAS float* dtv = (const LAS float*)(lds + SL_DTV) + wave * 64;
#pragma unroll 1
        for (int th = (skip & 2) ? 2 : 0; th < 2; ++th) {
            int ln = lane; asm volatile("" : "+v"(ln)); const int lr = ln & 15, q = ln >> 4;
            u32x4 zpre[2][2];
#pragma unroll
            for (int tbi = 0; tbi < 2; ++tbi) { const bf16* zr = PB + (rowc + 16 * (2 * th + tbi) + lr) * LDP + PC_Z + h * 64 + 8 * q;
#pragma unroll
                for (int m = 0; m < 2; ++m) zpre[tbi][m] = (skip & 8) ? (u32x4){0x3f803f80u, 0x3f803f80u, 0x3f803f80u, 0x3f803f80u} : *(const u32x4*)(zr + 32 * m); }
            f32x4 cbt[4][2];
#pragma unroll
            for (int sb = 0; sb < 4; ++sb) { cbt[sb][0] = (f32x4){0.f, 0.f, 0.f, 0.f}; cbt[sb][1] = (f32x4){0.f, 0.f, 0.f, 0.f}; }
#pragma unroll
            for (int kk = 0; kk < 4; ++kk) {
                bf16x8 cf[2];
#pragma unroll
                for (int tbi = 0; tbi < 2; ++tbi) cf[tbi] = *(const LAS bf16x8*)(lds + SL_CM + (16 * (2 * th + tbi) + lr) * (TM_LD * 2) + (32 * kk + 8 * q) * 2);
#pragma unroll
                for (int sb = 0; sb < 4; ++sb) { const bf16x8 bfA = *(const LAS bf16x8*)(lds + SL_BM + (16 * sb + lr) * (TM_LD * 2) + (32 * kk + 8 * q) * 2);
                    cbt[sb][0] = MFMA16(bfA, cf[0], cbt[sb][0]); cbt[sb][1] = MFMA16(bfA, cf[1], cbt[sb][1]); }
                __builtin_amdgcn_sched_barrier(0);
            }
            float ct[2]; ct[0] = cumv[16 * (2 * th) + lr]; ct[1] = cumv[16 * (2 * th + 1) + lr];
            bf16x8 mf[2][2];
#pragma unroll
            for (int sb = 0; sb < 4; ++sb) { const f32x4 cs = *(const LAS f32x4*)(cumv + 16 * sb + 4 * q), ds = *(const LAS f32x4*)(dtv + 16 * sb + 4 * q);
#pragma unroll
                for (int tbi = 0; tbi < 2; ++tbi) { const int t = 16 * (2 * th + tbi) + lr;
#pragma unroll
                    for (int r = 0; r < 4; ++r) { const int s = 16 * sb + 4 * q + r; const float f = (s <= t) ? __expf(ct[tbi] - cs[r]) * ds[r] : 0.f; cbt[sb][tbi][r] = cbt[sb][tbi][r] * f + ((s == t) ? Dk : 0.f); } } }
#pragma unroll
            for (int i = 0; i < 2; ++i) { mf[i][0] = pack8(cbt[2 * i][0], cbt[2 * i + 1][0]); mf[i][1] = pack8(cbt[2 * i][1], cbt[2 * i + 1][1]); }
            __builtin_amdgcn_sched_barrier(0);
            f32x4 y[4][2];
#pragma unroll
            for (int pb = 0; pb < 4; ++pb) { y[pb][0] = (f32x4){0.f, 0.f, 0.f, 0.f}; y[pb][1] = (f32x4){0.f, 0.f, 0.f, 0.f}; }
#pragma unroll
            for (int kk = 0; kk < 4; ++kk) {
                bf16x8 cf[2];
#pragma unroll
                for (int tbi = 0; tbi < 2; ++tbi) { const LAS unsigned char* cr = lds + SL_CM + (16 * (2 * th + tbi) + lr) * (TM_LD * 2) + (32 * kk + 4 * q) * 2; cf[tbi] = ld_pair8(cr, cr + 32); }
#pragma unroll
                for (int pb = 0; pb < 4; ++pb) { asm volatile("" : "+v"(H[2 * kk][pb]), "+v"(H[2 * kk + 1][pb]));
                    const bf16x8 hf = pack8(H[2 * kk][pb], H[2 * kk + 1][pb]); y[pb][0] = MFMA16(hf, cf[0], y[pb][0]); y[pb][1] = MFMA16(hf, cf[1], y[pb][1]); }
                __builtin_amdgcn_sched_barrier(0);
            }
            { const float e0 = __expf(ct[0]), e1 = __expf(ct[1]);
#pragma unroll
              for (int pb = 0; pb < 4; ++pb) { y[pb][0] = y[pb][0] * e0; y[pb][1] = y[pb][1] * e1; } }
#pragma unroll
            for (int i = 0; i < 2; ++i)
#pragma unroll
                for (int pb = 0; pb < 4; ++pb) { const LAS unsigned char* xr = lds + SL_XST + (wave * 64 + xphys(pb, lr)) * (XS_LD * 2) + (32 * i + 4 * q) * 2; const bf16x8 xf = ld_pair8(xr, xr + 32);
                    y[pb][0] = MFMA16(xf, mf[i][0], y[pb][0]); y[pb][1] = MFMA16(xf, mf[i][1], y[pb][1]); }
            __builtin_amdgcn_sched_barrier(0);
            float ssq[2] = {0.f, 0.f};
#pragma unroll
            for (int tbi = 0; tbi < 2; ++tbi)
#pragma unroll
                for (int pb = 0; pb < 4; ++pb) { const u32x4 z4 = zpre[tbi][pb >> 1]; const unsigned zx = (pb & 1) ? z4.z : z4.x, zy = (pb & 1) ? z4.w : z4.y; const float zf[4] = {bflo(zx), bfhi(zx), bflo(zy), bfhi(zy)};
#pragma unroll
                    for (int r = 0; r < 4; ++r) { const float v = y[pb][tbi][r] * zf[r]; y[pb][tbi][r] = v; ssq[tbi] += v * v; } }
#pragma unroll
            for (int tbi = 0; tbi < 2; ++tbi) { float s = ssq[tbi]; s += __shfl_xor(s, 16); s += __shfl_xor(s, 32); if (q == 0) ((LAS float*)(lds + SL_SSQ))[(th * 32 + 16 * tbi + lr) * 8 + wave] = s; }
            lds_barrier();
#pragma unroll
            for (int tbi = 0; tbi < 2; ++tbi) { const int t = 16 * (2 * th + tbi) + lr; const LAS f32x4* sp = (const LAS f32x4*)((LAS float*)(lds + SL_SSQ) + (th * 32 + 16 * tbi + lr) * 8);
                const f32x4 s0 = sp[0], s1 = sp[1]; const float rstd = rsqrtf(((s0[0] + s0[1]) + (s0[2] + s0[3]) + (s1[0] + s1[1]) + (s1[2] + s1[3])) * (1.f / 512.f) + EPS);
                bf16* zr = dry ? dry + ((rowc + t) & 8191) * 2048 + h * 64 + 8 * q : PB + (rowc + t) * LDP + PC_Z + h * 64 + 8 * q;
#pragma unroll
                for (int m = 0; m < 2; ++m) { const LAS f32x4* gp = (const LAS f32x4*)((const LAS float*)(lds + SL_GN) + wave * 64 + 32 * m + 8 * q); const f32x4 ga = gp[0], gb = gp[1];
                    const f32x4 va = y[2 * m][tbi], vb = y[2 * m + 1][tbi];
                    u32x4 o; o.x = pk2(va[0] * rstd * ga[0], va[1] * rstd * ga[1]); o.y = pk2(va[2] * rstd * ga[2], va[3] * rstd * ga[3]); o.z = pk2(vb[0] * rstd * gb[0], vb[1] * rstd * gb[1]); o.w = pk2(vb[2] * rstd * gb[2], vb[3] * rstd * gb[3]);
                    if (!(skip & 16)) *(u32x4*)(zr + 32 * m) = o; else asm volatile("" :: "v"(o.x), "v"(o.y), "v"(o.z), "v"(o.w)); } }
        }
        if (!(skip & 4)) { int ln = lane; asm volatile("" : "+v"(ln)); ssd_state_update(H, c63, lds, wave, ln & 15, ln >> 4); }
        lds_barrier();
    }
    if (ssm_out) { int ln = lane; asm volatile("" : "+v"(ln)); const int lr = ln & 15, q = ln >> 4;
#pragma unroll
        for (int nb = 0; nb < 8; ++nb)
#pragma unroll
            for (int pb = 0; pb < 4; ++pb) *(f32x4*)(ssm_out + ((size_t)h * HD + xphys(pb, lr)) * NS + 16 * nb + 4 * q) = H[nb][pb];
    }
}

constexpr int GV_LD = 136;
constexpr int GL_MU = 0, GL_RS = 512, GL_VT = 1024, GL_VT_BYTES = 128 * GV_LD * 2;
static_assert(GL_VT + 2 * GL_VT_BYTES <= LDSCTL_OFF, "gMLP LDS map");

template <int T>
__device__ __forceinline__ void gmlp_stage(const KP a, int layer, const bf16* P0  , int g, float* vout  , LAS unsigned char* lds, int buf, int tid) {
    const LAS float* mu = (const LAS float*)(lds + GL_MU); const LAS float* rs = (const LAS float*)(lds + GL_RS);
#pragma unroll 1
    for (int task = tid; task < 64 * (T / 16); task += NTHREADS) {
        const int tq = task >> 6, pi = task & 63, s0 = 16 * tq, c2 = 2 * pi, cg = g * 128 + c2;
        const f32x2 gg = *(const f32x2*)(a.in(I_GLNG) + (size_t)layer * GMW + cg), gb = *(const f32x2*)(a.in(I_GLNB) + (size_t)layer * GMW + cg);
        unsigned rr[16];
#pragma unroll
        for (int j = 0; j < 16; ++j) rr[j] = *(const unsigned*)(P0 + (size_t)(s0 + j) * LDP + PC_V + cg);
        unsigned q0[8], q1[8];
#pragma unroll
        for (int e = 0; e < 8; ++e) { float oa[2], ob[2];
#pragma unroll
            for (int u = 0; u < 2; ++u) { const int j = 2 * e + u; const float m = mu[s0 + j], r = rs[s0 + j];
                oa[u] = (bflo(rr[j]) - m) * r * gg[0] + gb[0]; ob[u] = (bfhi(rr[j]) - m) * r * gg[1] + gb[1];
                if (vout) *(f32x2*)(vout + (size_t)(s0 + j) * GMW + cg) = (f32x2){oa[u], ob[u]}; }
            q0[e] = pk2(oa[0], oa[1]); q1[e] = pk2(ob[0], ob[1]); }
        LAS unsigned char* d = lds + GL_VT + buf * GL_VT_BYTES + c2 * (GV_LD * 2) + s0 * 2;
        *(LAS u32x4*)d = (u32x4){q0[0], q0[1], q0[2], q0[3]}; *(LAS u32x4*)(d + 16) = (u32x4){q0[4], q0[5], q0[6], q0[7]};
        *(LAS u32x4*)(d + GV_LD * 2) = (u32x4){q1[0], q1[1], q1[2], q1[3]}; *(LAS u32x4*)(d + GV_LD * 2 + 16) = (u32x4){q1[4], q1[5], q1[6], q1[7]};
    }
}
template <int T>
__device__ __forceinline__ void gmlp_item(const KP a, int layer, size_t r0  , float* vout, bf16* PB, const bf16* Wsb  , LAS unsigned char* lds, int tid, int wave, int lane, bf16* dry = nullptr) {
    constexpr int NTB = T / 16;
    bf16* P0 = PB + r0 * LDP;
    { LAS float* mu = (LAS float*)(lds + GL_MU); LAS float* rs = (LAS float*)(lds + GL_RS);
#pragma unroll 1
      for (int t0 = wave * (T / 8); t0 < (wave + 1) * (T / 8); t0 += 8) {
          u32x4 qa[8], qb[8];
#pragma unroll
          for (int i = 0; i < 8; ++i) { const bf16* vr = P0 + (size_t)(t0 + i) * LDP + PC_V + lane * 16; qa[i] = *(const u32x4*)vr; qb[i] = *(const u32x4*)(vr + 8); }
#pragma unroll
          for (int i = 0; i < 8; ++i) {
              const float f[16] = { bflo(qa[i].x), bfhi(qa[i].x), bflo(qa[i].y), bfhi(qa[i].y), bflo(qa[i].z), bfhi(qa[i].z), bflo(qa[i].w), bfhi(qa[i].w), bflo(qb[i].x), bfhi(qb[i].x), bflo(qb[i].y), bfhi(qb[i].y), bflo(qb[i].z), bfhi(qb[i].z), bflo(qb[i].w), bfhi(qb[i].w) };
              float s = 0.f;
#pragma unroll
              for (int j = 0; j < 16; ++j) s += f[j];
              const float mean = wave_sum(s) * (1.f / GMW); float qq = 0.f;
#pragma unroll
              for (int j = 0; j < 16; ++j) { const float d = f[j] - mean; qq += d * d; }
              const float var = wave_sum(qq) * (1.f / GMW);
              if (lane == 0) { mu[t0 + i] = mean; rs[t0 + i] = rsqrtf(var + EPS); } }
      } }
    lds_barrier();
    gmlp_stage<T>(a, layer, P0, 0, vout, lds, 0, tid);
    lds_barrier();
#pragma unroll 1
    for (int g = 0; g < 8; ++g) {
        int ln = lane; asm volatile("" : "+v"(ln)); const int lr = ln & 15, q = ln >> 4;
        if (g + 1 < 8) gmlp_stage<T>(a, layer, P0, g + 1, vout, lds, (g + 1) & 1, wave * 64 + ln);
        const LAS unsigned char* vt = lds + GL_VT + (g & 1) * GL_VT_BYTES + (16 * wave + lr) * (GV_LD * 2);
        bf16x8 af[T / 32];
#pragma unroll
        for (int kk = 0; kk < T / 32; ++kk) af[kk] = *(const LAS bf16x8*)(vt + (32 * kk + 8 * q) * 2);
        const bf16* wg = Wsb + (size_t)g * 128 * 128;
        bf16x8 wf[NTB][T / 32]; float bsv[NTB]; u32x2 uu[NTB];
#pragma unroll
        for (int tb = 0; tb < NTB; ++tb) {
#pragma unroll
            for (int kk = 0; kk <= tb / 2; ++kk) wf[tb][kk] = *(const bf16x8*)(wg + (size_t)(16 * tb + lr) * 128 + 32 * kk + 8 * q);
            bsv[tb] = a.in(I_GBS)[(size_t)(layer * 8 + g) * 128 + 16 * tb + lr];
            uu[tb] = *(const u32x2*)(P0 + (size_t)(16 * tb + lr) * LDP + PC_U + g * 128 + 16 * wave + 4 * q); }
#pragma unroll
        for (int tb = 0; tb < NTB; ++tb) {
            f32x4 acc = {0.f, 0.f, 0.f, 0.f};
#pragma unroll
            for (int kk = 0; kk <= tb / 2; ++kk) acc = MFMA16(af[kk], wf[tb][kk], acc);
            bf16* up = dry ? dry + ((r0 + 16 * tb + lr) & 8191) * 2048 + g * 128 + 16 * wave + 4 * q : P0 + (size_t)(16 * tb + lr) * LDP + PC_U + g * 128 + 16 * wave + 4 * q;
            u32x2 o; o.x = pk2(bflo(uu[tb].x) * (acc[0] + bsv[tb]), bfhi(uu[tb].x) * (acc[1] + bsv[tb])); o.y = pk2(bflo(uu[tb].y) * (acc[2] + bsv[tb]), bfhi(uu[tb].y) * (acc[3] + bsv[tb])); *(u32x2*)up = o;
        }
        lds_barrier();
    }
}

static_assert(GL_VT + 4 * GL_VT_BYTES <= LDSCTL_OFF, "gMLP decode LDS map");
__device__ __forceinline__ void gmlp_stage_dec(const KP a, int layer, const bf16* P0, int g, float* vout, LAS unsigned char* lds, int buf, int tid) {
    const LAS float* mu = (const LAS float*)(lds + GL_MU); const LAS float* rs = (const LAS float*)(lds + GL_RS);
    if (tid < 256) {
        const int tq = tid >> 6, pi = tid & 63, s0 = 16 * tq, c2 = 2 * pi, cg = g * 128 + c2;
        const f32x2 gg = *(const f32x2*)(a.in(I_GLNG) + (size_t)layer * GMW + cg), gb = *(const f32x2*)(a.in(I_GLNB) + (size_t)layer * GMW + cg);
        unsigned rr[16];
#pragma unroll
        for (int j = 0; j < 16; ++j) rr[j] = *(const unsigned*)(P0 + (size_t)(s0 + j) * LDP + PC_V + cg);
        unsigned h0[8], h1[8], l0[8], l1[8];
#pragma unroll
        for (int e = 0; e < 8; ++e) { float oa[2], ob[2];
#pragma unroll
            for (int u = 0; u < 2; ++u) { const int j = 2 * e + u; const float m = mu[s0 + j], r = rs[s0 + j];
                oa[u] = (bflo(rr[j]) - m) * r * gg[0] + gb[0]; ob[u] = (bfhi(rr[j]) - m) * r * gg[1] + gb[1];
                *(f32x2*)(vout + (size_t)(s0 + j) * GMW + cg) = (f32x2){oa[u], ob[u]}; }
            h0[e] = pk2(oa[0], oa[1]); h1[e] = pk2(ob[0], ob[1]);
            l0[e] = pk2(oa[0] - bflo(h0[e]), oa[1] - bfhi(h0[e])); l1[e] = pk2(ob[0] - bflo(h1[e]), ob[1] - bfhi(h1[e])); }
        LAS unsigned char* d = lds + GL_VT + buf * GL_VT_BYTES + c2 * (GV_LD * 2) + s0 * 2;
        *(LAS u32x4*)d = (u32x4){h0[0], h0[1], h0[2], h0[3]}; *(LAS u32x4*)(d + 16) = (u32x4){h0[4], h0[5], h0[6], h0[7]};
        *(LAS u32x4*)(d + GV_LD * 2) = (u32x4){h1[0], h1[1], h1[2], h1[3]}; *(LAS u32x4*)(d + GV_LD * 2 + 16) = (u32x4){h1[4], h1[5], h1[6], h1[7]};
        d += 2 * GL_VT_BYTES;
        *(LAS u32x4*)d = (u32x4){l0[0], l0[1], l0[2], l0[3]}; *(LAS u32x4*)(d + 16) = (u32x4){l0[4], l0[5], l0[6], l0[7]};
        *(LAS u32x4*)(d + GV_LD * 2) = (u32x4){l1[0], l1[1], l1[2], l1[3]}; *(LAS u32x4*)(d + GV_LD * 2 + 16) = (u32x4){l1[4], l1[5], l1[6], l1[7]};
    }
}
__device__ __forceinline__ void gmlp_item_dec(const KP a, int layer, size_t r0, float* vout, bf16* PB, LAS unsigned char* lds, int tid, int wave, int lane) {
    constexpr int T = 64, NTB = 4;
    bf16* P0 = PB + r0 * LDP;
    { LAS float* mu = (LAS float*)(lds + GL_MU); LAS float* rs = (LAS float*)(lds + GL_RS);
      const int t0 = wave * 8;
      u32x4 qa[8], qb[8];
#pragma unroll
      for (int i = 0; i < 8; ++i) { const bf16* vr = P0 + (size_t)(t0 + i) * LDP + PC_V + lane * 16; qa[i] = *(const u32x4*)vr; qb[i] = *(const u32x4*)(vr + 8); }
#pragma unroll
      for (int i = 0; i < 8; ++i) {
          const float f[16] = { bflo(qa[i].x), bfhi(qa[i].x), bflo(qa[i].y), bfhi(qa[i].y), bflo(qa[i].z), bfhi(qa[i].z), bflo(qa[i].w), bfhi(qa[i].w), bflo(qb[i].x), bfhi(qb[i].x), bflo(qb[i].y), bfhi(qb[i].y), bflo(qb[i].z), bfhi(qb[i].z), bflo(qb[i].w), bfhi(qb[i].w) };
          float s = 0.f;
#pragma unroll
          for (int j = 0; j < 16; ++j) s += f[j];
          const float mean = wave_sum(s) * (1.f / GMW); float qq = 0.f;
#pragma unroll
          for (int j = 0; j < 16; ++j) { const float d = f[j] - mean; qq += d * d; }
          const float var = wave_sum(qq) * (1.f / GMW);
          if (lane == 0) { mu[t0 + i] = mean; rs[t0 + i] = rsqrtf(var + EPS); } } }
    lds_barrier();
    gmlp_stage_dec(a, layer, P0, 0, vout, lds, 0, tid);
    lds_barrier();
#pragma unroll 1
    for (int g = 0; g < 8; ++g) {
        int ln = lane; asm volatile("" : "+v"(ln)); const int lr = ln & 15, q = ln >> 4;
        if (g + 1 < 8) gmlp_stage_dec(a, layer, P0, g + 1, vout, lds, (g + 1) & 1, wave * 64 + ln);
        const LAS unsigned char* vt = lds + GL_VT + (g & 1) * GL_VT_BYTES + (16 * wave + lr) * (GV_LD * 2);
        bf16x8 ah[T / 32], al[T / 32];
#pragma unroll
        for (int kk = 0; kk < T / 32; ++kk) { ah[kk] = *(const LAS bf16x8*)(vt + (32 * kk + 8 * q) * 2); al[kk] = *(const LAS bf16x8*)(vt + 2 * GL_VT_BYTES + (32 * kk + 8 * q) * 2); }
        const float* w32 = a.in(I_GWS) + (size_t)(layer * 8 + g) * 128 * 128;
        bf16x8 wh[NTB][T / 32], wl[NTB][T / 32]; float bsv[NTB]; u32x2 uu[NTB];
#pragma unroll
        for (int tb = 0; tb < NTB; ++tb) { const int t = 16 * tb + lr;
#pragma unroll
            for (int kk = 0; kk <= tb / 2; ++kk) { const float* wp = w32 + (size_t)t * 128 + 32 * kk + 8 * q; const f32x4 w0 = *(const f32x4*)wp, w1 = *(const f32x4*)(wp + 4);
                float f[8] = {w0[0], w0[1], w0[2], w0[3], w1[0], w1[1], w1[2], w1[3]};
#pragma unroll
                for (int e = 0; e < 8; ++e) if (32 * kk + 8 * q + e > t) f[e] = 0.f;
                const u32x4 hi = {pk2(f[0], f[1]), pk2(f[2], f[3]), pk2(f[4], f[5]), pk2(f[6], f[7])};
                const u32x4 lo = {pk2(f[0] - bflo(hi.x), f[1] - bfhi(hi.x)), pk2(f[2] - bflo(hi.y), f[3] - bfhi(hi.y)), pk2(f[4] - bflo(hi.z), f[5] - bfhi(hi.z)), pk2(f[6] - bflo(hi.w), f[7] - bfhi(hi.w))};
                wh[tb][kk] = __builtin_bit_cast(bf16x8, hi); wl[tb][kk] = __builtin_bit_cast(bf16x8, lo); }
            bsv[tb] = a.in(I_GBS)[(size_t)(layer * 8 + g) * 128 + t];
            uu[tb] = *(const u32x2*)(P0 + (size_t)t * LDP + PC_U + g * 128 + 16 * wave + 4 * q); }
#pragma unroll
        for (int tb = 0; tb < NTB; ++tb) {
            f32x4 acc = {0.f, 0.f, 0.f, 0.f};
#pragma unroll
            for (int kk = 0; kk <= tb / 2; ++kk) { acc = MFMA16(al[kk], wh[tb][kk], acc); acc = MFMA16(ah[kk], wl[tb][kk], acc); acc = MFMA16(ah[kk], wh[tb][kk], acc); }
            bf16* up = P0 + (size_t)(16 * tb + lr) * LDP + PC_U + g * 128 + 16 * wave + 4 * q;
            u32x2 o; o.x = pk2(bflo(uu[tb].x) * (acc[0] + bsv[tb]), bfhi(uu[tb].x) * (acc[1] + bsv[tb])); o.y = pk2(bflo(uu[tb].y) * (acc[2] + bsv[tb]), bfhi(uu[tb].y) * (acc[3] + bsv[tb])); *(u32x2*)up = o;
        }
        lds_barrier();
    }
}

#ifndef MK_PER_PHASE
#define MK_PER_PHASE 0
#endif
constexpr int WGM_WIDE = 8;
constexpr int WGM_N2K = 4;
constexpr int FFN_R1 = 64 * 256;
constexpr int PH_PER_LAYER = 15, N_PHASES = DEPTH * PH_PER_LAYER + 1;

__global__ void __launch_bounds__(NTHREADS, 2) mk_fwd(Args a_unused) {
    (void)a_unused;
    extern __shared__ __attribute__((aligned(16))) unsigned char lds_raw[];
    LAS unsigned char* lds = (LAS unsigned char*)lds_raw;
    const int G = gridDim.x, bid = blockIdx.x;
    const int wave0 = __builtin_amdgcn_readfirstlane(threadIdx.x >> 6);
    { volatile LAS unsigned* M0 = (volatile LAS unsigned*)(lds + LDSCTL_OFF); if (threadIdx.x < 64) M0[threadIdx.x] = 0u; }
    __syncthreads();
    int lo, hi; XcdBarrier bar;
    { const KP k0 = kp_get(); lo = k0.ph_lo(); hi = k0.ph_hi();
      bar.bar = (unsigned*)(k0.ws() + WS_CTL) + CW_BAR; bar.x = 0; bar.st = (volatile LAS unsigned*)(lds + LDSCTL_OFF) + 8; bar.w0 = (unsigned)wave0;
      if (hi - lo > 1) bar = xcd_barrier_post((unsigned*)(k0.ws() + WS_CTL) + CW_BAR, (volatile LAS unsigned*)(lds + LDSCTL_OFF) + 8, (unsigned)wave0); }
#define PH_LOCALS \
    const KP a = kp_get(); int lane = lane_id(); asm volatile("" : "+v"(lane)); unsigned char* wsb = a.ws(); float* X = a.out(); \
    const int wave = wave0, tid = wave * 64 + lane, gw = bid * NWAVES + wave, NGW = G * NWAVES, gtid = bid * NTHREADS + tid, NGT = G * NTHREADS; \
    bf16* Wb = (bf16*)(wsb + WS_W); bf16* XS = (bf16*)(wsb + WS_HB); bf16* XT = (bf16*)((unsigned char*)X + WSO_XT); float* RS = (float*)(wsb + WS_RS); float* SSQ = (float*)(wsb + WS_SQ); bf16* PB = (bf16*)(wsb + WS_PB); bf16* AB = PB; bf16* PE = (bf16*)(wsb + WS_PE); float* DT = (float*)(wsb + WS_DT); float* PART = (float*)(wsb + WS_PART); \
    (void)tid; (void)gw; (void)NGW; (void)gtid; (void)NGT; (void)Wb; (void)XS; (void)XT; (void)RS; (void)SSQ; (void)PB; (void)AB; (void)PE; (void)DT; (void)PART; (void)X;

    int ph = 0;
#define PH_ON (lo <= ph && ph < hi)
#define PH_END do { if (PH_ON && ph + 1 < hi) xcd_barrier(bar); ++ph; } while (0)

    if (PH_ON) { PH_LOCALS convert_group<0>(a, 0, Wb, lds, gw, NGW, wave, lane); convert_group<1>(a, 0, Wb, lds, gw, NGW, wave, lane);
        convert_group<3>(a, 0, Wb, lds, gw, NGW, wave, lane); convert_misc(a, 0, Wb, PE, gtid, NGT);
        phase_first(a.in(I_XP), a.in(I_XS), XS, RS, gw, NGW, lane);
#ifdef DBG_FILL
        if (0 == 0) for (size_t i = OUT_SSM_P + gtid; i < OUT_END; i += NGT) a.out()[i] = 0.f;
#endif
    }
    PH_END;
    if (PH_ON) { PH_LOCALS pg8::Gemm g{XS, Wb + WO_GU1, XBP, KP_D, M_TOK, FF2, D}; pg8::StaticOrder S; S.init(M_TOK, FF2, D, G, bid, WGM_WIDE);
        EpiGU E{AB, LDF, RS}; pg8::gemm_phase<EpiGU, pg8::StaticOrder, true, true>(lds, g, S, E, wave); }
    PH_END;
    if (PH_ON) { PH_LOCALS
        pg8::Gemm g{AB, Wb + WO_D1, LDF, KP_F, M_TOK, D, FF}; pg8::TailSplitOrder S; S.init(M_P, M_TOK - M_P, M_P / 256, D, FF, G, bid, WGM_N2K, 0);
        EpiRes<false> E{nullptr, nullptr, XS, M_P, 0.5f, PART, SSQ}; pg8::gemm_phase<EpiRes<false>, pg8::TailSplitOrder, true, true>(lds, g, S, E, wave); }
    PH_END;
    if (PH_ON) { PH_LOCALS phase_rstd<true>(SSQ, RS, PART, XS, gw, NGW, lane, gtid, NGT); }
    PH_END;
    if (PH_ON) { PH_LOCALS pg8::Gemm g{XS, Wb + WO_IN, XBP, KP_D, M_TOK, NIN, D}; pg8::StaticOrder S; S.init(M_TOK, NIN, D, G, bid, WGM_WIDE);
        EpiInProj E{PB, DT, a.in(I_DTB) + 0 * NH, RS}; pg8::gemm_phase<EpiInProj, pg8::StaticOrder, true, true>(lds, g, S, E, wave);
        TAIL_CONVERT((M_TOK / 256) * (NIN / 256), convert_group<2>(a, 0, Wb, lds, tw_, tn_, wave, lane);); }
    PH_END;
    if (PH_ON) { PH_LOCALS
        constexpr int N_S1 = NB_P * NSC1 * NG, N_GM = NB_P * (SEQ / 128) + NB_S;
        for (int it = bid; it < N_S1; it += G) ssd1_item(a, 0, it / (NSC1 * NG), (it / NG) % NSC1, it % NG, PB, DT, (unsigned char*)X, lds, tid, wave, lane);
        for (int j = bid; j < NB_P * (SEQ / 128); j += G) gmlp_item<128>(a, 0, (size_t)(j / (SEQ / 128)) * SEQ + (size_t)(j % (SEQ / 128)) * 128, nullptr, PB, Wb + WO_WS, lds, tid, wave, lane);
        for (int bs = (G >= NB_S) ? bid - (G - NB_S) : bid; bs < NB_S; bs += G) if (bs >= 0)
            gmlp_item_dec(a, 0, (size_t)M_P + (size_t)bs * L_S, X + OUT_GV + (size_t)(0 * NB_S + bs) * L_S * GMW, PB, lds, tid, wave, lane);
        (void)N_GM;
    }
    PH_END;
    if (PH_ON) { PH_LOCALS
        constexpr int N_S3D = NB_S * NG;
        if (G > N_S3D) {
            if (bid < N_S3D) { const int bs = bid / NG, g = bid % NG;
                ssd3_item(a, 0, (size_t)M_P + (size_t)bs * L_S, 1, g, nullptr, a.in(I_SSSM) + (size_t)(0 * NB_S + bs) * NH * HD * NS, 2, a.in(I_SCONV) + (size_t)(0 * NB_S + bs) * 3 * XBC,
                          X + OUT_SSM_S + (size_t)(0 * NB_S + bs) * NH * HD * NS, X + OUT_CONV_S + (size_t)(0 * NB_S + bs) * 3 * XBC, PB, DT, lds, tid, wave, lane); }
            else ssd2_phase((unsigned char*)X, gw - N_S3D * NWAVES, NGW - N_S3D * NWAVES, lane);
        } else {
            for (int j = bid; j < N_S3D; j += G) { const int bs = j / NG, g = j % NG;
                ssd3_item(a, 0, (size_t)M_P + (size_t)bs * L_S, 1, g, nullptr, a.in(I_SSSM) + (size_t)(0 * NB_S + bs) * NH * HD * NS, 2, a.in(I_SCONV) + (size_t)(0 * NB_S + bs) * 3 * XBC,
                          X + OUT_SSM_S + (size_t)(0 * NB_S + bs) * NH * HD * NS, X + OUT_CONV_S + (size_t)(0 * NB_S + bs) * 3 * XBC, PB, DT, lds, tid, wave, lane); }
            ssd2_phase((unsigned char*)X, gw, NGW, lane);
        }
    }
    PH_END;
    if (PH_ON) { PH_LOCALS
        constexpr int N_S3P = NB_P * NSC * NG;
        for (int it = bid; it < N_S3P; it += G) {
            { const int b = it / (NSC * NG), k = (it / NG) % NSC, g = it % NG; const bool lastk = (k == NSC - 1);
                ssd3_item(a, 0, (size_t)b * SEQ + (size_t)k * SC * 64, SC, g, k ? (const float*)((unsigned char*)X + WSO_ST) + ((size_t)b * NSC1 + (k - 1)) * NH * ST_ELEMS : nullptr, nullptr, k ? 1 : 0, nullptr,
                          lastk ? X + OUT_SSM_P + (size_t)(0 * NB_P + b) * NH * HD * NS : nullptr, lastk ? X + OUT_CONV_P + (size_t)(0 * NB_P + b) * 3 * XBC : nullptr, PB, DT, lds, tid, wave, lane); }
        }
    }
    PH_END;
    if (PH_ON) { PH_LOCALS
        { pg8::Gemm g{PB + PC_Z, Wb + WO_A, LDP, KP_D, M_TOK, D, DIN}; pg8::StaticOrder S; S.init(M_TOK, D, DIN, G, bid, WGM_N2K);
          EpiMerge<0> E{PB + PC_GA, PB + PC_MRG}; pg8::gemm_phase<EpiMerge<0>, pg8::StaticOrder, true, true>(lds, g, S, E, wave); }
        { pg8::Gemm g{PB + PC_U, Wb + WO_B, LDP, KP_G, M_TOK, D, GMW}; pg8::StaticOrder S; S.init(M_TOK, D, GMW, G, bid, WGM_N2K);
          EpiMerge<1> E{PB + PC_GB, PB + PC_MRG}; pg8::gemm_phase<EpiMerge<1>, pg8::StaticOrder, true, true>(lds, g, S, E, wave); }
        TAIL_CONVERT((M_TOK / 256) * (D / 256), convert_group<0>(a, 1, Wb, lds, tw_, tn_, wave, lane); convert_group<1>(a, 1, Wb, lds, tw_, tn_, wave, lane););
    }
    PH_END;
    if (PH_ON) { PH_LOCALS pg8::Gemm g{PB + PC_MRG, Wb + WO_O, LDP, KP_D, M_TOK, D, D}; pg8::TailSplitOrder S; S.init(M_P, M_TOK - M_P, M_P / 256, D, D, G, bid, WGM_N2K, 0);
        EpiRes<false> E{nullptr, nullptr, XS, M_P, 1.0f, PART, SSQ}; pg8::gemm_phase<EpiRes<false>, pg8::TailSplitOrder, true, true>(lds, g, S, E, wave); }
    PH_END;
    if (PH_ON) { PH_LOCALS phase_rstd<true>(SSQ, RS, PART, XS, gw, NGW, lane, gtid, NGT); }
    PH_END;
    if (PH_ON) { PH_LOCALS pg8::Gemm g{XS, Wb + WO_GU2, XBP, KP_D, M_TOK, FF2, D}; pg8::StaticOrder S; S.init(M_TOK, FF2, D, G, bid, WGM_WIDE);
        EpiGU E{AB, LDF, RS}; pg8::gemm_phase<EpiGU, pg8::StaticOrder, true, true>(lds, g, S, E, wave); }
    PH_END;
    if (PH_ON) { PH_LOCALS
        pg8::Gemm g{AB, Wb + WO_D2, LDF, KP_F, M_TOK, D, FF}; pg8::TailSplitOrder S; S.init(M_P, M_TOK - M_P, M_P / 256, D, FF, G, bid, WGM_N2K, 0);
        EpiRes<false> E{nullptr, nullptr, XS, M_P, 0.5f, PART, SSQ}; pg8::gemm_phase<EpiRes<false>, pg8::TailSplitOrder, true, true>(lds, g, S, E, wave); }
    PH_END;
    if (PH_ON) { PH_LOCALS phase_rstd<true>(SSQ, RS, PART, XS, gw, NGW, lane, gtid, NGT); }
    PH_END;
    if (PH_ON) { PH_LOCALS
        { pg8::Gemm g{XS, Wb + WO_PG, XBP, KP_D, M_TOK, D, D}; pg8::StaticOrder S; S.init(M_TOK, D, D, G, bid, WGM_N2K);
          EpiPg E{PB + PC_TMP, RS}; pg8::gemm_phase<EpiPg, pg8::StaticOrder, true, true>(lds, g, S, E, wave); }
        { pg8::Gemm g{PE, Wb + WO_PP, LDE, KP_E, M_TOK, D, PLE}; pg8::StaticOrder S; S.init(M_TOK, D, PLE, G, bid, WGM_N2K);
          EpiPle E{PB + PC_TMP, XS, XT, SSQ}; pg8::gemm_phase<EpiPle, pg8::StaticOrder, true, true>(lds, g, S, E, wave); }
        TAIL_CONVERT((M_TOK / 256) * (D / 256), convert_group<2>(a, 1, Wb, lds, tw_, tn_, wave, lane););
    }
    PH_END;
    if (PH_ON) { PH_LOCALS
        convert_group<3>(a, 1, Wb, lds, gw, NGW, wave, lane); convert_misc(a, 1, Wb, PE, gtid, NGT);
        phase_rstd<false>(SSQ, RS, PART, XT, gw, NGW, lane, gtid, NGT);
#ifdef DBG_FILL
        if (1 == 0) for (size_t i = OUT_SSM_P + gtid; i < OUT_END; i += NGT) a.out()[i] = 0.f;
#endif
    }
    PH_END;
    if (PH_ON) { PH_LOCALS pg8::Gemm g{XT, Wb + WO_GU1, XBP, KP_D, M_TOK, FF2, D}; pg8::StaticOrder S; S.init(M_TOK, FF2, D, G, bid, WGM_WIDE);
        EpiGU E{AB, LDF, RS}; pg8::gemm_phase<EpiGU, pg8::StaticOrder, true, true>(lds, g, S, E, wave); }
    PH_END;
    if (PH_ON) { PH_LOCALS
        pg8::Gemm g{AB, Wb + WO_D1, LDF, KP_F, M_TOK, D, FF}; pg8::TailSplitOrder S; S.init(M_P, M_TOK - M_P, M_P / 256, D, FF, G, bid, WGM_N2K, 0);
        EpiRes<false> E{nullptr, nullptr, XT, M_P, 0.5f, PART, SSQ}; pg8::gemm_phase<EpiRes<false>, pg8::TailSplitOrder, true, true>(lds, g, S, E, wave); }
    PH_END;
    if (PH_ON) { PH_LOCALS phase_rstd<true>(SSQ, RS, PART, XT, gw, NGW, lane, gtid, NGT); }
    PH_END;
    if (PH_ON) { PH_LOCALS pg8::Gemm g{XT, Wb + WO_IN, XBP, KP_D, M_TOK, NIN, D}; pg8::StaticOrder S; S.init(M_TOK, NIN, D, G, bid, WGM_WIDE);
        EpiInProj E{PB, DT, a.in(I_DTB) + 1 * NH, RS}; pg8::gemm_phase<EpiInProj, pg8::StaticOrder, true, true>(lds, g, S, E, wave); }
    PH_END;
    if (PH_ON) { PH_LOCALS
        constexpr int N_S1 = NB_P * NSC1 * NG, N_GM = NB_P * (SEQ / 128) + NB_S;
        for (int it = bid; it < N_S1; it += G) ssd1_item(a, 1, it / (NSC1 * NG), (it / NG) % NSC1, it % NG, PB, DT, (unsigned char*)X, lds, tid, wave, lane);
        for (int j = bid; j < NB_P * (SEQ / 128); j += G) gmlp_item<128>(a, 1, (size_t)(j / (SEQ / 128)) * SEQ + (size_t)(j % (SEQ / 128)) * 128, nullptr, PB, Wb + WO_WS, lds, tid, wave, lane);
        for (int bs = (G >= NB_S) ? bid - (G - NB_S) : bid; bs < NB_S; bs += G) if (bs >= 0)
            gmlp_item_dec(a, 1, (size_t)M_P + (size_t)bs * L_S, X + OUT_GV + (size_t)(1 * NB_S + bs) * L_S * GMW, PB, lds, tid, wave, lane);
        (void)N_GM;
    }
    PH_END;
    if (PH_ON) { PH_LOCALS
        constexpr int N_S3D = NB_S * NG;
        if (G > N_S3D) {
            if (bid < N_S3D) { const int bs = bid / NG, g = bid % NG;
                ssd3_item(a, 1, (size_t)M_P + (size_t)bs * L_S, 1, g, nullptr, a.in(I_SSSM) + (size_t)(1 * NB_S + bs) * NH * HD * NS, 2, a.in(I_SCONV) + (size_t)(1 * NB_S + bs) * 3 * XBC,
                          X + OUT_SSM_S + (size_t)(1 * NB_S + bs) * NH * HD * NS, X + OUT_CONV_S + (size_t)(1 * NB_S + bs) * 3 * XBC, PB, DT, lds, tid, wave, lane); }
            else ssd2_phase((unsigned char*)X, gw - N_S3D * NWAVES, NGW - N_S3D * NWAVES, lane);
        } else {
            for (int j = bid; j < N_S3D; j += G) { const int bs = j / NG, g = j % NG;
                ssd3_item(a, 1, (size_t)M_P + (size_t)bs * L_S, 1, g, nullptr, a.in(I_SSSM) + (size_t)(1 * NB_S + bs) * NH * HD * NS, 2, a.in(I_SCONV) + (size_t)(1 * NB_S + bs) * 3 * XBC,
                          X + OUT_SSM_S + (size_t)(1 * NB_S + bs) * NH * HD * NS, X + OUT_CONV_S + (size_t)(1 * NB_S + bs) * 3 * XBC, PB, DT, lds, tid, wave, lane); }
            ssd2_phase((unsigned char*)X, gw, NGW, lane);
        }
    }
    PH_END;
    if (PH_ON) { PH_LOCALS
        constexpr int N_S3P = NB_P * NSC * NG;
        for (int it = bid; it < N_S3P; it += G) {
            { const int b = it / (NSC * NG), k = (it / NG) % NSC, g = it % NG; const bool lastk = (k == NSC - 1);
                ssd3_item(a, 1, (size_t)b * SEQ + (size_t)k * SC * 64, SC, g, k ? (const float*)((unsigned char*)X + WSO_ST) + ((size_t)b * NSC1 + (k - 1)) * NH * ST_ELEMS : nullptr, nullptr, k ? 1 : 0, nullptr,
                          lastk ? X + OUT_SSM_P + (size_t)(1 * NB_P + b) * NH * HD * NS : nullptr, lastk ? X + OUT_CONV_P + (size_t)(1 * NB_P + b) * 3 * XBC : nullptr, PB, DT, lds, tid, wave, lane); }
        }
    }
    PH_END;
    if (PH_ON) { PH_LOCALS
        { pg8::Gemm g{PB + PC_Z, Wb + WO_A, LDP, KP_D, M_TOK, D, DIN}; pg8::StaticOrder S; S.init(M_TOK, D, DIN, G, bid, WGM_N2K);
          EpiMerge<0> E{PB + PC_GA, PB + PC_MRG}; pg8::gemm_phase<EpiMerge<0>, pg8::StaticOrder, true, true>(lds, g, S, E, wave); }
        { pg8::Gemm g{PB + PC_U, Wb + WO_B, LDP, KP_G, M_TOK, D, GMW}; pg8::StaticOrder S; S.init(M_TOK, D, GMW, G, bid, WGM_N2K);
          EpiMerge<1> E{PB + PC_GB, PB + PC_MRG}; pg8::gemm_phase<EpiMerge<1>, pg8::StaticOrder, true, true>(lds, g, S, E, wave); }
    }
    PH_END;
    if (PH_ON) { PH_LOCALS pg8::Gemm g{PB + PC_MRG, Wb + WO_O, LDP, KP_D, M_TOK, D, D}; pg8::TailSplitOrder S; S.init(M_P, M_TOK - M_P, M_P / 256, D, D, G, bid, WGM_N2K, 0);
        EpiRes<false> E{nullptr, nullptr, XT, M_P, 1.0f, PART, SSQ}; pg8::gemm_phase<EpiRes<false>, pg8::TailSplitOrder, true, true>(lds, g, S, E, wave); }
    PH_END;
    if (PH_ON) { PH_LOCALS phase_rstd<true>(SSQ, RS, PART, XT, gw, NGW, lane, gtid, NGT); }
    PH_END;
    if (PH_ON) { PH_LOCALS pg8::Gemm g{XT, Wb + WO_GU2, XBP, KP_D, M_TOK, FF2, D}; pg8::StaticOrder S; S.init(M_TOK, FF2, D, G, bid, WGM_WIDE);
        EpiGU E{AB, LDF, RS}; pg8::gemm_phase<EpiGU, pg8::StaticOrder, true, true>(lds, g, S, E, wave); }
    PH_END;
    if (PH_ON) { PH_LOCALS
        pg8::Gemm g{AB, Wb + WO_D2, LDF, KP_F, M_TOK, D, FF}; pg8::TailSplitOrder S; S.init(M_P, M_TOK - M_P, M_P / 256, D, FF, G, bid, WGM_N2K, 0);
        EpiRes<false> E{nullptr, nullptr, XT, M_P, 0.5f, PART, SSQ}; pg8::gemm_phase<EpiRes<false>, pg8::TailSplitOrder, true, true>(lds, g, S, E, wave); }
    PH_END;
    if (PH_ON) { PH_LOCALS phase_rstd<true>(SSQ, RS, PART, XT, gw, NGW, lane, gtid, NGT); }
    PH_END;
    if (PH_ON) { PH_LOCALS
        { pg8::Gemm g{XT, Wb + WO_PG, XBP, KP_D, M_TOK, D, D}; pg8::StaticOrder S; S.init(M_TOK, D, D, G, bid, WGM_N2K);
          EpiPg E{PB + PC_TMP, RS}; pg8::gemm_phase<EpiPg, pg8::StaticOrder, true, true>(lds, g, S, E, wave); }
        { pg8::Gemm g{PE, Wb + WO_PP, LDE, KP_E, M_TOK, D, PLE}; pg8::StaticOrder S; S.init(M_TOK, D, PLE, G, bid, WGM_N2K);
          EpiPle E{PB + PC_TMP, XT, XS, SSQ}; pg8::gemm_phase<EpiPle, pg8::StaticOrder, true, true>(lds, g, S, E, wave); }
    }
    PH_END;
    if (PH_ON) { PH_LOCALS phase_final_norm(XS, X, a.in(I_FINN), gw, NGW, lane); }
    PH_END;
#undef PH_ON
#undef PH_END
}

extern "C" void kernel_launch(void* const* d_in, const int* in_sizes, int n_in, void* d_out, int out_size, void* d_ws, size_t ws_size, hipStream_t stream) {
    static int grid = 0;
    if (grid == 0) {
        if (n_in != N_IN || (size_t)out_size != OUT_END || ws_size < WS_END) { fprintf(stderr, "kernel_launch: unexpected problem: n_in %d out %d ws %zu (need %zu)\n", n_in, out_size, ws_size, (size_t)WS_END); grid = -1; return; }
        int dev = 0, cus = 0, per_cu = 0;
        if (hipGetDevice(&dev) != hipSuccess || hipDeviceGetAttribute(&cus, hipDeviceAttributeMultiprocessorCount, dev) != hipSuccess) { grid = -1; return; }
        if (hipFuncSetAttribute((const void*)mk_fwd, hipFuncAttributeMaxDynamicSharedMemorySize, LDS_BYTES) != hipSuccess) { fprintf(stderr, "kernel_launch: hipFuncSetAttribute failed\n"); grid = -1; return; }
        if (hipOccupancyMaxActiveBlocksPerMultiprocessor(&per_cu, (const void*)mk_fwd, NTHREADS, LDS_BYTES) != hipSuccess || per_cu < 1) { fprintf(stderr, "kernel_launch: occupancy query says %d blocks per CU\n", per_cu); (void)hipGetLastError(); grid = -1; return; }
        grid = cus;
    }
    if (grid < 0) return;
    (void)in_sizes;
    if (hipMemsetAsync((char*)d_ws + WS_CTL, 0, CTL_ZERO_BYTES, stream) != hipSuccess) return;
    Args a{};
    for (int i = 0; i < N_IN; ++i) a.in[i] = (const float*)d_in[i];
    a.out = (float*)d_out; a.ws = (unsigned char*)d_ws;
#if MK_PER_PHASE
    #ifndef DBG_LIMIT
#define DBG_LIMIT N_PHASES
#endif
    for (int p = 0; p < DBG_LIMIT; ++p) { a.ph_lo = p; a.ph_hi = p + 1; hipLaunchKernelGGL(mk_fwd, dim3(grid), dim3(NTHREADS), LDS_BYTES, stream, a); }
#else
    a.ph_lo = 0; a.ph_hi = N_PHASES; hipLaunchKernelGGL(mk_fwd, dim3(grid), dim3(NTHREADS), LDS_BYTES, stream, a);
#endif
    const hipError_t le = hipPeekAtLastError();
    if (le != hipSuccess) fprintf(stderr, "kernel_launch: launch failed: %s\n", hipGetErrorName(le));
}
```
